# Optimizing an MI355X kernel written in HIP

```python
import math
import jax
import jax.numpy as jnp
from jax import lax
import numpy as np

D_MODEL = 1024
BATCH = 2
SEQ = 8192
DEPTH = 4
DEC_BATCH = 32
DEC_SEQ = 8
PAST_LEN = 8192
PAGE_SIZE = 128

N_A_LAYERS = DEPTH // 2
N_B_LAYERS = DEPTH - N_A_LAYERS

M_EXPAND = 2
M_D_INNER = M_EXPAND * D_MODEL
M_HEADDIM = 64
M_HEADS = M_D_INNER // M_HEADDIM
M_NGROUPS = 4
M_D_STATE = 128
M_CONV = 4
M_GN = M_NGROUPS * M_D_STATE
M_CONV_DIM = M_D_INNER + 2 * M_GN
M_IN_DIM = 2 * M_D_INNER + 2 * M_GN + M_HEADS
SSD_CHUNK = 128

HEAD_DIM = 64
HEADS_PER_GROUP = D_MODEL // HEAD_DIM
DIL_PAIRS = ((128, 1), (512, 4), (2048, 16))
N_DIL = len(DIL_PAIRS)
ATT_HEADS = N_DIL * HEADS_PER_GROUP
ATT_WIDTH = ATT_HEADS * HEAD_DIM
ATT_OUT = HEADS_PER_GROUP * HEAD_DIM
WINDOW_MAX = 2048
ATT_BLOCK = 128
ROPE_THETA = 10000.0

D_FF = 2816
FFN_CONV = 3

EPS = 1e-6

kernel_name = 'yoco_ssd_dilated_convffn_step'


def rmsnorm(x, g):
    xf = x.astype(jnp.float32)
    y = xf * lax.rsqrt(jnp.mean(xf * xf, axis=-1, keepdims=True) + EPS)
    return (y * g.astype(jnp.float32)).astype(x.dtype)


def modulate(x, shift, scale):
    return x * (1 + scale[:, None]) + shift[:, None]


def causal_dwconv(x, prev, w, b):
    K = w.shape[0]
    T = x.shape[1]
    xc = jnp.concatenate([prev.astype(x.dtype), x], axis=1)
    y = sum(xc[:, k:k + T] * w[k] for k in range(K)) + b
    return y, xc[:, T:]


def rope(x, pos):
    dh = x.shape[-1]
    half = dh // 2
    inv = ROPE_THETA ** (-jnp.arange(half, dtype=jnp.float32) * (2.0 / dh))
    ang = pos.astype(jnp.float32)[:, None] * inv[None, :]
    cos = jnp.cos(ang)[None, :, None, :]
    sin = jnp.sin(ang)[None, :, None, :]
    xf = x.astype(jnp.float32)
    x1, x2 = xf[..., :half], xf[..., half:]
    return jnp.concatenate([x1 * cos - x2 * sin, x2 * cos + x1 * sin], axis=-1).astype(x.dtype)


def ssd_scan(x, dt, A, Bm, Cm, h0):
    f32 = jnp.float32
    b, L, H, P = x.shape
    G, N = Bm.shape[2], Bm.shape[3]
    E = H // G
    Q = min(SSD_CHUNK, L)
    nc = -(-L // Q)
    pad = nc * Q - L

    def padt(t):
        return jnp.pad(t.astype(f32), [(0, 0), (0, pad)] + [(0, 0)] * (t.ndim - 2))

    xc = padt(x).reshape(b, nc, Q, G, E, P)
    dtc = padt(dt).reshape(b, nc, Q, G, E)
    Bc = padt(Bm).reshape(b, nc, Q, G, N)
    Cc = padt(Cm).reshape(b, nc, Q, G, N)
    acum = jnp.cumsum(dtc * A.astype(f32).reshape(G, E), axis=2)
    seg = acum[:, :, :, None] - acum[:, :, None, :]
    causal = jnp.tril(jnp.ones((Q, Q), dtype=bool))[:, :, None, None]
    Lm = jnp.exp(jnp.where(causal, seg, -jnp.inf))
    xdt = xc * dtc[..., None]
    CB = jnp.einsum('bclgn,bcsgn->bclsg', Cc, Bc)
    y_diag = jnp.einsum('bclsge,bcsgep->bclgep', CB[..., None] * Lm, xdt)
    xdt_dec = xdt * jnp.exp(acum[:, :, -1:] - acum)[..., None]
    states = jnp.einsum('bclgn,bclgep->bcgepn', Bc, xdt_dec)
    chunk_decay = jnp.exp(acum[:, :, -1])

    def step(h, inp):
        dec, s = inp
        return h * dec[..., None, None] + s, h

    h_last, h_prev = lax.scan(step, h0.astype(f32).reshape(b, G, E, P, N),
                              (jnp.moveaxis(chunk_decay, 1, 0), jnp.moveaxis(states, 1, 0)))
    h_prev = jnp.moveaxis(h_prev, 0, 1)
    y_off = jnp.einsum('bclgn,bcgepn->bclgep', Cc, h_prev) * jnp.exp(acum)[..., None]
    y = (y_diag + y_off).reshape(b, nc * Q, H, P)[:, :L]
    return y, h_last.reshape(b, H, P, N)


def mamba2_mixer(xn, ssm0, conv0, w_in, conv_w, conv_b, dt_bias, A_log, Dskip, norm_w, w_out):
    f32 = jnp.float32
    B_, T, _ = xn.shape
    zxbcdt = xn @ w_in
    z = zxbcdt[..., :M_D_INNER]
    xBC = zxbcdt[..., M_D_INNER:M_D_INNER + M_CONV_DIM]
    dt = zxbcdt[..., M_D_INNER + M_CONV_DIM:]
    xBC, conv_new = causal_dwconv(xBC, conv0, conv_w, conv_b)
    xBC = jax.nn.silu(xBC)
    xs = xBC[..., :M_D_INNER].reshape(B_, T, M_HEADS, M_HEADDIM)
    Bm = xBC[..., M_D_INNER:M_D_INNER + M_GN].reshape(B_, T, M_NGROUPS, M_D_STATE)
    Cm = xBC[..., M_D_INNER + M_GN:].reshape(B_, T, M_NGROUPS, M_D_STATE)
    dt = jax.nn.softplus(dt.astype(f32) + dt_bias.astype(f32))
    A = -jnp.exp(A_log.astype(f32))
    y, ssm_new = ssd_scan(xs, dt, A, Bm, Cm, ssm0)
    y = y + Dskip.astype(f32)[:, None] * xs.astype(f32)
    yg = (y.reshape(B_, T, M_D_INNER) * jax.nn.silu(z.astype(f32))).reshape(
        B_, T, M_NGROUPS, M_D_INNER // M_NGROUPS)
    yg = yg * lax.rsqrt(jnp.mean(yg * yg, axis=-1, keepdims=True) + EPS)
    y = (yg.reshape(B_, T, M_D_INNER) * norm_w.astype(f32)).astype(xn.dtype)
    return y @ w_out, ssm_new.astype(ssm0.dtype), conv_new


def conv_ffn(xn, prev, w_up, conv_w, conv_b, w_down):
    u, new_prev = causal_dwconv(xn @ w_up, prev, conv_w, conv_b)
    return (jax.nn.silu(u[..., :D_FF]) * u[..., D_FF:]) @ w_down, new_prev


def dilated_band(q, k, v, window, dil):
    f32 = jnp.float32
    B_, S, H, Dh = q.shape
    band = window // dil
    span = dil * ATT_BLOCK
    L = -(-S // span) * span
    n = L // dil
    nb = n // ATT_BLOCK

    def split(t):
        t = jnp.pad(t, [(0, 0), (0, L - S), (0, 0), (0, 0)])
        return t.reshape(B_, n, dil, H, Dh).transpose(0, 2, 1, 3, 4).reshape(B_, dil, nb, ATT_BLOCK, H, Dh)

    def band_keys(t):
        tp = jnp.pad(t, [(0, 0), (0, 0), (1, 0), (0, 0), (0, 0), (0, 0)])
        return jnp.concatenate([tp[:, :, :-1], tp[:, :, 1:]], axis=3)

    qb = split(q)
    kk = band_keys(split(k))
    vv = band_keys(split(v))
    s = jnp.einsum('brcqhe,brckhe->brchqk', qb, kk).astype(f32) * (Dh ** -0.5)
    i = jnp.arange(ATT_BLOCK)[:, None]
    j = jnp.arange(2 * ATT_BLOCK)[None, :]
    dist = ATT_BLOCK + i - j
    c = jnp.arange(nb)[:, None, None]
    valid = (dist >= 0) & (dist <= band) & ((c > 0) | (j >= ATT_BLOCK))
    s = jnp.where(valid[None, None, :, None], s, -jnp.inf)
    m = s.max(axis=-1)
    p = jnp.exp(s - m[..., None])
    l = p.sum(axis=-1)
    o = jnp.einsum('brchqk,brckhe->brcqhe', p, vv.astype(f32))

    def merge(t):
        rest = t.shape[4:]
        t = t.reshape((B_, dil, n) + rest).swapaxes(1, 2).reshape((B_, L) + rest)
        return t[:, :S]

    return merge(m.swapaxes(-1, -2)), merge(l.swapaxes(-1, -2)), merge(o)


def dilated_gather(q, k_all, v_all, window, dil, q_off):
    f32 = jnp.float32
    B_, T, H, Dh = q.shape
    band = window // dil
    idx = q_off + jnp.arange(T)[:, None] - dil * jnp.arange(band + 1)[None, :]
    valid = idx >= 0
    idx = jnp.maximum(idx, 0)
    kg = jnp.take(k_all, idx, axis=1)
    vg = jnp.take(v_all, idx, axis=1)
    s = jnp.einsum('bthe,btkhe->bthk', q, kg).astype(f32) * (Dh ** -0.5)
    s = jnp.where(valid[None, :, None, :], s, -jnp.inf)
    m = s.max(axis=-1)
    p = jnp.exp(s - m[..., None])
    l = p.sum(axis=-1)
    o = jnp.einsum('bthk,btkhe->bthe', p, vg.astype(f32))
    return m, l, o


def combine_groups(parts):
    m = jnp.stack([pt[0] for pt in parts])
    l = jnp.stack([pt[1] for pt in parts])
    o = jnp.stack([pt[2] for pt in parts])
    w = jnp.exp(m - m.max(axis=0))
    return jnp.einsum('gbth,gbthe->bthe', w, o) / jnp.sum(w * l, axis=0)[..., None]


def dilated_attention(xn, pos, kv, w_q, w_o):
    B_, T, _ = xn.shape
    k_src, v_src, off = kv
    q = rope((xn @ w_q).reshape(B_, T, ATT_HEADS, HEAD_DIM), pos)
    parts = []
    for g, (win, dil) in enumerate(DIL_PAIRS):
        hs = slice(g * HEADS_PER_GROUP, (g + 1) * HEADS_PER_GROUP)
        if off is None:
            parts.append(dilated_band(q[:, :, hs], k_src[:, :, hs], v_src[:, :, hs], win, dil))
        else:
            parts.append(dilated_gather(q[:, :, hs], k_src[:, :, hs], v_src[:, :, hs], win, dil, off))
    o = combine_groups(parts)
    return o.reshape(B_, T, ATT_OUT).astype(xn.dtype) @ w_o


def trunk(x, c, pos, ssm0, conv0, ffn0, kv_past, p):
    B_, T, _ = x.shape
    h = x
    cs = jax.nn.silu(c)
    ssm_out, conv_out, ffn_out = [], [], []
    kv = None
    k_new = None
    v_new = None
    for i in range(DEPTH):
        mod = cs @ p['ada_w'][i] + p['ada_b'][i]
        sh1, sc1, g1, sh2, sc2, g2 = jnp.split(mod, 6, axis=-1)
        xn = modulate(rmsnorm(h, p['norm_mix'][i]), sh1, sc1)
        if i < N_A_LAYERS:
            y, s_new, cv_new = mamba2_mixer(xn, ssm0[i], conv0[i], p['m_w_in'][i], p['m_conv_w'][i],
                                           p['m_conv_b'][i], p['m_dt_bias'][i], p['m_A_log'][i],
                                           p['m_D'][i], p['m_norm'][i], p['m_w_out'][i])
            ssm_out.append(s_new)
            conv_out.append(cv_new)
        else:
            jb = i - N_A_LAYERS
            y = dilated_attention(xn, pos, kv, p['w_q'][jb], p['w_o'][jb])
        h = h + g1[:, None] * y
        xn = modulate(rmsnorm(h, p['norm_ffn'][i]), sh2, sc2)
        y, f_new = conv_ffn(xn, ffn0[i], p['ffn_w_up'][i], p['ffn_conv_w'][i], p['ffn_conv_b'][i],
                            p['ffn_w_down'][i])
        ffn_out.append(f_new)
        h = h + g2[:, None] * y
        if i == N_A_LAYERS - 1:
            ksh, ksc = jnp.split(cs @ p['kv_ada_w'] + p['kv_ada_b'], 2, axis=-1)
            xkv = modulate(rmsnorm(h, p['kv_norm']), ksh, ksc)
            kvp = (xkv @ p['w_kv']).reshape(B_, T, 2, ATT_HEADS, HEAD_DIM)
            k_new = rope(kvp[:, :, 0], pos)
            v_new = kvp[:, :, 1]
            if kv_past is None:
                kv = (k_new, v_new, None)
            else:
                ck, cv = kv_past
                kv = (jnp.concatenate([ck.astype(k_new.dtype), k_new], axis=1),
                      jnp.concatenate([cv.astype(v_new.dtype), v_new], axis=1), ck.shape[1])
    y = rmsnorm(h, p['final_norm'])
    return y, jnp.stack(ssm_out), jnp.stack(conv_out), jnp.stack(ffn_out), k_new, v_new


def setup_inputs(seed: int = 0) -> dict:
    key = jax.random.key(seed)
    keys = iter(jax.random.split(key, 48))
    f32 = jnp.float32

    def nrm(shape, scale):
        return jax.random.normal(next(keys), shape, f32) * scale

    def gain(shape):
        return 1.0 + nrm(shape, 0.01)

    win_buf = min(WINDOW_MAX, PAST_LEN)
    D = D_MODEL
    x_prompt = nrm((BATCH, SEQ, D), 1.0)
    x_sample = nrm((DEC_BATCH, DEC_SEQ, D), 1.0)
    state_ssm = nrm((N_A_LAYERS, DEC_BATCH, M_HEADS, M_HEADDIM, M_D_STATE), 0.1)
    state_conv = nrm((N_A_LAYERS, DEC_BATCH, M_CONV - 1, M_CONV_DIM), 1.0)
    state_ffn_conv = nrm((DEPTH, DEC_BATCH, FFN_CONV - 1, 2 * D_FF), 1.0)
    cache_k = nrm((DEC_BATCH, win_buf, ATT_HEADS, HEAD_DIM), 1.0)
    cache_v = nrm((DEC_BATCH, win_buf, ATT_HEADS, HEAD_DIM), 1.0)
    c_prompt = nrm((BATCH, D), 1.0)
    c_sample = nrm((DEC_BATCH, D), 1.0)
    ada_w = nrm((DEPTH, D, 6 * D), 0.5 * D ** -0.5)
    ada_b = nrm((DEPTH, 6 * D), 0.02)
    norm_mix = gain((DEPTH, D))
    norm_ffn = gain((DEPTH, D))
    m_w_in = nrm((N_A_LAYERS, D, M_IN_DIM), D ** -0.5)
    m_conv_w = nrm((N_A_LAYERS, M_CONV, M_CONV_DIM), 0.5)
    m_conv_b = nrm((N_A_LAYERS, M_CONV_DIM), 0.02)
    dt0 = jnp.exp(jax.random.uniform(next(keys), (N_A_LAYERS, M_HEADS), f32,
                                     math.log(1e-3), math.log(1e-1)))
    m_dt_bias = dt0 + jnp.log(-jnp.expm1(-dt0))
    m_A_log = jnp.log(jax.random.uniform(next(keys), (N_A_LAYERS, M_HEADS), f32, 1.0, 16.0))
    m_D = 1.0 + nrm((N_A_LAYERS, M_HEADS), 0.1)
    m_norm = gain((N_A_LAYERS, M_D_INNER))
    m_w_out = nrm((N_A_LAYERS, M_D_INNER, D), M_D_INNER ** -0.5)
    kv_norm = gain((D,))
    kv_ada_w = nrm((D, 2 * D), 0.5 * D ** -0.5)
    kv_ada_b = nrm((2 * D,), 0.02)
    w_kv = nrm((D, 2 * ATT_WIDTH), D ** -0.5)
    w_q = nrm((N_B_LAYERS, D, ATT_WIDTH), D ** -0.5)
    w_o = nrm((N_B_LAYERS, ATT_OUT, D), ATT_OUT ** -0.5)
    ffn_w_up = nrm((DEPTH, D, 2 * D_FF), D ** -0.5)
    ffn_conv_w = nrm((DEPTH, FFN_CONV, 2 * D_FF), 0.6)
    ffn_conv_b = nrm((DEPTH, 2 * D_FF), 0.02)
    ffn_w_down = nrm((DEPTH, D_FF, D), D_FF ** -0.5)
    final_norm = gain((D,))
    return {'x_prompt': x_prompt, 'x_sample': x_sample, 'state_ssm': state_ssm, 'state_conv': state_conv,
            'state_ffn_conv': state_ffn_conv, 'cache_k': cache_k, 'cache_v': cache_v,
            'c_prompt': c_prompt, 'c_sample': c_sample, 'ada_w': ada_w, 'ada_b': ada_b,
            'norm_mix': norm_mix, 'norm_ffn': norm_ffn, 'm_w_in': m_w_in, 'm_conv_w': m_conv_w,
            'm_conv_b': m_conv_b, 'm_dt_bias': m_dt_bias, 'm_A_log': m_A_log, 'm_D': m_D,
            'm_norm': m_norm, 'm_w_out': m_w_out, 'kv_norm': kv_norm, 'kv_ada_w': kv_ada_w,
            'kv_ada_b': kv_ada_b, 'w_kv': w_kv, 'w_q': w_q, 'w_o': w_o, 'ffn_w_up': ffn_w_up,
            'ffn_conv_w': ffn_conv_w, 'ffn_conv_b': ffn_conv_b, 'ffn_w_down': ffn_w_down,
            'final_norm': final_norm}


def reference(x_prompt, x_sample, state_ssm, state_conv, state_ffn_conv, cache_k, cache_v,
              c_prompt, c_sample, ada_w, ada_b, norm_mix, norm_ffn, m_w_in, m_conv_w, m_conv_b,
              m_dt_bias, m_A_log, m_D, m_norm, m_w_out, kv_norm, kv_ada_w, kv_ada_b, w_kv, w_q, w_o,
              ffn_w_up, ffn_conv_w, ffn_conv_b, ffn_w_down, final_norm):
    p = dict(ada_w=ada_w, ada_b=ada_b, norm_mix=norm_mix, norm_ffn=norm_ffn, m_w_in=m_w_in,
             m_conv_w=m_conv_w, m_conv_b=m_conv_b, m_dt_bias=m_dt_bias, m_A_log=m_A_log, m_D=m_D,
             m_norm=m_norm, m_w_out=m_w_out, kv_norm=kv_norm, kv_ada_w=kv_ada_w, kv_ada_b=kv_ada_b,
             w_kv=w_kv, w_q=w_q, w_o=w_o, ffn_w_up=ffn_w_up, ffn_conv_w=ffn_conv_w,
             ffn_conv_b=ffn_conv_b, ffn_w_down=ffn_w_down, final_norm=final_norm)
    Bp, S, _ = x_prompt.shape
    Bs, T, _ = x_sample.shape
    ssm0 = jnp.zeros((N_A_LAYERS, Bp, M_HEADS, M_HEADDIM, M_D_STATE), state_ssm.dtype)
    conv0 = jnp.zeros((N_A_LAYERS, Bp, M_CONV - 1, M_CONV_DIM), x_prompt.dtype)
    ffn0 = jnp.zeros((DEPTH, Bp, FFN_CONV - 1, 2 * D_FF), x_prompt.dtype)
    y_p, ssm_p, conv_p, ffn_p, k_p, v_p = trunk(x_prompt, c_prompt, jnp.arange(S, dtype=jnp.int32),
                                                ssm0, conv0, ffn0, None, p)
    keep = min(WINDOW_MAX, S)
    k_p = k_p[:, S - keep:]
    v_p = v_p[:, S - keep:]
    pos_s = PAST_LEN + jnp.arange(T, dtype=jnp.int32)
    y_s, ssm_s, conv_s, ffn_s, k_s, v_s = trunk(x_sample, c_sample, pos_s, state_ssm, state_conv,
                                                state_ffn_conv, (cache_k, cache_v), p)
    return (y_p, y_s, ssm_p, ssm_s, conv_p, conv_s, ffn_p, ffn_s, k_p, k_s, v_p, v_s)
```

```cpp
#define PROBE_MASK 0x0u
#include <hip/hip_runtime.h>
#ifndef PROBE_FLAGS
#define PROBE_FLAGS 0
#endif
#include <cstdio>
#include <cstdint>
#include <cmath>
namespace pg8 {
#define PG8_LAS __attribute__((address_space(3)))
typedef unsigned short bf16_t;
typedef short bf16x8 __attribute__((ext_vector_type(8)));
typedef float f32x4 __attribute__((ext_vector_type(4)));
typedef unsigned u32x4 __attribute__((ext_vector_type(4)));
constexpr int BM = 256, BK = 64, HALF = 128, HTB = HALF * BK * 2  , STAGE_BYTES = 8 * HTB, NXCD = 8, WGM = 8;

__host__ __device__ __forceinline__ int lds_byte(int r, int c) { const int st = (r >> 4) * 2 + (c >> 5), rr = r & 15, cc = c & 31, ob = rr * 64 + cc * 2; return st * 1024 + (ob ^ (((ob >> 9) & 1) << 5)); }
__host__ __device__ __forceinline__ void stage_rc(int b, int& R, int& C) { const int st = b / 1024, sb = b % 1024, swz = sb ^ (((sb >> 9) & 1) << 5); R = (st >> 1) * 16 + swz / 64; C = (st & 1) * 32 + (swz % 64) / 2; }
__host__ __device__ __forceinline__ int perm32(int rho) { const int n = rho >> 4, i = rho & 15; return 8 * (i >> 2) + 4 * n + (i & 3); }

struct Unit { int pm, pn; };
struct Gemm { const bf16_t* A; const bf16_t* Bt; int M, N, K; int pf = 0; };

struct StaticOrder {
    int nM, nN, nwg, G, c;
    __host__ __device__ __forceinline__ void init(int M, int N, int G_, int c_) { nM = M / BM; nN = N / BM; nwg = nM * nN; G = G_; c = c_; }
    __host__ __device__ __forceinline__ bool next(int i, Unit& u) const {
        const long L = (long)i * G + c; if (L >= nwg) return false;
        int wgid = (int)L; { const int q = nwg / NXCD, r = nwg % NXCD, xcd = wgid % NXCD, off = wgid / NXCD; wgid = (xcd < r ? xcd * (q + 1) : r * (q + 1) + (xcd - r) * q) + off; }
        const int nig = WGM * nN, gid = wgid / nig, fm = gid * WGM, gsz = (nM - fm) < WGM ? (nM - fm) : WGM;
        u.pm = fm + ((wgid % nig) % gsz); u.pn = (wgid % nig) / gsz; return true;
    }
    __device__ __forceinline__ void a_ready(const Unit&) const {}
    __device__ __forceinline__ void done(const Unit&) const {}
};

__device__ __forceinline__ unsigned cvt_pk_bf16(float lo, float hi) { unsigned r; asm volatile("v_cvt_pk_bf16_f32 %0, %1, %2" : "=v"(r) : "v"(lo), "v"(hi)); return r; }
typedef float f32x2 __attribute__((ext_vector_type(2)));
typedef unsigned u32x2 __attribute__((ext_vector_type(2)));
__device__ __forceinline__ u32x4 pack8(const f32x4 a, const f32x4 b) { u32x4 w; w.x = cvt_pk_bf16(a[0], a[1]); w.y = cvt_pk_bf16(a[2], a[3]); w.z = cvt_pk_bf16(b[0], b[1]); w.w = cvt_pk_bf16(b[2], b[3]); return w; }
struct EpiBf16 {
    static constexpr bool PERM = true, AFTER_DRAIN = false;
    bf16_t* O; int ldc;
    __device__ __forceinline__ void operator()(const f32x4 (&acc)[2][2][4][2], const Unit& u, int wr, int wc, int fr, int fq) const {
        const int row0 = u.pm * BM + wr * 64 + fr, col0 = u.pn * BM + wc * 32 + 8 * fq;
#pragma unroll
        for (int ai = 0; ai < 2; ++ai)
#pragma unroll
            for (int m = 0; m < 4; ++m) { bf16_t* rowp = O + (size_t)(row0 + ai * HALF + m * 16) * ldc + col0;
#pragma unroll
                for (int bj = 0; bj < 2; ++bj) *(u32x4*)(rowp + bj * HALF) = pack8(acc[ai][bj][m][0], acc[ai][bj][m][1]); }
    }
};
#ifdef EPI_NT
#define EPI_ST(p, v) __builtin_nontemporal_store((v), (p))
#else
#define EPI_ST(p, v) (*(p) = (v))
#endif
struct EpiNull {
    static constexpr bool PERM = true, AFTER_DRAIN = false;
    float* sink;
    __device__ __forceinline__ void operator()(const f32x4 (&acc)[2][2][4][2], const Unit& u, int wr, int wc, int fr, int fq) const {
        float s = 0.f;
#pragma unroll
        for (int ai = 0; ai < 2; ++ai)
#pragma unroll
            for (int bj = 0; bj < 2; ++bj)
#pragma unroll
                for (int m = 0; m < 4; ++m)
#pragma unroll
                    for (int n = 0; n < 2; ++n) s += acc[ai][bj][m][n][0] + acc[ai][bj][m][n][1] + acc[ai][bj][m][n][2] + acc[ai][bj][m][n][3];
        if (s == 1.2345e-30f) sink[0] = s;
    }
};
struct EpiInProj {
    static constexpr bool PERM = true, AFTER_DRAIN = false;
    bf16_t* O; float* dtraw; bool skip;
    __device__ __forceinline__ void operator()(const f32x4 (&acc)[2][2][4][2], const Unit& u, int wr, int wc, int fr, int fq) const {
        if (skip) return;
        const int row0 = u.pm * BM + wr * 64 + fr, col0 = u.pn * BM + wc * 32 + 8 * fq;
#pragma unroll
        for (int ai = 0; ai < 2; ++ai)
#pragma unroll
            for (int m = 0; m < 4; ++m) { bf16_t* rowp = O + (size_t)(row0 + ai * HALF + m * 16) * 5120 + col0;
#pragma unroll
                for (int bj = 0; bj < 2; ++bj) EPI_ST((u32x4*)(rowp + bj * HALF), pack8(acc[ai][bj][m][0], acc[ai][bj][m][1])); }
    }
};
struct EpiResid {
    static constexpr bool PERM = true, AFTER_DRAIN = false;
    const float* inF; const bf16_t* inB; bf16_t* out; const float* gate;
    __device__ __forceinline__ void operator()(const f32x4 (&acc)[2][2][4][2], const Unit& u, int wr, int wc, int fr, int fq) const {
        const int col0 = u.pn * BM + wc * 32 + 8 * fq;
        f32x4 gv[2][2];
        { const float* g = gate + (size_t)(u.pm >> 5) * 6144 + col0;
#pragma unroll
          for (int bj = 0; bj < 2; ++bj)
#pragma unroll
              for (int n = 0; n < 2; ++n) gv[bj][n] = *(const f32x4*)(g + bj * HALF + 4 * n); }
#pragma unroll
        for (int ai = 0; ai < 2; ++ai) {
            if (inF != nullptr) {
#pragma unroll
                for (int mp = 0; mp < 2; ++mp) {
                    f32x4 bs[2][2][2];
#pragma unroll
                    for (int mm = 0; mm < 2; ++mm) { const int row = u.pm * BM + ai * HALF + wr * 64 + (2 * mp + mm) * 16 + fr; const float* ip = inF + (size_t)row * 1024 + col0;
#pragma unroll
                        for (int bj = 0; bj < 2; ++bj)
#pragma unroll
                            for (int n = 0; n < 2; ++n) bs[mm][bj][n] = *(const f32x4*)(ip + bj * HALF + 4 * n); }
#pragma unroll
                    for (int mm = 0; mm < 2; ++mm) { const int m = 2 * mp + mm, row = u.pm * BM + ai * HALF + wr * 64 + m * 16 + fr; bf16_t* op = out + (size_t)row * 1024 + col0;
#pragma unroll
                        for (int bj = 0; bj < 2; ++bj) *(u32x4*)(op + bj * HALF) = pack8(bs[mm][bj][0] + gv[bj][0] * acc[ai][bj][m][0], bs[mm][bj][1] + gv[bj][1] * acc[ai][bj][m][1]); }
                    asm volatile("" ::: "memory");
                }
            } else {
                u32x4 bb[4][2];
#pragma unroll
                for (int m = 0; m < 4; ++m) { const int row = u.pm * BM + ai * HALF + wr * 64 + m * 16 + fr; const bf16_t* ip = inB + (size_t)row * 1024 + col0;
#pragma unroll
                    for (int bj = 0; bj < 2; ++bj) bb[m][bj] = *(const u32x4*)(ip + bj * HALF); }
#pragma unroll
                for (int m = 0; m < 4; ++m) { const int row = u.pm * BM + ai * HALF + wr * 64 + m * 16 + fr; bf16_t* op = out + (size_t)row * 1024 + col0;
#pragma unroll
                    for (int bj = 0; bj < 2; ++bj) { const u32x4 w = bb[m][bj];
                        const f32x4 x0 = (f32x4){__builtin_bit_cast(float, w.x << 16), __builtin_bit_cast(float, w.x & 0xffff0000u), __builtin_bit_cast(float, w.y << 16), __builtin_bit_cast(float, w.y & 0xffff0000u)};
                        const f32x4 x1 = (f32x4){__builtin_bit_cast(float, w.z << 16), __builtin_bit_cast(float, w.z & 0xffff0000u), __builtin_bit_cast(float, w.w << 16), __builtin_bit_cast(float, w.w & 0xffff0000u)};
                        *(u32x4*)(op + bj * HALF) = pack8(x0 + gv[bj][0] * acc[ai][bj][m][0], x1 + gv[bj][1] * acc[ai][bj][m][1]); } }
            }
        }
    }
};
__device__ __forceinline__ f32x4 dpp_ror(const f32x4 v, const int n) {
    f32x4 r;
#pragma unroll
    for (int j = 0; j < 4; ++j) r[j] = n == 1 ? __builtin_bit_cast(float, __builtin_amdgcn_update_dpp(0, __float_as_int(v[j]), 0x121, 0xf, 0xf, false))
                                              : __builtin_bit_cast(float, __builtin_amdgcn_update_dpp(0, __float_as_int(v[j]), 0x122, 0xf, 0xf, false));
    return r;
}
__device__ __forceinline__ float silu_f(float x) { return x * __builtin_amdgcn_rcpf(1.0f + __expf(-x)); }
struct EpiUpConv {
    static constexpr bool PERM = true, AFTER_DRAIN = false;
    bf16_t* G; float* UB; const float* fw; const float* fb; float* ffnP; float* ffnS; const float* st; bool skip;
    __device__ __forceinline__ void operator()(const f32x4 (&acc)[2][2][4][2], const Unit& u, int wr, int wc, int fr, int fq) const {
        if (skip) return;
        const int cg0 = u.pn * 128 + wc * 32 + 8 * fq;
        const bool sample = u.pm >= 64;
        u32x2 held[2][4];
#pragma unroll
        for (int n = 0; n < 2; ++n) {
            const int ch = cg0 + 4 * n;
            f32x4 w[2][3], bs[2];
#pragma unroll
            for (int pt = 0; pt < 2; ++pt) { bs[pt] = *(const f32x4*)(fb + pt * 2816 + ch);
#pragma unroll
                for (int k = 0; k < 3; ++k) w[pt][k] = *(const f32x4*)(fw + k * 5632 + pt * 2816 + ch); }
#pragma unroll
            for (int ai = 0; ai < 2; ++ai)
#pragma unroll
                for (int m = 0; m < 4; ++m) {
                    int row = u.pm * BM + ai * HALF + wr * 64 + m * 16 + fr; asm volatile("" : "+v"(row));
                    f32x4 a[2];
#pragma unroll
                    for (int pt = 0; pt < 2; ++pt) {
                        const f32x4 cur = acc[ai][pt][m][n];
                        f32x4 p1, p2;
                        if (!sample) {
                            const f32x4 pv = acc[ai][pt][m > 0 ? m - 1 : 0][n];
#pragma unroll
                            for (int j = 0; j < 4; ++j) {
                                const int o1 = __builtin_amdgcn_update_dpp(0, __float_as_int(pv[j]), 0x121, 0xf, 0xf, false);
                                const int o2 = __builtin_amdgcn_update_dpp(0, __float_as_int(pv[j]), 0x122, 0xf, 0xf, false);
                                p1[j] = __builtin_bit_cast(float, __builtin_amdgcn_update_dpp(o1, __float_as_int(cur[j]), 0x111, 0xf, 0xf, false));
                                p2[j] = __builtin_bit_cast(float, __builtin_amdgcn_update_dpp(o2, __float_as_int(cur[j]), 0x112, 0xf, 0xf, false)); }
                        } else {
                            const int t = fr & 7, b = (row - 16384) >> 3; const float* sp = st + (size_t)b * 2 * 5632 + pt * 2816 + ch;
                            const f32x4 s0 = *(const f32x4*)sp, s1 = *(const f32x4*)(sp + 5632);
                            f32x4 c1, c2;
#pragma unroll
                            for (int j = 0; j < 4; ++j) {
                                c1[j] = __builtin_bit_cast(float, __builtin_amdgcn_update_dpp(0, __float_as_int(cur[j]), 0x111, 0xf, 0xf, false));
                                c2[j] = __builtin_bit_cast(float, __builtin_amdgcn_update_dpp(0, __float_as_int(cur[j]), 0x112, 0xf, 0xf, false)); }
                            p1 = t >= 1 ? c1 : s1; p2 = t >= 2 ? c2 : (t == 1 ? s1 : s0);
                        }
                        a[pt] = bs[pt] + w[pt][0] * p2 + w[pt][1] * p1 + w[pt][2] * cur;
                        if (!sample) { const int t = row & 8191;
                            if (t >= 8190) *(f32x4*)(ffnP + ((size_t)(row >> 13) * 2 + (t - 8190)) * 5632 + pt * 2816 + ch) = cur;
                            if ((m == 0 && fr < 2) || (m == 3 && fr >= 14)) *(f32x4*)(UB + ((size_t)(row >> 6) * 4 + (m == 0 ? fr : fr - 12)) * 5632 + pt * 2816 + ch) = cur;
                        } else { const int t = fr & 7, b = (row - 16384) >> 3;
                            if (t >= 6) *(f32x4*)(ffnS + ((size_t)b * 2 + (t - 6)) * 5632 + pt * 2816 + ch) = cur; }
                    }
                    if (sample || !(m == 0 && fr < 2)) {
                        u32x2 o; o.x = cvt_pk_bf16(silu_f(a[0][0]) * a[1][0], silu_f(a[0][1]) * a[1][1]); o.y = cvt_pk_bf16(silu_f(a[0][2]) * a[1][2], silu_f(a[0][3]) * a[1][3]);
                        if (n == 0) held[ai][m] = o; else *(u32x4*)(G + (size_t)row * 2816 + cg0) = (u32x4){held[ai][m].x, held[ai][m].y, o.x, o.y}; }
                    asm volatile("" ::: "memory");
                }
        }
    }
};
struct RopeCS { f32x4 v[4]; };
__device__ __forceinline__ RopeCS rope_load(const float* rp) { RopeCS r;
#pragma unroll
    for (int q = 0; q < 4; ++q) r.v[q] = *(const f32x4*)(rp + 4 * q);
    return r; }
__device__ __forceinline__ void rope8(const f32x4 (&a0)[2], const f32x4 (&a1)[2], const RopeCS& R, float sc, f32x4 (&o1)[2], f32x4 (&o2)[2]) {
#pragma unroll
    for (int n = 0; n < 2; ++n) { const f32x4 cs0 = R.v[2 * n], cs1 = R.v[2 * n + 1];
        const float c[4] = {cs0[0], cs0[2], cs1[0], cs1[2]}, s[4] = {cs0[1], cs0[3], cs1[1], cs1[3]};
#pragma unroll
        for (int j = 0; j < 4; ++j) { const float x1 = a0[n][j], x2 = a1[n][j]; o1[n][j] = (x1 * c[j] - x2 * s[j]) * sc; o2[n][j] = (x2 * c[j] + x1 * s[j]) * sc; } }
}
__device__ __forceinline__ int row_pos(int row) { return row < 16384 ? (row & 8191) : 8192 + ((row - 16384) & 7); }
struct EpiRopeKV {
    static constexpr bool PERM = true, AFTER_DRAIN = false;
    bf16_t* Kb; bf16_t* Vb; float* kP; float* kS; float* vP; float* vS; const float* rope;
    __device__ __forceinline__ void operator()(const f32x4 (&acc)[2][2][4][2], const Unit& u, int wr, int wc, int fr, int fq) const {
#pragma unroll
        for (int ai = 0; ai < 2; ++ai) {
            RopeCS R[4];
            if (u.pn < 12) {
#pragma unroll
                for (int m = 0; m < 4; ++m) R[m] = rope_load(rope + ((size_t)row_pos(u.pm * BM + ai * HALF + wr * 64 + m * 16 + fr) * 32 + 8 * fq) * 2); }
#pragma unroll
            for (int m = 0; m < 4; ++m) {
                const int rl = ai * HALF + wr * 64 + m * 16 + fr, row = u.pm * BM + rl;
                bool fo; size_t forow;
                if (u.pm < 64) { const int t = row & 8191; fo = t >= 6144; forow = (size_t)(row >> 13) * 2048 + (t - 6144); } else { fo = true; forow = (size_t)(row - 16384); }
                if (u.pn < 12) {
                    f32x4 o1[2], o2[2]; rope8(acc[ai][0][m], acc[ai][1][m], R[m], 1.0f, o1, o2);
                    const int colA = u.pn * BM + 64 * wc + 8 * fq;
                    bf16_t* kp = Kb + (size_t)row * 3072 + colA;
                    EPI_ST((u32x4*)kp, pack8(o1[0], o1[1])); EPI_ST((u32x4*)(kp + 32), pack8(o2[0], o2[1]));
                    if (fo) { float* f = ((u.pm < 64) ? kP : kS) + forow * 3072 + colA;
                        EPI_ST((f32x4*)f, o1[0]); EPI_ST((f32x4*)(f + 4), o1[1]); EPI_ST((f32x4*)(f + 32), o2[0]); EPI_ST((f32x4*)(f + 36), o2[1]); }
                } else {
#pragma unroll
                    for (int bj = 0; bj < 2; ++bj) { const int vcol = (u.pn - 12) * BM + bj * HALF + wc * 32 + 8 * fq;
                        EPI_ST((u32x4*)(Vb + (size_t)row * 3072 + vcol), pack8(acc[ai][bj][m][0], acc[ai][bj][m][1]));
                        if (fo) { float* f = ((u.pm < 64) ? vP : vS) + forow * 3072 + vcol; EPI_ST((f32x4*)f, acc[ai][bj][m][0]); EPI_ST((f32x4*)(f + 4), acc[ai][bj][m][1]); } }
                }
            }
        }
    }
};
struct EpiRopeQ {
    static constexpr bool PERM = true, AFTER_DRAIN = false;
    bf16_t* Qb; const float* rope; float qscale;
    __device__ __forceinline__ void operator()(const f32x4 (&acc)[2][2][4][2], const Unit& u, int wr, int wc, int fr, int fq) const {
#pragma unroll
        for (int ai = 0; ai < 2; ++ai) {
            RopeCS R[4];
#pragma unroll
            for (int m = 0; m < 4; ++m) R[m] = rope_load(rope + ((size_t)row_pos(u.pm * BM + ai * HALF + wr * 64 + m * 16 + fr) * 32 + 8 * fq) * 2);
#pragma unroll
            for (int m = 0; m < 4; ++m) {
                const int rl = ai * HALF + wr * 64 + m * 16 + fr, row = u.pm * BM + rl;
                f32x4 o1[2], o2[2]; rope8(acc[ai][0][m], acc[ai][1][m], R[m], qscale, o1, o2);
                bf16_t* qp = Qb + (size_t)row * 3072 + u.pn * BM + 64 * wc + 8 * fq;
                EPI_ST((u32x4*)qp, pack8(o1[0], o1[1])); EPI_ST((u32x4*)(qp + 32), pack8(o2[0], o2[1]));
            }
        }
    }
};

template <class Epi, class Sched, bool ALIGN_EPI = false, bool SP2 = false>
__device__ __forceinline__ void gemm_phase(PG8_LAS unsigned char* lds, const Gemm g, const Sched& S, const Epi& E, int tid_in) {
    int tid_ = tid_in; asm volatile("" : "+v"(tid_));
    const int tid = tid_, wid = __builtin_amdgcn_readfirstlane(tid >> 6), lane = tid & 63, wr = wid >> 2, wc = wid & 3, fr = lane & 15, fq = lane >> 4;
    const int K = g.K, nt = K / BK;
    unsigned voffA[2], voffB[2];
#pragma unroll
    for (int i = 0; i < 2; ++i) { int R, C; stage_rc(tid * 16 + i * 8192, R, C); const int Rb = Epi::PERM ? ((R & ~31) + perm32(R & 31)) : R;
        voffA[i] = (unsigned)(R * K + C) * 2u; voffB[i] = (unsigned)(Rb * K + C) * 2u; }
    const size_t kstep = (size_t)(BK * 2);
    const size_t hstep = (size_t)HALF * K * 2;
    const size_t tstep = 2 * hstep;
    const unsigned ldsw = (unsigned)wid * 1024u;
    const int aoff = lds_byte(wr * 64 + fr, fq * 8), boff = lds_byte(wc * 32 + fr, fq * 8);
#define PG8_SA(b, h) (((b) * 2 + (h)) * HTB)
#define PG8_SB(b, h) ((4 + (b) * 2 + (h)) * HTB)
#ifndef GEMM_B_AUX
#define GEMM_B_AUX 0
#endif
#ifndef GEMM_A_AUX
#define GEMM_A_AUX 0
#endif
#define PG8_STAGE(bufoff, gbase, voff) do { if ((bufoff) >= 4 * HTB) { _Pragma("unroll") for (int _i = 0; _i < 2; ++_i) \
        __builtin_amdgcn_global_load_lds((const unsigned*)((const char*)(gbase) + (voff)[_i]), (PG8_LAS unsigned*)(lds + (bufoff) + ldsw + _i * 8192), 16, 0, GEMM_B_AUX); } else { _Pragma("unroll") for (int _i = 0; _i < 2; ++_i) \
        __builtin_amdgcn_global_load_lds((const unsigned*)((const char*)(gbase) + (voff)[_i]), (PG8_LAS unsigned*)(lds + (bufoff) + ldsw + _i * 8192), 16, 0, GEMM_A_AUX); } } while (0)
#define PG8_LDA(dst, b, h) do { _Pragma("unroll") for (int m = 0; m < 4; ++m) _Pragma("unroll") for (int k = 0; k < 2; ++k) dst[m][k] = *(const PG8_LAS bf16x8*)(lds + PG8_SA(b, h) + aoff + m * 2048 + k * 1024); } while (0)
#define PG8_LDB(dst, b, h) do { _Pragma("unroll") for (int n = 0; n < 2; ++n) _Pragma("unroll") for (int k = 0; k < 2; ++k) dst[n][k] = *(const PG8_LAS bf16x8*)(lds + PG8_SB(b, h) + boff + n * 2048 + k * 1024); } while (0)
#define PG8_MMA(ai, bj, At, Bt) do { __builtin_amdgcn_s_setprio(1); _Pragma("unroll") for (int m = 0; m < 4; ++m) _Pragma("unroll") for (int n = 0; n < 2; ++n) _Pragma("unroll") for (int k = 0; k < 2; ++k) \
        acc[ai][bj][m][n] = __builtin_amdgcn_mfma_f32_16x16x32_bf16(Bt[n][k], At[m][k], acc[ai][bj][m][n], 0, 0, 0); __builtin_amdgcn_s_setprio(0); } while (0)
#if PROBE_FLAGS != 0
#define PG8_STAGE_P(bufoff, gbase, voff) do { if (!(g.pf & 1)) PG8_STAGE(bufoff, gbase, voff); } while (0)
#define PG8_LDA_P(dst, b, h) do { if (!(g.pf & 2)) PG8_LDA(dst, b, h); } while (0)
#define PG8_MMA_P(ai, bj, At, Bt) do { if (!(g.pf & 4)) PG8_MMA(ai, bj, At, Bt); } while (0)
#else
#define PG8_STAGE_P PG8_STAGE
#define PG8_LDA_P PG8_LDA
#define PG8_MMA_P PG8_MMA
#endif
#define PG8_WAIT_V(n) asm volatile("s_waitcnt vmcnt(" #n ")" ::: "memory")
#define PG8_WAIT_L(n) asm volatile("s_waitcnt lgkmcnt(" #n ")" ::: "memory")
#define PG8_BAR __builtin_amdgcn_s_barrier()
#define PG8_SCHED __builtin_amdgcn_sched_barrier(0)
    Unit cur, nxt; int ui = 0;
    if (!S.next(0, cur)) return;
    f32x4 acc[2][2][4][2];
#pragma unroll
    for (int a = 0; a < 2; ++a)
#pragma unroll
        for (int b = 0; b < 2; ++b)
#pragma unroll
            for (int m = 0; m < 4; ++m)
#pragma unroll
                for (int n = 0; n < 2; ++n) acc[a][b][m][n] = (f32x4){0.f, 0.f, 0.f, 0.f};
    bf16x8 At[4][2], B0[2][2], B1[2][2];
    const char* cA = (const char*)g.A + (size_t)cur.pm * tstep; const char* cB = (const char*)g.Bt + (size_t)cur.pn * tstep;
    S.a_ready(cur);
    if constexpr (SP2) {
        PG8_STAGE(PG8_SB(0, 0), cB, voffB); PG8_STAGE(PG8_SB(0, 1), cB + hstep, voffB); PG8_STAGE(PG8_SA(0, 0), cA, voffA); PG8_STAGE(PG8_SA(0, 1), cA + hstep, voffA);
        if (wr == 1) PG8_BAR;
        PG8_WAIT_V(2); PG8_BAR;
        PG8_STAGE(PG8_SB(1, 0), cB + kstep, voffB); PG8_STAGE(PG8_SA(1, 0), cA + kstep, voffA); PG8_STAGE(PG8_SB(1, 1), cB + hstep + kstep, voffB);
        PG8_WAIT_V(6); PG8_BAR;
    } else {
        PG8_STAGE(PG8_SB(0, 0), cB, voffB); PG8_STAGE(PG8_SA(0, 0), cA, voffA); PG8_STAGE(PG8_SB(0, 1), cB + hstep, voffB); PG8_STAGE(PG8_SA(0, 1), cA + hstep, voffA);
        if (wr == 1) PG8_BAR;
        PG8_WAIT_V(4); PG8_BAR;
        PG8_STAGE(PG8_SB(1, 0), cB + kstep, voffB); PG8_STAGE(PG8_SA(1, 0), cA + kstep, voffA); PG8_STAGE(PG8_SB(1, 1), cB + hstep + kstep, voffB);
        PG8_WAIT_V(6); PG8_BAR;
    }
    for (;;) {
        const bool has_next = S.next(ui + 1, nxt);
        const char* nA = has_next ? (const char*)g.A + (size_t)nxt.pm * tstep : cA; const char* nB = has_next ? (const char*)g.Bt + (size_t)nxt.pn * tstep : cB;
        for (int t = 0; t < nt; t += 2) {
            const bool last = (t == nt - 2);
            const char* a1 = cA + (size_t)(t + 1) * kstep;
            const char* a2 = last ? nA : cA + (size_t)(t + 2) * kstep; const char* b2 = last ? nB : cB + (size_t)(t + 2) * kstep;
            const char* a3 = a2 + kstep; const char* b3 = b2 + kstep;
            if (last && has_next) S.a_ready(nxt);
            if constexpr (SP2) {
            PG8_LDB(B0, 0, 0); PG8_LDB(B1, 0, 1); PG8_SCHED; PG8_LDA(At, 0, 0); PG8_STAGE_P(PG8_SA(1, 1), a1 + hstep, voffA);
            PG8_WAIT_V(8); PG8_WAIT_L(0); PG8_BAR; PG8_MMA_P(0, 0, At, B0); PG8_MMA_P(0, 1, At, B1); PG8_BAR; PG8_SCHED;
            PG8_LDA_P(At, 0, 1); PG8_STAGE_P(PG8_SB(0, 0), b2, voffB); PG8_STAGE_P(PG8_SB(0, 1), b2 + hstep, voffB); PG8_STAGE_P(PG8_SA(0, 0), a2, voffA);
            PG8_WAIT_V(8); PG8_WAIT_L(0); PG8_BAR; PG8_MMA_P(1, 0, At, B0); PG8_MMA_P(1, 1, At, B1); PG8_BAR; PG8_SCHED;
            PG8_LDB(B0, 1, 0); PG8_LDB(B1, 1, 1); PG8_SCHED; PG8_LDA(At, 1, 0); PG8_STAGE_P(PG8_SA(0, 1), a2 + hstep, voffA);
            PG8_WAIT_V(8); PG8_WAIT_L(0); PG8_BAR; PG8_MMA_P(0, 0, At, B0); PG8_MMA_P(0, 1, At, B1); PG8_BAR; PG8_SCHED;
            PG8_LDA_P(At, 1, 1); PG8_STAGE_P(PG8_SB(1, 0), b3, voffB); PG8_STAGE_P(PG8_SB(1, 1), b3 + hstep, voffB); PG8_STAGE_P(PG8_SA(1, 0), a3, voffA);
            PG8_WAIT_V(8); PG8_WAIT_L(0); PG8_BAR; PG8_MMA_P(1, 0, At, B0); PG8_MMA_P(1, 1, At, B1); PG8_BAR; PG8_SCHED;
            } else {
            PG8_LDB(B0, 0, 0); PG8_SCHED; PG8_LDA(At, 0, 0); PG8_STAGE(PG8_SA(1, 1), a1 + hstep, voffA);
            PG8_WAIT_L(8); PG8_BAR; PG8_WAIT_L(0); PG8_MMA(0, 0, At, B0); PG8_BAR; PG8_SCHED;
            PG8_LDB(B1, 0, 1); PG8_STAGE(PG8_SB(0, 0), b2, voffB);
            PG8_BAR; PG8_WAIT_L(0); PG8_MMA(0, 1, At, B1); PG8_BAR;
            PG8_LDA(At, 0, 1); PG8_STAGE(PG8_SA(0, 0), a2, voffA);
            PG8_BAR; PG8_WAIT_L(0); PG8_MMA(1, 0, At, B0); PG8_BAR; PG8_SCHED;
            PG8_STAGE(PG8_SB(0, 1), b2 + hstep, voffB);
            PG8_WAIT_V(6); PG8_BAR; PG8_MMA(1, 1, At, B1); PG8_BAR;
            PG8_LDB(B0, 1, 0); PG8_SCHED; PG8_LDA(At, 1, 0); PG8_STAGE(PG8_SA(0, 1), a2 + hstep, voffA);
            PG8_WAIT_L(8); PG8_BAR; PG8_WAIT_L(0); PG8_MMA(0, 0, At, B0); PG8_BAR; PG8_SCHED;
            PG8_LDB(B1, 1, 1); PG8_STAGE(PG8_SB(1, 0), b3, voffB);
            PG8_BAR; PG8_WAIT_L(0); PG8_MMA(0, 1, At, B1); PG8_BAR;
            PG8_LDA(At, 1, 1); PG8_STAGE(PG8_SA(1, 0), a3, voffA);
            PG8_BAR; PG8_WAIT_L(0); PG8_MMA(1, 0, At, B0); PG8_BAR; PG8_SCHED;
            PG8_STAGE(PG8_SB(1, 1), b3 + hstep, voffB);
            PG8_WAIT_V(6); PG8_BAR; PG8_MMA(1, 1, At, B1); PG8_BAR;
            }
        }
        if constexpr (ALIGN_EPI) { if (wr == 0) PG8_BAR; }
        if constexpr (!Epi::AFTER_DRAIN) { E(acc, cur, wr, wc, fr, fq); S.done(cur); }
        if (!has_next) break;
#pragma unroll
        for (int a = 0; a < 2; ++a)
#pragma unroll
            for (int b = 0; b < 2; ++b)
#pragma unroll
                for (int m = 0; m < 4; ++m)
#pragma unroll
                    for (int n = 0; n < 2; ++n) acc[a][b][m][n] = (f32x4){0.f, 0.f, 0.f, 0.f};
        cur = nxt; cA = nA; cB = nB; ++ui;
        if constexpr (ALIGN_EPI) { if (wr == 1) PG8_BAR; }
    }
    PG8_WAIT_V(0);
    if constexpr (!ALIGN_EPI) { if (wr == 0) PG8_BAR; }
    PG8_BAR;
    if constexpr (Epi::AFTER_DRAIN) { E.fused(acc, cur, wr, wc, fr, fq, lds, wid, lane); S.done(cur); }
#undef PG8_SA
#undef PG8_SB
#undef PG8_STAGE
#undef PG8_LDA
#undef PG8_LDB
#undef PG8_MMA
#undef PG8_WAIT_V
#undef PG8_WAIT_L
#undef PG8_BAR
#undef PG8_SCHED
}
}

constexpr int NWAVES = 8;
#ifndef MK_N_LAUNCHES
#define MK_N_LAUNCHES 1
#endif

constexpr int DM = 1024, TP = 8192, MP = 16384, SB = 32, ST = 8, MT = 16640, NSEQ = 34;
constexpr int INW = 5120, INPAD = 5376, NHEAD = 32, FF = 2816, FF2 = 5632, AW = 3072;
constexpr float EPS = 1e-6f;
constexpr float QSCALE = 0.125f * 1.4426950408889634f;
constexpr size_t O_YP = 0, O_YS = 16777216, O_SSMP = 17039360, O_SSMS = 18087936, O_CONVP = 34865152, O_CONVS = 34902016, O_FFNP = 35491840, O_FFNS = 35581952,
                 O_KP = 37023744, O_KS = 49606656, O_VP = 50393088, O_VS = 62976000, O_END = 63762432;
enum { I_XP = 0, I_XS, I_SSM, I_CONV, I_FFNC, I_CK, I_CV, I_CP, I_CS, I_ADAW, I_ADAB, I_NMIX, I_NFFN, I_WIN, I_CW, I_CB, I_DTB, I_ALOG, I_D, I_MNORM, I_WOUT, I_KVN, I_KVAW, I_KVAB, I_WKV, I_WQ, I_WO, I_WUP, I_FCW, I_FCB, I_WDN, I_FN };

constexpr size_t MiB = 1u << 20;
constexpr size_t al(size_t x) { return (x + MiB - 1) / MiB * MiB; }
constexpr size_t WS_CTL = 0, CTL_ZERO_BYTES = 1 * MiB;
constexpr size_t WS_MOD = 1 * MiB;
constexpr size_t WS_ROPE = WS_MOD + al((size_t)5 * NSEQ * 6144 * 4);
constexpr size_t WS_DTRAW = WS_ROPE + al((size_t)8200 * 32 * 8);
constexpr size_t WS_DTV = WS_DTRAW + al((size_t)MT * 32 * 4);
constexpr size_t WS_ACUM = WS_DTV + al((size_t)MT * 32 * 4);
constexpr size_t WS_DECAY = WS_ACUM + al((size_t)MT * 32 * 4);
constexpr size_t WS_WIN = WS_DECAY + MiB;
constexpr size_t WS_WOUT = WS_WIN + al((size_t)2 * INPAD * 1024 * 2);
constexpr size_t WS_WUP = WS_WOUT + al((size_t)2 * 1024 * 2048 * 2);
constexpr size_t WS_WDN = WS_WUP + al((size_t)4 * FF2 * 1024 * 2);
constexpr size_t WS_WKV = WS_WDN + al((size_t)4 * 1024 * FF * 2);
constexpr size_t WS_WQ = WS_WKV + al((size_t)6144 * 1024 * 2);
constexpr size_t WS_WO = WS_WQ + al((size_t)2 * AW * 1024 * 2);
constexpr size_t WS_H = WS_WO + al((size_t)2 * 1024 * 1024 * 2);
constexpr size_t WS_XN = WS_H + al((size_t)MT * 1024 * 4);
constexpr size_t WS_XNKV = WS_XN + al((size_t)MT * 1024 * 2);
constexpr size_t WS_BIG = WS_XNKV + al((size_t)MT * 1024 * 2);
constexpr size_t WS_ACT = WS_BIG + al((size_t)MT * FF2 * 2);
constexpr size_t WS_CT = WS_ACT + al((size_t)MT * 3072 * 2);
constexpr size_t WS_STATES = WS_CT + al((size_t)2 * 2560 * 8192 * 2);
constexpr size_t WS_HPREV = WS_STATES + al((size_t)2 * 64 * 32 * 8192 * 4);
constexpr size_t WS_Y = WS_HPREV + al((size_t)2 * 64 * 32 * 8192 * 2);
constexpr size_t WS_KB = WS_Y + al((size_t)MT * 2048 * 2);
constexpr size_t WS_VB = WS_KB + al((size_t)MT * AW * 2);
constexpr size_t WS_QB = WS_VB + al((size_t)MT * AW * 2);
constexpr size_t WS_VT = WS_QB + al((size_t)MT * AW * 2) + MiB;
constexpr size_t WS_OB = WS_VT + al((size_t)2 * 48 * 64 * 8192 * 2) + MiB;
constexpr size_t WS_OG = WS_OB + al((size_t)MT * 1024 * 2);
constexpr size_t WS_ML = WS_OG + al((size_t)3 * MT * 1024 * 2);
constexpr size_t WS_SLAB = WS_ML + al((size_t)3 * MT * 16 * 8);
constexpr size_t WS_UB = WS_SLAB + 4 * MiB;
constexpr size_t WS_END = WS_UB + al((size_t)256 * 4 * 5632 * 4);
constexpr int CW_TMO = 0, CW_CODE = 1, CW_BAR = 4096;

constexpr int RING_OFF = 0, RING_BYTES = 147456;
constexpr int LDSCTL_OFF = RING_BYTES, MISC_OFF = LDSCTL_OFF + 320;
constexpr int LDS_BYTES = RING_BYTES + 1024;

#define GAS __attribute__((address_space(1)))
#define LAS __attribute__((address_space(3)))
typedef unsigned short bf16;
typedef unsigned v4u __attribute__((ext_vector_type(4)));
typedef unsigned v2u __attribute__((ext_vector_type(2)));
typedef float f32x4 __attribute__((ext_vector_type(4)));
typedef float f32x2 __attribute__((ext_vector_type(2)));
typedef short bf16x8 __attribute__((ext_vector_type(8)));
typedef short s16x4 __attribute__((ext_vector_type(4)));
typedef GAS unsigned gu32;
#define RLX_AGENT __ATOMIC_RELAXED, __HIP_MEMORY_SCOPE_AGENT
#define LDS_WAIT() asm volatile("s_waitcnt lgkmcnt(0)" ::: "memory")
#define VM_WAIT() asm volatile("s_waitcnt vmcnt(0)" ::: "memory")
__device__ __forceinline__ int lane_id_v() { int l; asm volatile("v_mbcnt_lo_u32_b32 %0, -1, 0\n\tv_mbcnt_hi_u32_b32 %0, -1, %0" : "=v"(l)); return l; }
__device__ __forceinline__ unsigned f2bf(float f) { unsigned u = __builtin_bit_cast(unsigned, f); return (u + 0x7fffu + ((u >> 16) & 1u)) >> 16; }
__device__ __forceinline__ unsigned pk2(float lo, float hi) { unsigned r; asm("v_cvt_pk_bf16_f32 %0, %1, %2" : "=v"(r) : "v"(lo), "v"(hi)); return r; }
__device__ __forceinline__ float bflo(unsigned w) { return __builtin_bit_cast(float, w << 16); }
__device__ __forceinline__ float bfhi(unsigned w) { return __builtin_bit_cast(float, w & 0xffff0000u); }
__device__ __forceinline__ float bf2f(bf16 h) { return __builtin_bit_cast(float, (unsigned)h << 16); }
__device__ __forceinline__ float silu(float x) { return x * __builtin_amdgcn_rcpf(1.0f + __expf(-x)); }
__device__ __forceinline__ float softplus(float x) { const float y = __expf(x);
    return x > 20.f ? x : (y < 0.03125f ? y * (1.0f + y * (-0.5f + y * (0.33333334f + y * (-0.25f + y * 0.2f)))) : __logf(1.0f + y)); }
__device__ __forceinline__ float row16_sum(float x) {
    x += __builtin_bit_cast(float, __builtin_amdgcn_update_dpp(0, __builtin_bit_cast(int, x), 0x128, 0xf, 0xf, false));
    x += __builtin_bit_cast(float, __builtin_amdgcn_update_dpp(0, __builtin_bit_cast(int, x), 0x124, 0xf, 0xf, false));
    x += __builtin_bit_cast(float, __builtin_amdgcn_update_dpp(0, __builtin_bit_cast(int, x), 0x122, 0xf, 0xf, false));
    x += __builtin_bit_cast(float, __builtin_amdgcn_update_dpp(0, __builtin_bit_cast(int, x), 0x121, 0xf, 0xf, false));
    return x;
}
__device__ __forceinline__ float wave_sum(float v) {
#pragma unroll
    for (int o = 1; o < 64; o <<= 1) v += __shfl_xor(v, o);
    return v;
}
__device__ __forceinline__ float wave_max(float v) {
#pragma unroll
    for (int o = 1; o < 64; o <<= 1) v = fmaxf(v, __shfl_xor(v, o));
    return v;
}
template <int N> struct TR {
    static __device__ __forceinline__ float run(float (&v)[N], int lane) {
        constexpr int H = N / 2; float r[H];
        const bool up = (lane & H) != 0;
#pragma unroll
        for (int i = 0; i < H; ++i) { const float keep = up ? v[i + H] : v[i], send = up ? v[i] : v[i + H]; r[i] = keep + __shfl_xor(send, H); }
        return TR<H>::run(r, lane);
    }
};
template <> struct TR<1> { static __device__ __forceinline__ float run(float (&v)[1], int) { return v[0]; } };

#define XB_TMO      128
#define XB_XCNT(j)  (256  + 64 * (j))
#define XB_XSUB(j)  (1280 + 64 * (j))
#define XB_XGEN(j)  (2304 + 64 * (j))
#define XB_TOP      3328
#define XB_TOPGEN   3392
#define XCD_BAR_WORDS 3456
#define XB_SPIN_CAP (1u << 18)

__device__ __forceinline__ unsigned xb_ld(unsigned* p)              { return __hip_atomic_load(p, __ATOMIC_RELAXED, __HIP_MEMORY_SCOPE_AGENT); }
__device__ __forceinline__ unsigned xb_add(unsigned* p, unsigned v) { return __hip_atomic_fetch_add(p, v, __ATOMIC_RELAXED, __HIP_MEMORY_SCOPE_AGENT); }
__device__ __forceinline__ unsigned xb_xcc_id() { return (unsigned)__builtin_amdgcn_s_getreg((3 << 11) | 20) & 0xFu; }
#define XB_SPIN(cond, bar) do { unsigned _sp = 0; while (cond) { __builtin_amdgcn_s_sleep(1); \
    if ((++_sp & 255u) == 0u) { if (xb_ld(&(bar)[XB_TMO])) break; if (_sp > XB_SPIN_CAP) { atomicAdd(&(bar)[XB_TMO], 1u); break; } } } } while (0)

struct XcdBarrier {
    unsigned* bar; unsigned x;
    volatile LAS unsigned* st; int wave;
};

__device__ __forceinline__ XcdBarrier xcd_barrier_post(unsigned* bar, volatile LAS unsigned* st) {
    XcdBarrier b; b.bar = bar; b.x = xb_xcc_id(); b.st = st;
    if (threadIdx.x == 0) (void)xb_add(&bar[XB_XCNT(b.x)], 1u);
    return b;
}
__device__ __forceinline__ void xcd_barrier_complete(unsigned* bar, unsigned x, unsigned& nloc, unsigned& nx) {
    const unsigned G = gridDim.x * gridDim.y * gridDim.z;
    unsigned sum, cnt, mine, sp = 0u;
    for (;;) {
        sum = 0u; cnt = 0u; mine = 0u;
#pragma unroll
        for (unsigned j = 0; j < 16; ++j) { const unsigned c = xb_ld(&bar[XB_XCNT(j)]); sum += c; cnt += (c > 0u) ? 1u : 0u; mine = (j == x) ? c : mine; }
        if (sum == G) break;
        __builtin_amdgcn_s_sleep(1);
        if ((++sp & 255u) == 0u) { if (xb_ld(&bar[XB_TMO])) break; if (sp > XB_SPIN_CAP) { atomicAdd(&bar[XB_TMO], 1u); break; } }
    }
    nloc = mine > 0u ? mine : 1u; nx = cnt > 0u ? cnt : 1u;
}

__device__ __forceinline__ void xcd_barrier(const XcdBarrier& b) {
    asm volatile("s_waitcnt vmcnt(0)" ::: "memory");
    __syncthreads();
    if (b.wave == 0 && lane_id_v() == 0) {
        unsigned* bar = b.bar;
        __builtin_amdgcn_s_waitcnt(0);
        unsigned nloc = b.st[0], nx = b.st[1];
        if (nloc == 0u) { xcd_barrier_complete(bar, b.x, nloc, nx); b.st[0] = nloc; b.st[1] = nx; }
        const unsigned old = xb_add(&bar[XB_XSUB(b.x)], 1u);
        const unsigned gen = old / nloc;
        if (old + 1u == (gen + 1u) * nloc) {
            __builtin_amdgcn_fence(__ATOMIC_RELEASE, "agent");
            asm volatile("s_waitcnt vmcnt(0)" ::: "memory");
            const unsigned og = xb_add(&bar[XB_TOP], 1u);
            const unsigned tg = og / nx;
            if (og + 1u == (tg + 1u) * nx) xb_add(&bar[XB_TOPGEN], 1u);
            else XB_SPIN(xb_ld(&bar[XB_TOPGEN]) == tg, bar);
            __builtin_amdgcn_fence(__ATOMIC_ACQUIRE, "agent");
            xb_add(&bar[XB_XGEN(b.x)], 1u);
            asm volatile("s_waitcnt vmcnt(0)" ::: "memory");
        } else {
            XB_SPIN(xb_ld(&bar[XB_XGEN(b.x)]) == gen, bar);
            __builtin_amdgcn_fence(__ATOMIC_ACQUIRE, "agent");
            asm volatile("s_waitcnt vmcnt(0)" ::: "memory");
        }
    }
    __syncthreads();
}

struct Frame {
    LAS unsigned char* lds;
    volatile LAS unsigned* MISC;
    gu32* ctl;
    int tid, lane, wave, G, vcu, pflags;
    const float* const* in; float* out; unsigned char* ws;
};
#define WSP(T, off) ((T*)(F.ws + (off)))

struct TrJob { const float* src; bf16* dst; int ldw, K, n0, k0, mode; };
__device__ __forceinline__ TrJob tr_job(const float* W, int ldw, int col_base, int K, int ncols, bf16* WT, int mode, int item) {
    const int nblk = ncols / 32, kb = item / nblk, nb = item % nblk; TrJob j; j.k0 = 64 * kb; j.n0 = 32 * nb; j.src = W + (size_t)j.k0 * ldw + col_base + j.n0; j.dst = WT; j.ldw = ldw; j.K = K; j.mode = mode; return j;
}
__device__ __forceinline__ void tr_load(const TrJob& j, f32x4 (&buf)[8], int lane) {
    const int r8 = lane >> 3, c4 = lane & 7;
#pragma unroll
    for (int i = 0; i < 8; ++i) buf[i] = *(const f32x4*)(j.src + (size_t)(8 * i + r8) * j.ldw + 4 * c4);
}
__device__ __forceinline__ void tr_store(const TrJob& j, const f32x4 (&buf)[8], LAS float* scr, int lane) {
    const int r8 = lane >> 3, c4 = lane & 7;
#pragma unroll
    for (int i = 0; i < 8; ++i) *(LAS f32x4*)(scr + (8 * i + r8) * 36 + 4 * c4) = buf[i];
    LDS_WAIT();
    const int c = lane & 7;
#pragma unroll
    for (int jj = 0; jj < 4; ++jj) { const int n = (lane >> 3) + 8 * jj; const LAS float* s = scr + (8 * c) * 36 + n;
        v4u o; o.x = pk2(s[0 * 36], s[1 * 36]); o.y = pk2(s[2 * 36], s[3 * 36]); o.z = pk2(s[4 * 36], s[5 * 36]); o.w = pk2(s[6 * 36], s[7 * 36]);
        int dn = j.n0 + n; if (j.mode == 1) { const int sidx = dn & 255; dn = (dn & ~255) + ((sidx >> 5) & 1) * 128 + (sidx >> 6) * 32 + (sidx & 31); }
        else if (j.mode == 2) { const int part = dn >= 2816 ? 1 : 0, c = dn - part * 2816; dn = (c >> 7) * 256 + part * 128 + (c & 127); }
        *(v4u*)(j.dst + (size_t)dn * j.K + j.k0 + 8 * c) = o; }
    LDS_WAIT();
}
__device__ __forceinline__ TrJob p0_job(Frame& F, int it) {
    constexpr int I_IN = 16 * 161, I_OUT = 32 * 32, I_UP = 16 * 176, I_DN = 44 * 32, I_KV = 16 * 96, I_Q = 16 * 96, I_O = 16 * 32;
    int r = it;
    if (r < 2 * I_IN) { const int L = r / I_IN; return tr_job(F.in[I_WIN] + (size_t)L * 1024 * 5152, 5152, 0, 1024, 5152, WSP(bf16, WS_WIN) + (size_t)L * INPAD * 1024, 0, r % I_IN); } r -= 2 * I_IN;
    if (r < 2 * I_OUT) { const int L = r / I_OUT; return tr_job(F.in[I_WOUT] + (size_t)L * 2048 * 1024, 1024, 0, 2048, 1024, WSP(bf16, WS_WOUT) + (size_t)L * 1024 * 2048, 0, r % I_OUT); } r -= 2 * I_OUT;
    if (r < 4 * I_UP) { const int L = r / I_UP; return tr_job(F.in[I_WUP] + (size_t)L * 1024 * FF2, FF2, 0, 1024, FF2, WSP(bf16, WS_WUP) + (size_t)L * FF2 * 1024, 2, r % I_UP); } r -= 4 * I_UP;
    if (r < 4 * I_DN) { const int L = r / I_DN; return tr_job(F.in[I_WDN] + (size_t)L * FF * 1024, 1024, 0, FF, 1024, WSP(bf16, WS_WDN) + (size_t)L * 1024 * FF, 0, r % I_DN); } r -= 4 * I_DN;
    if (r < 2 * I_KV) { const int hv = r / I_KV; return tr_job(F.in[I_WKV], 6144, hv * 3072, 1024, 3072, WSP(bf16, WS_WKV) + (size_t)hv * 3072 * 1024, hv == 0 ? 1 : 0, r % I_KV); } r -= 2 * I_KV;
    if (r < 2 * I_Q) { const int L = r / I_Q; return tr_job(F.in[I_WQ] + (size_t)L * 1024 * AW, AW, 0, 1024, AW, WSP(bf16, WS_WQ) + (size_t)L * AW * 1024, 1, r % I_Q); } r -= 2 * I_Q;
    { const int L = r / I_O; return tr_job(F.in[I_WO] + (size_t)L * 1024 * 1024, 1024, 0, 1024, 1024, WSP(bf16, WS_WO) + (size_t)L * 1024 * 1024, 0, r % I_O); }
}
__device__ __forceinline__ void p0_weights(Frame& F) {
    LAS float* scr = (LAS float*)(F.lds + RING_OFF + F.wave * 16384);
    const int gw = F.vcu * NWAVES + F.wave, NGW = F.G * NWAVES, lane = F.lane;
    constexpr int NITEMS = 2 * 16 * 161 + 2 * 32 * 32 + 4 * 16 * 176 + 4 * 44 * 32 + 2 * 16 * 96 + 2 * 16 * 96 + 2 * 16 * 32;
    f32x4 bA[8], bB[8]; TrJob jA, jB;
    int it = gw;
    if (it < NITEMS) { jA = p0_job(F, it); tr_load(jA, bA, lane); }
#pragma unroll 1
    for (; it < NITEMS; it += 2 * NGW) {
        const bool hasB = it + NGW < NITEMS, hasA2 = it + 2 * NGW < NITEMS;
        if (hasB) { jB = p0_job(F, it + NGW); tr_load(jB, bB, lane); }
        tr_store(jA, bA, scr, lane);
        if (hasA2) { jA = p0_job(F, it + 2 * NGW); tr_load(jA, bA, lane); }
        if (hasB) tr_store(jB, bB, scr, lane);
    }
    const int gt = F.vcu * (NWAVES * 64) + F.tid, NGT = F.G * NWAVES * 64;
    for (int i = gt; i < 2 * 224 * 128; i += NGT) { const int L = i / (224 * 128), j = i % (224 * 128);
        *(v4u*)(WSP(bf16, WS_WIN) + (size_t)L * INPAD * 1024 + (size_t)5152 * 1024 + (size_t)j * 8) = (v4u){0u, 0u, 0u, 0u}; }
    for (int i = gt; i < 8200 * 32; i += NGT) { const int pos = i >> 5, k = i & 31;
        const float inv = (float)exp(-(double)k * (9.210340371976184 / 32.0)); const float ang = (float)pos * inv;
        float s, c; sincosf(ang, &s, &c); *(f32x2*)(WSP(float, WS_ROPE) + (size_t)i * 2) = (f32x2){c, s}; }
}
__device__ __forceinline__ void p0_adaln(Frame& F) {
    LAS float* cs = (LAS float*)(F.lds + RING_OFF);
    LAS float* ob = (LAS float*)(F.lds + RING_OFF + 512 * 34 * 4);
    const int tid = F.tid, cq = F.lane, kq = F.wave;
    for (int chunk = blockIdx.x; chunk < 208; chunk += F.G) {
        const int l = chunk < 192 ? chunk / 48 : 4, cc = chunk < 192 ? chunk % 48 : chunk - 192;
        const float* W = l < 4 ? F.in[I_ADAW] + (size_t)l * 1024 * 6144 : F.in[I_KVAW]; const int ldw = l < 4 ? 6144 : 2048, col0 = cc * 128;
        const float* bias = l < 4 ? F.in[I_ADAB] + l * 6144 : F.in[I_KVAB];
        f32x2 acc[NSEQ];
#pragma unroll
        for (int s = 0; s < NSEQ; ++s) acc[s] = (f32x2){0.f, 0.f};
#pragma unroll 1
        for (int hf = 0; hf < 2; ++hf) {
            __syncthreads();
            int t1 = tid; asm volatile("" : "+v"(t1));
            { float cv[NSEQ];
#pragma unroll
              for (int i = 0; i < NSEQ; ++i) { const int idx = t1 + i * (NWAVES * 64), k = idx / NSEQ, s = idx % NSEQ;
                  cv[i] = s < 2 ? F.in[I_CP][s * 1024 + hf * 512 + k] : F.in[I_CS][(s - 2) * 1024 + hf * 512 + k]; }
              __builtin_amdgcn_sched_barrier(0);
#pragma unroll
              for (int i = 0; i < NSEQ; ++i) cs[t1 + i * (NWAVES * 64)] = silu(cv[i]); }
            __syncthreads();
            f32x2 wn[8];
#pragma unroll
            for (int i = 0; i < 8; ++i) wn[i] = *(const f32x2*)(W + (size_t)(hf * 512 + kq * 64 + i) * ldw + col0 + 2 * cq);
#pragma unroll 1
            for (int kk0 = 0; kk0 < 64; kk0 += 8) {
                f32x2 wv[8];
#pragma unroll
                for (int i = 0; i < 8; ++i) wv[i] = wn[i];
                if (kk0 + 8 < 64) {
#pragma unroll
                    for (int i = 0; i < 8; ++i) wn[i] = *(const f32x2*)(W + (size_t)(hf * 512 + kq * 64 + kk0 + 8 + i) * ldw + col0 + 2 * cq); }
                __builtin_amdgcn_sched_barrier(0);
#pragma unroll
                for (int i = 0; i < 8; ++i) { const int k = kq * 64 + kk0 + i;
#pragma unroll
                    for (int s2 = 0; s2 < NSEQ / 2; ++s2) { const f32x2 a = *(const LAS f32x2*)(cs + k * NSEQ + 2 * s2); acc[2 * s2] += a.x * wv[i]; acc[2 * s2 + 1] += a.y * wv[i]; } }
                __builtin_amdgcn_sched_barrier(0); }
        }
#pragma unroll 1
        for (int w = 0; w < NWAVES; ++w) {
            if (F.wave == w) {
#pragma unroll
                for (int s = 0; s < NSEQ; ++s) { LAS f32x2* p = (LAS f32x2*)(ob + s * 128 + 2 * cq); if (w == 0) *p = acc[s]; else *p = *p + acc[s]; } }
            __syncthreads();
        }
        int t2 = tid; asm volatile("" : "+v"(t2));
        for (int idx = t2; idx < NSEQ * 128; idx += NWAVES * 64) { const int s = idx >> 7, c = idx & 127;
            WSP(float, WS_MOD)[((size_t)l * NSEQ + s) * 6144 + col0 + c] = ob[idx] + bias[col0 + c]; }
    }
    __syncthreads();
}

__device__ __forceinline__ const float* rowsrc(const float* P, const float* S, int m) { return m < MP ? P + (size_t)m * 1024 : S + (size_t)(m - MP) * 1024; }
__device__ __forceinline__ int row_seq(int m) { return m < MP ? (m >> 13) : 2 + ((m - MP) >> 3); }
__device__ __forceinline__ float load_row_rstd(const float* xrow, int lane, f32x4 (&v)[4]) {
    const f32x4* xr = (const f32x4*)xrow + lane; float s = 0.f;
#pragma unroll
    for (int j = 0; j < 4; ++j) { v[j] = xr[64 * j]; s += (v[j].x * v[j].x + v[j].y * v[j].y) + (v[j].z * v[j].z + v[j].w * v[j].w); }
    return 1.0f / sqrtf(wave_sum(s) * (1.f / 1024.f) + EPS);
}
__device__ __forceinline__ void store_mod_row(const f32x4 (&v)[4], float rstd, const float* g, const float* mrow, int sh, int sc, bf16* orow, int lane) {
    unsigned long long* o8 = (unsigned long long*)orow + lane;
    f32x4 gv[4], sv[4], hv[4];
#pragma unroll
    for (int j = 0; j < 4; ++j) { const int col = 4 * lane + 256 * j; gv[j] = *(const f32x4*)(g + col); sv[j] = *(const f32x4*)(mrow + sc + col); hv[j] = *(const f32x4*)(mrow + sh + col); }
    __builtin_amdgcn_sched_barrier(0);
#pragma unroll
    for (int j = 0; j < 4; ++j) { const f32x4 r = v[j] * rstd * gv[j] * (sv[j] + 1.0f) + hv[j];
        o8[64 * j] = (unsigned long long)pk2(r.x, r.y) | ((unsigned long long)pk2(r.z, r.w) << 32); }
}
__device__ __forceinline__ float load_row_ssq(const float* xrow, int lane, f32x4 (&v)[4]) {
    const f32x4* xr = (const f32x4*)xrow + lane; float s = 0.f;
#pragma unroll
    for (int j = 0; j < 4; ++j) { v[j] = xr[64 * j]; s += (v[j].x * v[j].x + v[j].y * v[j].y) + (v[j].z * v[j].z + v[j].w * v[j].w); }
    return s;
}
struct Pend { const float* slab; const float* gate; const float* in; float* hout; };
__device__ __forceinline__ float load_row_any(const Pend& pd, const float* P, const float* S, int m, int lane, f32x4 (&v)[4]) {
    if (pd.slab == nullptr || m < MP) return load_row_ssq(rowsrc(P, S, m), lane, v);
    const int r = m - MP; const float* gp = pd.gate + (size_t)(2 + (r >> 3)) * 6144; float s = 0.f;
    f32x4 p0[4], p1[4], p2[4], p3[4], xin[4], gt[4];
#pragma unroll
    for (int j = 0; j < 4; ++j) { const int col = 4 * lane + 256 * j; const size_t o = (size_t)r * 1024 + col;
        p0[j] = *(const f32x4*)(pd.slab + o); p1[j] = *(const f32x4*)(pd.slab + 262144 + o); p2[j] = *(const f32x4*)(pd.slab + 524288 + o); p3[j] = *(const f32x4*)(pd.slab + 786432 + o);
        xin[j] = *(const f32x4*)(pd.in + o); gt[j] = *(const f32x4*)(gp + col); }
    __builtin_amdgcn_sched_barrier(0);
#pragma unroll
    for (int j = 0; j < 4; ++j) { const int col = 4 * lane + 256 * j; const size_t o = (size_t)r * 1024 + col;
        const f32x4 p = (p0[j] + p1[j]) + (p2[j] + p3[j]);
        v[j] = xin[j] + gt[j] * p; *(f32x4*)(pd.hout + o) = v[j];
        s += (v[j].x * v[j].x + v[j].y * v[j].y) + (v[j].z * v[j].z + v[j].w * v[j].w); }
    return s;
}
struct ModV { f32x4 a[4], h[4]; };
__device__ __forceinline__ void modv_load(ModV& M, const float* g, const float* mrow, int sh, int sc, int lane) {
    f32x4 gv[4], sv[4];
#pragma unroll
    for (int j = 0; j < 4; ++j) { const int col = 4 * lane + 256 * j; gv[j] = *(const f32x4*)(g + col); sv[j] = *(const f32x4*)(mrow + sc + col); M.h[j] = *(const f32x4*)(mrow + sh + col); }
    __builtin_amdgcn_sched_barrier(0);
#pragma unroll
    for (int j = 0; j < 4; ++j) M.a[j] = gv[j] * (sv[j] + 1.0f);
}
template <bool BF> struct RowRaw;
template <> struct RowRaw<false> { f32x4 v[4];
    __device__ __forceinline__ void load(const void* base, int m, int lane) { const f32x4* xr = (const f32x4*)((const float*)base + (size_t)m * 1024) + lane;
#pragma unroll
        for (int j = 0; j < 4; ++j) v[j] = xr[64 * j]; }
    __device__ __forceinline__ void get(f32x4 (&f)[4]) const {
#pragma unroll
        for (int j = 0; j < 4; ++j) f[j] = v[j]; } };
template <> struct RowRaw<true> { v2u v[4];
    __device__ __forceinline__ void load(const void* base, int m, int lane) { const v2u* xr = (const v2u*)((const bf16*)base + (size_t)m * 1024) + lane;
#pragma unroll
        for (int j = 0; j < 4; ++j) v[j] = xr[64 * j]; }
    __device__ __forceinline__ void get(f32x4 (&f)[4]) const {
#pragma unroll
        for (int j = 0; j < 4; ++j) f[j] = (f32x4){bflo(v[j].x), bfhi(v[j].x), bflo(v[j].y), bfhi(v[j].y)}; } };
__device__ __forceinline__ float row_rstd(const f32x4 (&v)[4]) { float s = 0.f;
#pragma unroll
    for (int j = 0; j < 4; ++j) s += (v[j].x * v[j].x + v[j].y * v[j].y) + (v[j].z * v[j].z + v[j].w * v[j].w);
    return 1.0f / sqrtf(wave_sum(s) * (1.f / 1024.f) + EPS); }
__device__ __forceinline__ void store_modv_row(const f32x4 (&v)[4], float rstd, const ModV& M, bf16* orow, int lane) {
    unsigned long long* o8 = (unsigned long long*)orow + lane;
#pragma unroll
    for (int j = 0; j < 4; ++j) { const f32x4 r = v[j] * rstd * M.a[j] + M.h[j]; o8[64 * j] = (unsigned long long)pk2(r.x, r.y) | ((unsigned long long)pk2(r.z, r.w) << 32); }
}
template <int NOUT, bool BF>
__device__ __forceinline__ void norm_rows(Frame& F, const Pend pd, const void* P, const float* S, const float* g1, const float* mod1, int sh1, int sc1, bf16* out1, const float* g2, const float* mod2, int sh2, int sc2, bf16* out2) {
    const int gw = F.vcu * NWAVES + F.wave, NGW = F.G * NWAVES, lane = F.lane;
    if (NGW == 2048) {
        RowRaw<BF> va, vb;
        va.load(P, gw, lane); vb.load(P, gw + 2048, lane);
        ModV M1, M2;
#pragma unroll 1
        for (int i = 0; i < 4; ++i) {
            const int m = gw + 4096 * i;
            if ((i & 1) == 0) { modv_load(M1, g1, mod1 + (size_t)(i >> 1) * 6144, sh1, sc1, lane); if (NOUT == 2) modv_load(M2, g2, mod2 + (size_t)(i >> 1) * 6144, sh2, sc2, lane); }
            RowRaw<BF> na, nb;
            if (i < 3) { na.load(P, m + 4096, lane); nb.load(P, m + 6144, lane); }
            __builtin_amdgcn_sched_barrier(0);
            f32x4 fa[4], fb[4]; va.get(fa); vb.get(fb);
            const float ra = row_rstd(fa), rb = row_rstd(fb);
            store_modv_row(fa, ra, M1, out1 + (size_t)m * 1024, lane); store_modv_row(fb, rb, M1, out1 + (size_t)(m + 2048) * 1024, lane);
            if (NOUT == 2) { store_modv_row(fa, ra, M2, out2 + (size_t)m * 1024, lane); store_modv_row(fb, rb, M2, out2 + (size_t)(m + 2048) * 1024, lane); }
            __builtin_amdgcn_sched_barrier(0);
            if (i < 3) { va = na; vb = nb; }
        }
        if (F.wave == 0) { const int m = MP + F.vcu; f32x4 v[4]; const float rs = 1.0f / sqrtf(wave_sum(load_row_any(pd, S, S, m, lane, v)) * (1.f / 1024.f) + EPS); const int seq = row_seq(m);
            store_mod_row(v, rs, g1, mod1 + (size_t)seq * 6144, sh1, sc1, out1 + (size_t)m * 1024, lane);
            if (NOUT == 2) store_mod_row(v, rs, g2, mod2 + (size_t)seq * 6144, sh2, sc2, out2 + (size_t)m * 1024, lane); }
        return;
    }
    for (int m = gw; m < MT; m += NGW) { f32x4 v[4]; float rs;
        if (m < MP) { RowRaw<BF> r; r.load(P, m, lane); r.get(v); rs = row_rstd(v); }
        else rs = 1.0f / sqrtf(wave_sum(load_row_any(pd, S, S, m, lane, v)) * (1.f / 1024.f) + EPS);
        const int seq = row_seq(m);
        store_mod_row(v, rs, g1, mod1 + (size_t)seq * 6144, sh1, sc1, out1 + (size_t)m * 1024, lane);
        if (NOUT == 2) store_mod_row(v, rs, g2, mod2 + (size_t)seq * 6144, sh2, sc2, out2 + (size_t)m * 1024, lane); }
}
__device__ __forceinline__ void final_norm_phase(Frame& F, const Pend pd, const bf16* HB, const float* HSr, const float* g, float* out) {
    const int gw = F.vcu * NWAVES + F.wave, NGW = F.G * NWAVES, lane = F.lane;
    f32x4 gv[4];
#pragma unroll
    for (int j = 0; j < 4; ++j) gv[j] = *(const f32x4*)(g + 4 * lane + 256 * j);
    if (NGW == 2048) {
        RowRaw<true> va, vb;
        va.load(HB, gw, lane); vb.load(HB, gw + 2048, lane);
#pragma unroll 1
        for (int i = 0; i < 4; ++i) {
            const int m = gw + 4096 * i;
            RowRaw<true> na, nb;
            if (i < 3) { na.load(HB, m + 4096, lane); nb.load(HB, m + 6144, lane); }
            __builtin_amdgcn_sched_barrier(0);
            f32x4 fa[4], fb[4]; va.get(fa); vb.get(fb);
            const float ra = row_rstd(fa), rb = row_rstd(fb);
            f32x4* oa = (f32x4*)(out + (size_t)m * 1024) + lane; f32x4* ob = (f32x4*)(out + (size_t)(m + 2048) * 1024) + lane;
#pragma unroll
            for (int j = 0; j < 4; ++j) { oa[64 * j] = fa[j] * ra * gv[j]; ob[64 * j] = fb[j] * rb * gv[j]; }
            __builtin_amdgcn_sched_barrier(0);
            if (i < 3) { va = na; vb = nb; }
        }
        if (F.wave == 0) { const int m = MP + F.vcu; f32x4 v[4]; const float rstd = 1.0f / sqrtf(wave_sum(load_row_any(pd, HSr, HSr, m, lane, v)) * (1.f / 1024.f) + EPS);
            f32x4* o = (f32x4*)(out + (size_t)m * 1024) + lane;
#pragma unroll
            for (int j = 0; j < 4; ++j) o[64 * j] = v[j] * rstd * gv[j]; }
        return;
    }
    for (int m = gw; m < MT; m += NGW) { f32x4 v[4]; float rstd;
        if (m < MP) { RowRaw<true> r; r.load(HB, m, lane); r.get(v); rstd = row_rstd(v); }
        else rstd = 1.0f / sqrtf(wave_sum(load_row_any(pd, HSr, HSr, m, lane, v)) * (1.f / 1024.f) + EPS);
        f32x4* o = (f32x4*)(out + (size_t)m * 1024) + lane;
#pragma unroll
        for (int j = 0; j < 4; ++j) o[64 * j] = v[j] * rstd * gv[j]; }
}


__device__ __forceinline__ void unpack4(const v2u w, float (&x)[4]) { x[0] = bflo(w.x); x[1] = bfhi(w.x); x[2] = bflo(w.y); x[3] = bfhi(w.y); }
struct CvIn { v2u x[11]; f32x4 st[3]; f32x4 w[4], bias; };
__device__ __forceinline__ void cvm_load(Frame& F, int L, int u, int lane, CvIn& I) {
    const bf16* Z = WSP(bf16, WS_BIG); const float* st = F.in[I_CONV] + (size_t)L * 32 * 3 * 3072;
    const int rb = u / 48, cgp = u % 48, ch0 = cgp * 64 + 4 * (lane & 15), seg = lane >> 4, row0 = rb * 32 + seg * 8; const bool sample = rb >= 512;
#pragma unroll
    for (int r = 3; r < 11; ++r) I.x[r] = *(const v2u*)(Z + (size_t)(row0 + r - 3) * 5120 + 2048 + ch0);
    { const float* cw = F.in[I_CW] + (size_t)L * 4 * 3072; const float* cb = F.in[I_CB] + (size_t)L * 3072;
#pragma unroll
      for (int k = 0; k < 4; ++k) I.w[k] = *(const f32x4*)(cw + k * 3072 + ch0);
      I.bias = *(const f32x4*)(cb + ch0); }
    if (sample) { const int b = (row0 - MP) >> 3;
#pragma unroll
        for (int r = 0; r < 3; ++r) I.st[r] = *(const f32x4*)(st + ((size_t)b * 3 + r) * 3072 + ch0); }
    else if ((row0 & 8191) != 0) {
#pragma unroll
        for (int r = 0; r < 3; ++r) I.x[r] = *(const v2u*)(Z + (size_t)(row0 + r - 3) * 5120 + 2048 + ch0); }
    else {
#pragma unroll
        for (int r = 0; r < 3; ++r) I.x[r] = (v2u){0u, 0u}; }
}
__device__ __forceinline__ void cvm_compute(Frame& F, int L, int u, int lane, const CvIn& I) {
    bf16* A = WSP(bf16, WS_ACT); bf16* CT = WSP(bf16, WS_CT);
    const float* cw = F.in[I_CW] + (size_t)L * 4 * 3072; const float* cb = F.in[I_CB] + (size_t)L * 3072;
    float* convP = F.out + O_CONVP + (size_t)L * 2 * 3 * 3072; float* convS = F.out + O_CONVS + (size_t)L * 32 * 3 * 3072;
    const int rb = u / 48, cgp = u % 48, ch0 = cgp * 64 + 4 * (lane & 15), seg = lane >> 4, row0 = rb * 32 + seg * 8; const bool sample = rb >= 512;
    float xw[11][4];
#pragma unroll
    for (int r = 3; r < 11; ++r) unpack4(I.x[r], xw[r]);
    if (sample) {
#pragma unroll
        for (int r = 0; r < 3; ++r) { xw[r][0] = I.st[r].x; xw[r][1] = I.st[r].y; xw[r][2] = I.st[r].z; xw[r][3] = I.st[r].w; } }
    else {
#pragma unroll
        for (int r = 0; r < 3; ++r) unpack4(I.x[r], xw[r]); }
    f32x4 w[4];
#pragma unroll
    for (int k = 0; k < 4; ++k) w[k] = I.w[k];
    const f32x4 bias = I.bias;
    float o[8][4];
#pragma unroll
    for (int tt = 0; tt < 8; ++tt)
#pragma unroll
        for (int c = 0; c < 4; ++c) o[tt][c] = silu(bias[c] + w[0][c] * xw[tt][c] + w[1][c] * xw[tt + 1][c] + w[2][c] * xw[tt + 2][c] + w[3][c] * xw[tt + 3][c]);
    if (sample || cgp >= 32) {
#pragma unroll
        for (int tt = 0; tt < 8; ++tt) *(v2u*)(A + (size_t)(row0 + tt) * 3072 + ch0) = (v2u){pk2(o[tt][0], o[tt][1]), pk2(o[tt][2], o[tt][3])}; }
    if (!sample && cgp < 40) { const int b = row0 >> 13, t0 = row0 & 8191;
#pragma unroll
        for (int c = 0; c < 4; ++c) *(v4u*)(CT + (size_t)(b * 2560 + ch0 + c) * 8192 + t0) = (v4u){pk2(o[0][c], o[1][c]), pk2(o[2][c], o[3][c]), pk2(o[4][c], o[5][c]), pk2(o[6][c], o[7][c])}; }
    if (sample) { const int b = (row0 - MP) >> 3;
#pragma unroll
        for (int j = 0; j < 3; ++j) *(f32x4*)(convS + ((size_t)b * 3 + j) * 3072 + ch0) = (f32x4){xw[8 + j][0], xw[8 + j][1], xw[8 + j][2], xw[8 + j][3]}; }
    else if ((row0 & 8191) == 8184) { const int b = row0 >> 13;
#pragma unroll
        for (int j = 0; j < 3; ++j) *(f32x4*)(convP + ((size_t)b * 3 + j) * 3072 + ch0) = (f32x4){xw[8 + j][0], xw[8 + j][1], xw[8 + j][2], xw[8 + j][3]}; }
}
__device__ __forceinline__ void conv_mamba_phase(Frame& F, int L) {
    const int gw = F.vcu * NWAVES + F.wave, NGW = F.G * NWAVES, lane = F.lane; constexpr int NU = 520 * 48;
    CvIn A, B; int u = gw;
    if (u < NU) cvm_load(F, L, u, lane, A);
#pragma unroll 1
    for (; u < NU; u += 2 * NGW) {
        const bool hasB = u + NGW < NU, hasA2 = u + 2 * NGW < NU;
        if (hasB) cvm_load(F, L, u + NGW, lane, B);
        cvm_compute(F, L, u, lane, A);
        if (hasA2) cvm_load(F, L, u + 2 * NGW, lane, A);
        if (hasB) cvm_compute(F, L, u + NGW, lane, B);
    }
}
struct FfIn { v2u x[2][10]; f32x4 st[2][2]; };
__device__ __forceinline__ void cvf_load(Frame& F, int L, int u, int lane, FfIn& I) {
    const bf16* U = WSP(bf16, WS_BIG); const float* st = F.in[I_FFNC] + (size_t)L * 32 * 2 * FF2;
    const int rb = u / 44, cgp = u % 44, ch0 = cgp * 64 + 4 * (lane & 15), seg = lane >> 4, row0 = rb * 32 + seg * 8; const bool sample = rb >= 512;
#pragma unroll
    for (int part = 0; part < 2; ++part) { const int ch = ch0 + part * FF;
#pragma unroll
        for (int r = 2; r < 10; ++r) I.x[part][r] = *(const v2u*)(U + (size_t)(row0 + r - 2) * FF2 + ch);
        if (sample) { const int b = (row0 - MP) >> 3;
#pragma unroll
            for (int r = 0; r < 2; ++r) I.st[part][r] = *(const f32x4*)(st + ((size_t)b * 2 + r) * FF2 + ch); }
        else if ((row0 & 8191) != 0) {
#pragma unroll
            for (int r = 0; r < 2; ++r) I.x[part][r] = *(const v2u*)(U + (size_t)(row0 + r - 2) * FF2 + ch); }
        else {
#pragma unroll
            for (int r = 0; r < 2; ++r) I.x[part][r] = (v2u){0u, 0u}; } }
}
__device__ __forceinline__ void cvf_compute(Frame& F, int L, int u, int lane, const FfIn& I) {
    bf16* Gh = WSP(bf16, WS_ACT);
    const float* fw = F.in[I_FCW] + (size_t)L * 3 * FF2; const float* fb = F.in[I_FCB] + (size_t)L * FF2;
    float* ffnP = F.out + O_FFNP + (size_t)L * 2 * 2 * FF2; float* ffnS = F.out + O_FFNS + (size_t)L * 32 * 2 * FF2;
    const int rb = u / 44, cgp = u % 44, ch0 = cgp * 64 + 4 * (lane & 15), seg = lane >> 4, row0 = rb * 32 + seg * 8; const bool sample = rb >= 512;
    float og[8][4];
#pragma unroll
    for (int part = 0; part < 2; ++part) {
        const int ch = ch0 + part * FF;
        float xw[10][4];
#pragma unroll
        for (int r = 2; r < 10; ++r) unpack4(I.x[part][r], xw[r]);
        if (sample) {
#pragma unroll
            for (int r = 0; r < 2; ++r) { xw[r][0] = I.st[part][r].x; xw[r][1] = I.st[part][r].y; xw[r][2] = I.st[part][r].z; xw[r][3] = I.st[part][r].w; } }
        else {
#pragma unroll
            for (int r = 0; r < 2; ++r) unpack4(I.x[part][r], xw[r]); }
        f32x4 w[3];
#pragma unroll
        for (int k = 0; k < 3; ++k) w[k] = *(const f32x4*)(fw + k * FF2 + ch);
        const f32x4 bias = *(const f32x4*)(fb + ch);
#pragma unroll
        for (int tt = 0; tt < 8; ++tt)
#pragma unroll
            for (int c = 0; c < 4; ++c) { const float a = bias[c] + w[0][c] * xw[tt][c] + w[1][c] * xw[tt + 1][c] + w[2][c] * xw[tt + 2][c];
                if (part == 0) og[tt][c] = silu(a); else og[tt][c] *= a; }
        if (sample) { const int b = (row0 - MP) >> 3;
#pragma unroll
            for (int j = 0; j < 2; ++j) *(f32x4*)(ffnS + ((size_t)b * 2 + j) * FF2 + ch) = (f32x4){xw[8 + j][0], xw[8 + j][1], xw[8 + j][2], xw[8 + j][3]}; }
        else if ((row0 & 8191) == 8184) { const int b = row0 >> 13;
#pragma unroll
            for (int j = 0; j < 2; ++j) *(f32x4*)(ffnP + ((size_t)b * 2 + j) * FF2 + ch) = (f32x4){xw[8 + j][0], xw[8 + j][1], xw[8 + j][2], xw[8 + j][3]}; }
    }
#pragma unroll
    for (int tt = 0; tt < 8; ++tt) *(v2u*)(Gh + (size_t)(row0 + tt) * FF + ch0) = (v2u){pk2(og[tt][0], og[tt][1]), pk2(og[tt][2], og[tt][3])};
}
__device__ __forceinline__ void conv_ffn_phase(Frame& F, int L) {
    const int gw = F.vcu * NWAVES + F.wave, NGW = F.G * NWAVES, lane = F.lane; constexpr int NU = 520 * 44;
    FfIn A, B; int u = gw;
    if (u < NU) cvf_load(F, L, u, lane, A);
#pragma unroll 1
    for (; u < NU; u += 2 * NGW) {
        const bool hasB = u + NGW < NU, hasA2 = u + 2 * NGW < NU;
        if (hasB) cvf_load(F, L, u + NGW, lane, B);
        cvf_compute(F, L, u, lane, A);
        if (hasA2) cvf_load(F, L, u + 2 * NGW, lane, A);
        if (hasB) cvf_compute(F, L, u + NGW, lane, B);
    }
}

struct FxIn { f32x4 u0[2], u1[2], u2[2], b[2], w0[2], w1[2], w2[2]; };
__device__ __forceinline__ void fx_load(FxIn& I, const float* UB, const float* fw, const float* fb, int pm, int i) {
    const int ri = i / 704, cq = i % 704, ch = 4 * cq, k = ri & 1, row = pm * 256 + (ri >> 1) * 64 + k, blk = row >> 6, t = row & 8191;
#pragma unroll
    for (int pt = 0; pt < 2; ++pt) { const int c = pt * 2816 + ch; const f32x4 z4 = (f32x4){0.f, 0.f, 0.f, 0.f};
        I.u0[pt] = *(const f32x4*)(UB + ((size_t)blk * 4 + k) * 5632 + c);
        I.u1[pt] = k == 1 ? *(const f32x4*)(UB + ((size_t)blk * 4 + 0) * 5632 + c) : (t >= 1 ? *(const f32x4*)(UB + ((size_t)(blk - 1) * 4 + 3) * 5632 + c) : z4);
        I.u2[pt] = t >= 2 ? *(const f32x4*)(UB + ((size_t)(blk - 1) * 4 + (k == 1 ? 3 : 2)) * 5632 + c) : z4;
        I.b[pt] = *(const f32x4*)(fb + c); I.w0[pt] = *(const f32x4*)(fw + c); I.w1[pt] = *(const f32x4*)(fw + 5632 + c); I.w2[pt] = *(const f32x4*)(fw + 2 * 5632 + c); }
}
__device__ __forceinline__ void fx_store(const FxIn& I, bf16* Gh, int pm, int i) {
    const int ri = i / 704, cq = i % 704, ch = 4 * cq, k = ri & 1, row = pm * 256 + (ri >> 1) * 64 + k;
    f32x4 a[2];
#pragma unroll
    for (int pt = 0; pt < 2; ++pt) a[pt] = I.b[pt] + I.w0[pt] * I.u2[pt] + I.w1[pt] * I.u1[pt] + I.w2[pt] * I.u0[pt];
    *(v2u*)(Gh + (size_t)row * FF + ch) = (v2u){pk2(silu(a[0][0]) * a[1][0], silu(a[0][1]) * a[1][1]), pk2(silu(a[0][2]) * a[1][2], silu(a[0][3]) * a[1][3])};
}
__device__ __forceinline__ void ffn_fixup(Frame& F, int L, int pm) {
    const float* UB = WSP(float, WS_UB); bf16* Gh = WSP(bf16, WS_ACT);
    const float* fw = F.in[I_FCW] + (size_t)L * 3 * FF2; const float* fb = F.in[I_FCB] + (size_t)L * FF2;
    int i = F.tid;
#pragma unroll 1
    for (; i + NWAVES * 64 < 8 * 704; i += 2 * NWAVES * 64) { FxIn A, B; fx_load(A, UB, fw, fb, pm, i); fx_load(B, UB, fw, fb, pm, i + NWAVES * 64);
        __builtin_amdgcn_sched_barrier(0);
        fx_store(A, Gh, pm, i); fx_store(B, Gh, pm, i + NWAVES * 64);
        __builtin_amdgcn_sched_barrier(0); }
    if (i < 8 * 704) { FxIn A; fx_load(A, UB, fw, fb, pm, i); fx_store(A, Gh, pm, i); }
    VM_WAIT(); __syncthreads();
}

#define MFMA16(a, b, c) __builtin_amdgcn_mfma_f32_16x16x32_bf16((a), (b), (c), 0, 0, 0)
__device__ __forceinline__ void ssd_s1_phase(Frame& F, int L) {
    const float* dtraw = WSP(float, WS_DTRAW); float* dtv = WSP(float, WS_DTV); float* acum = WSP(float, WS_ACUM); float* decay = WSP(float, WS_DECAY);
    const bf16* CT = WSP(bf16, WS_CT); bf16* STS = WSP(bf16, WS_STATES);
    const int gw = F.vcu * NWAVES + F.wave, NGW = F.G * NWAVES, lane = F.lane, fr = lane & 15, fq = lane >> 4;
    const bool light = F.G == 256 && (int)blockIdx.x < 128;
    const int wv = (int)blockIdx.x * NWAVES + F.wave;
    const int ufirst = F.G == 256 ? (light ? wv : 1024 + (wv - 1024) * 3) : gw, ucnt = F.G == 256 ? (light ? 1 : 3) : 0;
    for (int ui = 0, u = ufirst; F.G == 256 ? ui < ucnt : u < 4096; ++ui, u = F.G == 256 ? ufirst + ui : u + NGW) {
        const int hd = u & 31, c = (u >> 5) & 63, b = u >> 11, g = hd >> 3;
        const float Aneg = -__expf(F.in[I_ALOG][L * 32 + hd]), dtb = F.in[I_DTB][L * 32 + hd];
        const int rowc = b * 8192 + c * 128, tc = c * 128;
        const float dt0 = softplus(dtraw[(size_t)(rowc + 2 * lane) * 32 + hd] + dtb), dt1 = softplus(dtraw[(size_t)(rowc + 2 * lane + 1) * 32 + hd] + dtb);
        const float a0 = dt0 * Aneg, a1 = dt1 * Aneg;
        float incl = a0 + a1;
#pragma unroll
        for (int o = 1; o < 64; o <<= 1) { const float t = __shfl_up(incl, o); if (lane >= o) incl += t; }
        const float excl = incl - (a0 + a1), ac0 = excl + a0, ac1 = ac0 + a1, total = __shfl(incl, 63);
        dtv[(size_t)(rowc + 2 * lane) * 32 + hd] = dt0; dtv[(size_t)(rowc + 2 * lane + 1) * 32 + hd] = dt1;
        acum[(size_t)(rowc + 2 * lane) * 32 + hd] = ac0; acum[(size_t)(rowc + 2 * lane + 1) * 32 + hd] = ac1;
        if (lane == 0) decay[(b * 64 + c) * 32 + hd] = __expf(total);
        const float w0 = dt0 * __expf(total - ac0), w1 = dt1 * __expf(total - ac1);
        f32x4 acc[8][4];
#pragma unroll
        for (int nt = 0; nt < 8; ++nt)
#pragma unroll
            for (int pt = 0; pt < 4; ++pt) acc[nt][pt] = (f32x4){0.f, 0.f, 0.f, 0.f};
        const bf16* CTb = CT + (size_t)b * 2560 * 8192 + tc;
#pragma unroll 1
        for (int ks = 0; ks < 4; ++ks) {
            float wv[8];
#pragma unroll
            for (int jp = 0; jp < 4; ++jp) { const int sl = 16 * ks + 4 * fq + jp; wv[2 * jp] = __shfl(w0, sl); wv[2 * jp + 1] = __shfl(w1, sl); }
            v4u raw[4]; bf16x8 a[8];
#pragma unroll
            for (int pt = 0; pt < 4; ++pt) raw[pt] = *(const v4u*)(CTb + (size_t)(hd * 64 + 16 * pt + fr) * 8192 + 32 * ks + 8 * fq);
#pragma unroll
            for (int nt = 0; nt < 8; ++nt) a[nt] = *(const bf16x8*)(CTb + (size_t)(2048 + g * 128 + 16 * nt + fr) * 8192 + 32 * ks + 8 * fq);
            __builtin_amdgcn_sched_barrier(0);
            bf16x8 xb[4];
#pragma unroll
            for (int pt = 0; pt < 4; ++pt) {
                v4u sc; sc.x = pk2(bflo(raw[pt].x) * wv[0], bfhi(raw[pt].x) * wv[1]); sc.y = pk2(bflo(raw[pt].y) * wv[2], bfhi(raw[pt].y) * wv[3]);
                sc.z = pk2(bflo(raw[pt].z) * wv[4], bfhi(raw[pt].z) * wv[5]); sc.w = pk2(bflo(raw[pt].w) * wv[6], bfhi(raw[pt].w) * wv[7]); xb[pt] = __builtin_bit_cast(bf16x8, sc); }
#pragma unroll
            for (int nt = 0; nt < 8; ++nt)
#pragma unroll
                for (int pt = 0; pt < 4; ++pt) acc[nt][pt] = MFMA16(a[nt], xb[pt], acc[nt][pt]);
            __builtin_amdgcn_sched_barrier(0);
        }
        bf16* sp = STS + (size_t)((b * 64 + c) * 32 + hd) * 8192;
#pragma unroll
        for (int nt = 0; nt < 8; ++nt)
#pragma unroll
            for (int pt = 0; pt < 4; ++pt) *(v2u*)(sp + (16 * pt + fr) * 128 + 16 * nt + 4 * fq) = (v2u){pk2(acc[nt][pt][0], acc[nt][pt][1]), pk2(acc[nt][pt][2], acc[nt][pt][3])};
    }
}
__device__ __forceinline__ void ssd_sample_phase(Frame& F, int L) {
    const float* dtraw = WSP(float, WS_DTRAW); const bf16* ACT = WSP(bf16, WS_ACT); const bf16* Z = WSP(bf16, WS_BIG); bf16* Y = WSP(bf16, WS_Y);
    LAS float* part = (LAS float*)(F.lds + RING_OFF);
    LAS float* yb = (LAS float*)(F.lds + RING_OFF + 4096 + F.wave * 2048);
    const int lane = F.lane;
    for (int u = blockIdx.x; u < 128; u += F.G) {
        const int b = u >> 2, g = u & 3, hd = 8 * g + F.wave;
        const float Aneg = -__expf(F.in[I_ALOG][L * 32 + hd]), dtb = F.in[I_DTB][L * 32 + hd], Dh = F.in[I_D][L * 32 + hd];
        const float dt_l = softplus(dtraw[(size_t)(MP + b * 8 + (lane & 7)) * 32 + hd] + dtb);
        const float* h0 = F.in[I_SSM] + ((size_t)(L * 32 + b) * 32 + hd) * 8192;
        float* hs = F.out + O_SSMS + ((size_t)(L * 32 + b) * 32 + hd) * 8192;
#pragma unroll 1
        for (int ph = 0; ph < 2; ++ph) {
            f32x2 h[32];
#pragma unroll
            for (int i = 0; i < 32; ++i) h[i] = *(const f32x2*)(h0 + (32 * ph + i) * 128 + 2 * lane);
            const bf16* arow = ACT + (size_t)(MP + b * 8) * 3072;
            float xl_n = bf2f(arow[hd * 64 + lane]); unsigned bw_n = *(const unsigned*)(arow + 2048 + g * 128 + 2 * lane), cw_n = *(const unsigned*)(arow + 2560 + g * 128 + 2 * lane);
#pragma unroll 1
            for (int t = 0; t < 8; ++t) {
                const float dt = __shfl(dt_l, t), dA = __expf(dt * Aneg);
                const float xl = xl_n; const unsigned bw = bw_n, cw = cw_n;
                if (t < 7) { const bf16* nrow = arow + (size_t)(t + 1) * 3072;
                    xl_n = bf2f(nrow[hd * 64 + lane]); bw_n = *(const unsigned*)(nrow + 2048 + g * 128 + 2 * lane); cw_n = *(const unsigned*)(nrow + 2560 + g * 128 + 2 * lane); }
                const float B0 = bflo(bw), B1 = bfhi(bw), C0 = bflo(cw), C1 = bfhi(cw);
                float yp[32];
#pragma unroll
                for (int i = 0; i < 32; ++i) { const float coef = dt * __shfl(xl, 32 * ph + i);
                    h[i].x = h[i].x * dA + coef * B0; h[i].y = h[i].y * dA + coef * B1; yp[i] = h[i].x * C0 + h[i].y * C1; }
                float y = TR<32>::run(yp, lane); y += __shfl_xor(y, 32);
                if (lane < 32) yb[t * 64 + 32 * ph + lane] = y;
            }
#pragma unroll
            for (int i = 0; i < 32; ++i) *(f32x2*)(hs + (32 * ph + i) * 128 + 2 * lane) = h[i];
        }
        LDS_WAIT();
        { float xs[8], zs[8];
#pragma unroll
          for (int t = 0; t < 8; ++t) { const size_t row = (size_t)(MP + b * 8 + t); xs[t] = bf2f(ACT[row * 3072 + hd * 64 + lane]); zs[t] = bf2f(Z[row * 5120 + hd * 64 + lane]); }
#pragma unroll
          for (int t = 0; t < 8; ++t) { const float y = yb[t * 64 + lane] + Dh * xs[t], yg = y * silu(zs[t]);
            yb[t * 64 + lane] = yg;
            const float ss = wave_sum(yg * yg); if (lane == 0) part[F.wave * 8 + t] = ss; } }
        LDS_WAIT();
        __syncthreads();
        const float nw = F.in[I_MNORM][L * 2048 + hd * 64 + lane];
#pragma unroll 1
        for (int t = 0; t < 8; ++t) { float tot = 0.f;
#pragma unroll
            for (int w = 0; w < 8; ++w) tot += part[w * 8 + t];
            const float rstd = 1.0f / sqrtf(tot * (1.f / 512.f) + EPS);
            Y[(size_t)(MP + b * 8 + t) * 2048 + hd * 64 + lane] = (bf16)f2bf(yb[t * 64 + lane] * rstd * nw); }
        LDS_WAIT();
        __syncthreads();
    }
}
__device__ __forceinline__ void ssd_s2_phase(Frame& F, int L) {
    const bf16* STS = WSP(bf16, WS_STATES); const float* decay = WSP(float, WS_DECAY); bf16* HP = WSP(bf16, WS_HPREV);
    const int gt = F.vcu * (NWAVES * 64) + F.tid, NGT = F.G * NWAVES * 64;
    for (int gi = gt; gi < 131072; gi += NGT) {
        const int nq = gi & 31, p = (gi >> 5) & 63, hd = (gi >> 11) & 31, b = gi >> 16;
        const size_t base = ((size_t)(b * 64) * 32 + hd) * 8192 + p * 128 + 4 * nq;
        f32x4 h = (f32x4){0.f, 0.f, 0.f, 0.f};
#pragma unroll 1
        for (int c0 = 0; c0 < 64; c0 += 16) {
            v2u sw[16]; float d[16];
#pragma unroll
            for (int i = 0; i < 16; ++i) { sw[i] = *(const v2u*)(STS + base + (size_t)(c0 + i) * 32 * 8192); d[i] = decay[(b * 64 + c0 + i) * 32 + hd]; }
            __builtin_amdgcn_sched_barrier(0);
#pragma unroll
            for (int i = 0; i < 16; ++i) { const f32x4 s = (f32x4){bflo(sw[i].x), bfhi(sw[i].x), bflo(sw[i].y), bfhi(sw[i].y)};
                *(v2u*)(HP + base + (size_t)(c0 + i) * 32 * 8192) = (v2u){pk2(h.x, h.y), pk2(h.z, h.w)}; h = h * d[i] + s; }
            __builtin_amdgcn_sched_barrier(0);
        }
        *(f32x4*)(F.out + O_SSMP + ((size_t)(L * 2 + b) * 32 + hd) * 8192 + p * 128 + 4 * nq) = h;
    }
}
__device__ __forceinline__ void ssd_s3_phase(Frame& F, int L) {
    const float* dtv = WSP(float, WS_DTV); const float* acum = WSP(float, WS_ACUM); const bf16* ACT = WSP(bf16, WS_ACT); const bf16* Z = WSP(bf16, WS_BIG);
    const bf16* CT = WSP(bf16, WS_CT); const bf16* HP = WSP(bf16, WS_HPREV); bf16* Y = WSP(bf16, WS_Y);
    LAS unsigned char* tB = F.lds + RING_OFF; LAS unsigned char* tC = tB + 32768;
    LAS float* sA = (LAS float*)(F.lds + RING_OFF + 65536 + F.wave * 1024); LAS float* sD = sA + 128;
    LAS float* part = (LAS float*)(F.lds + RING_OFF + 65536 + 8192);
    LAS unsigned char* zs = F.lds + RING_OFF + 77824 + F.wave * 8192;
    const int lane = F.lane, fr = lane & 15, fq = lane >> 4, tid = F.tid;
    const int srow = lane >> 2, sk = lane & 3;
    for (int u = blockIdx.x; u < 512; u += F.G) {
        const int g = u & 3, c = (u >> 2) & 63, b = u >> 8, hd = 8 * g + F.wave;
        const int rowc = b * 8192 + c * 128;
#pragma unroll
        for (int jj = 0; jj < 4; ++jj) { const int ci = tid + 512 * jj, row = ci >> 4, ch = ci & 15; const bf16* src = ACT + (size_t)(rowc + row) * 3072 + 2048 + g * 128 + 8 * ch;
            const v4u vb = *(const v4u*)src, vc = *(const v4u*)(src + 512); const int off = row * 256 + ((ch ^ (row & 15)) << 4);
            *(LAS v4u*)(tB + off) = vb; *(LAS v4u*)(tC + off) = vc; }
        *(LAS f32x2*)(sA + 2 * lane) = (f32x2){acum[(size_t)(rowc + 2 * lane) * 32 + hd], acum[(size_t)(rowc + 2 * lane + 1) * 32 + hd]};
        *(LAS f32x2*)(sD + 2 * lane) = (f32x2){dtv[(size_t)(rowc + 2 * lane) * 32 + hd], dtv[(size_t)(rowc + 2 * lane + 1) * 32 + hd]};
        LDS_WAIT(); __syncthreads();
        const float Dh = F.in[I_D][L * 32 + hd];
        const bf16* hb = HP + (size_t)((b * 64 + c) * 32 + hd) * 8192;
        const bf16* CTx = CT + (size_t)(b * 2560 + hd * 64) * 8192 + c * 128;
#pragma unroll 1
        for (int half = 0; half < 2; ++half) {
            bf16x8 hp[2][4], xf[4][2];
#pragma unroll
            for (int pt = 0; pt < 2; ++pt) {
#pragma unroll
                for (int ks = 0; ks < 4; ++ks) { if (F.pflags & 16) hp[pt][ks] = (bf16x8){0, 0, 0, 0, 0, 0, 0, 0}; else hp[pt][ks] = *(const bf16x8*)(hb + (32 * half + 16 * pt + fr) * 128 + 32 * ks + 8 * fq); }
#pragma unroll
                for (int k2 = 0; k2 < 4; ++k2) { const bf16* xp = CTx + (size_t)(32 * half + 16 * pt + fr) * 8192 + 32 * k2 + 4 * fq;
                    if (F.pflags & 8) xf[k2][pt] = (bf16x8){0, 0, 0, 0, 0, 0, 0, 0}; else {
                    const v2u lo = *(const v2u*)xp, hi = *(const v2u*)(xp + 16); xf[k2][pt] = __builtin_bit_cast(bf16x8, ((v4u){lo.x, lo.y, hi.x, hi.y})); } } }
            { v4u zz[8];
#pragma unroll
              for (int i = 0; i < 8; ++i) zz[i] = *(const v4u*)(Z + (size_t)(rowc + 16 * i + srow) * 5120 + hd * 64 + 32 * half + 8 * sk);
              __builtin_amdgcn_sched_barrier(0);
#pragma unroll
              for (int i = 0; i < 8; ++i) { const int row = 16 * i + srow; *(LAS v4u*)(zs + row * 64 + ((sk ^ ((row >> 1) & 3)) << 4)) = zz[i]; } }
            LDS_WAIT();
#pragma unroll 1
            for (int j = 0; j < ((F.pflags & 4) ? 0 : 8); ++j) {
                const int l = 16 * j + fr;
                const float al = sA[l];
                bf16x8 cf[4];
#pragma unroll
                for (int ks = 0; ks < 4; ++ks) cf[ks] = *(const LAS bf16x8*)(tC + l * 256 + (((4 * ks + fq) ^ (l & 15)) << 4));
                f32x4 ya[2], yo[2];
#pragma unroll
                for (int pt = 0; pt < 2; ++pt) { ya[pt] = (f32x4){0.f, 0.f, 0.f, 0.f}; yo[pt] = (f32x4){0.f, 0.f, 0.f, 0.f}; }
#pragma unroll
                for (int pt = 0; pt < 2; ++pt)
#pragma unroll
                    for (int ks = 0; ks < 4; ++ks) yo[pt] = MFMA16(hp[pt][ks], cf[ks], yo[pt]);
#pragma unroll
                for (int ks2 = 0; ks2 < 4; ++ks2) if (ks2 <= (j >> 1) && !(F.pflags & 1)) {
                    const int i0 = 2 * ks2, i1 = i0 + 1; const bool has1 = i1 <= j;
                    const int r0 = 16 * i0 + fr, r1 = 16 * i1 + fr;
                    f32x4 g0 = (f32x4){0.f, 0.f, 0.f, 0.f}, g1 = (f32x4){0.f, 0.f, 0.f, 0.f};
#pragma unroll
                    for (int ks = 0; ks < 4; ++ks) { const bf16x8 bf0 = *(const LAS bf16x8*)(tB + r0 * 256 + (((4 * ks + fq) ^ (r0 & 15)) << 4)); g0 = MFMA16(bf0, cf[ks], g0); }
                    if (has1) {
#pragma unroll
                        for (int ks = 0; ks < 4; ++ks) { const bf16x8 bf1 = *(const LAS bf16x8*)(tB + r1 * 256 + (((4 * ks + fq) ^ (r1 & 15)) << 4)); g1 = MFMA16(bf1, cf[ks], g1); } }
                    const f32x4 sa0 = *(const LAS f32x4*)(sA + 16 * i0 + 4 * fq), sd0 = *(const LAS f32x4*)(sD + 16 * i0 + 4 * fq);
                    const f32x4 sa1 = *(const LAS f32x4*)(sA + 16 * i1 + 4 * fq), sd1 = *(const LAS f32x4*)(sD + 16 * i1 + 4 * fq);
                    float m0[4], m1[4];
#pragma unroll
                    for (int r = 0; r < 4; ++r) { const int s0 = 16 * i0 + 4 * fq + r, s1 = 16 * i1 + 4 * fq + r;
                        m0[r] = (s0 <= l) ? g0[r] * __expf(al - sa0[r]) * sd0[r] : 0.f;
                        m1[r] = (has1 && s1 <= l) ? g1[r] * __expf(al - sa1[r]) * sd1[r] : 0.f;
                        if (s0 == l) m0[r] += Dh;
                        if (has1 && s1 == l) m1[r] += Dh; }
                    v4u mp; mp.x = pk2(m0[0], m0[1]); mp.y = pk2(m0[2], m0[3]); mp.z = pk2(m1[0], m1[1]); mp.w = pk2(m1[2], m1[3]);
                    const bf16x8 mf = __builtin_bit_cast(bf16x8, mp);
#pragma unroll
                    for (int pt = 0; pt < 2; ++pt) ya[pt] = MFMA16(xf[ks2][pt], mf, ya[pt]);
                }
                const float el = __expf(al);
                float ssq = 0.f;
#pragma unroll
                for (int pt = 0; pt < 2; ++pt) {
                    LAS v2u* zp = (LAS v2u*)(zs + l * 64 + (((2 * pt + (fq >> 1)) ^ ((l >> 1) & 3)) << 4) + 8 * (fq & 1));
                    float zv[4]; unpack4(*zp, zv);
                    float yg[4];
#pragma unroll
                    for (int r = 0; r < 4; ++r) { const float y = ya[pt][r] + el * yo[pt][r]; yg[r] = y * silu(zv[r]); ssq += yg[r] * yg[r]; }
                    *zp = (v2u){pk2(yg[0], yg[1]), pk2(yg[2], yg[3])}; }
                ssq += __shfl_xor(ssq, 16); ssq += __shfl_xor(ssq, 32);
                if (fq == 0) { if (half == 0) part[F.wave * 128 + l] = ssq; else part[F.wave * 128 + l] += ssq; }
            }
            LDS_WAIT();
            { v4u yy[8];
#pragma unroll
              for (int i = 0; i < 8; ++i) { const int row = 16 * i + srow; yy[i] = *(const LAS v4u*)(zs + row * 64 + ((sk ^ ((row >> 1) & 3)) << 4)); }
#pragma unroll
              for (int i = 0; i < 8; ++i) *(v4u*)(Y + (size_t)(rowc + 16 * i + srow) * 2048 + hd * 64 + 32 * half + 8 * sk) = yy[i]; }
        }
        VM_WAIT(); LDS_WAIT();
        __syncthreads();
        if (!(F.pflags & 2)) {
        v4u yy[2][8]; f32x4 nw[2][2];
#pragma unroll
        for (int half = 0; half < 2; ++half) {
#pragma unroll
            for (int i = 0; i < 8; ++i) yy[half][i] = *(const v4u*)(Y + (size_t)(rowc + 16 * i + srow) * 2048 + hd * 64 + 32 * half + 8 * sk);
#pragma unroll
            for (int q = 0; q < 2; ++q) nw[half][q] = *(const f32x4*)(F.in[I_MNORM] + L * 2048 + hd * 64 + 32 * half + 8 * sk + 4 * q); }
        __builtin_amdgcn_sched_barrier(0);
#pragma unroll
        for (int i = 0; i < 8; ++i) {
            const int l = 16 * i + srow;
            float tot = 0.f;
#pragma unroll
            for (int w = 0; w < 8; ++w) tot += part[w * 128 + l];
            const float rstd = 1.0f / sqrtf(tot * (1.f / 512.f) + EPS);
#pragma unroll
            for (int half = 0; half < 2; ++half) { const v4u v = yy[half][i]; const f32x4 w0 = nw[half][0] * rstd, w1 = nw[half][1] * rstd;
                *(v4u*)(Y + (size_t)(rowc + l) * 2048 + hd * 64 + 32 * half + 8 * sk) =
                    (v4u){pk2(bflo(v.x) * w0.x, bfhi(v.x) * w0.y), pk2(bflo(v.y) * w0.z, bfhi(v.y) * w0.w), pk2(bflo(v.z) * w1.x, bfhi(v.z) * w1.y), pk2(bflo(v.w) * w1.z, bfhi(v.w) * w1.w)}; }
        }
        }
        LDS_WAIT();
        __syncthreads();
    }
}


template <int NT, int KB>
__device__ __forceinline__ void sg_batch(const bf16* a0, const bf16* a1, const bf16* const (&bp)[NT], int k, f32x4 (&acc)[2][NT]) {
    bf16x8 af0[KB], af1[KB], bf[KB][NT];
#pragma unroll
    for (int i = 0; i < KB; ++i) { af0[i] = *(const bf16x8*)(a0 + k + 32 * i); af1[i] = *(const bf16x8*)(a1 + k + 32 * i);
#pragma unroll
        for (int ct = 0; ct < NT; ++ct) bf[i][ct] = *(const bf16x8*)(bp[ct] + k + 32 * i); }
    __builtin_amdgcn_sched_barrier(0);
#pragma unroll
    for (int i = 0; i < KB; ++i)
#pragma unroll
        for (int ct = 0; ct < NT; ++ct) { acc[0][ct] = MFMA16(bf[i][ct], af0[i], acc[0][ct]); acc[1][ct] = MFMA16(bf[i][ct], af1[i], acc[1][ct]); }
    __builtin_amdgcn_sched_barrier(0);
}
template <int NT, class CB, class EP>
__device__ __forceinline__ void sgemm_unit(const bf16* A, const bf16* Bt, int K, int kbeg, int kend, const CB& cb, const EP& ep, int wave, int lane) {
    const int fr = lane & 15, fq = lane >> 4;
    f32x4 acc[2][NT];
#pragma unroll
    for (int rt = 0; rt < 2; ++rt)
#pragma unroll
        for (int ct = 0; ct < NT; ++ct) acc[rt][ct] = (f32x4){0.f, 0.f, 0.f, 0.f};
    const bf16* a0 = A + (size_t)(32 * wave + fr) * K + 8 * fq; const bf16* a1 = a0 + (size_t)16 * K;
    const bf16* bp[NT];
#pragma unroll
    for (int ct = 0; ct < NT; ++ct) bp[ct] = Bt + (size_t)(cb(ct) + fr) * K + 8 * fq;
    constexpr int KB = NT >= 4 ? 4 : 8;
    int k = kbeg;
#pragma unroll 1
    for (; k + 32 * KB <= kend; k += 32 * KB) sg_batch<NT, KB>(a0, a1, bp, k, acc);
#pragma unroll 1
    for (; k + 64 <= kend; k += 64) sg_batch<NT, 2>(a0, a1, bp, k, acc);
    if (k < kend) sg_batch<NT, 1>(a0, a1, bp, k, acc);
    ep(acc, 32 * wave + fr, fq);
}
__device__ __forceinline__ v2u pack4(const f32x4 a) { return (v2u){pk2(a[0], a[1]), pk2(a[2], a[3])}; }
#define SAMPLE_UNITS(u, NU, skip) for (int u = (int)F.G - 1 - (skip) - (int)blockIdx.x; u >= 0 && u < (NU); u += (int)F.G)

__device__ __forceinline__ void sg_inproj(Frame& F, int L) {
    const bf16* A = WSP(bf16, WS_XN) + (size_t)MP * 1024; const bf16* Bt = WSP(bf16, WS_WIN) + (size_t)L * INPAD * 1024;
    bf16* O = WSP(bf16, WS_BIG);
    SAMPLE_UNITS(u, 160, 0) { const int c0 = 32 * u;
        sgemm_unit<2>(A, Bt, 1024, 0, 1024, [&](int ct) { return c0 + 16 * ct; },
            [&](const f32x4 (&acc)[2][2], int rl, int fq) {
#pragma unroll
                for (int rt = 0; rt < 2; ++rt)
#pragma unroll
                    for (int ct = 0; ct < 2; ++ct) *(v2u*)(O + (size_t)(MP + rl + 16 * rt) * INW + c0 + 16 * ct + 4 * fq) = pack4(acc[rt][ct]); },
            F.wave, F.lane); }
}
__device__ __forceinline__ void sg_dt(Frame& F, int L) {
    const bf16* Bt = WSP(bf16, WS_WIN) + (size_t)L * INPAD * 1024; float* dtraw = WSP(float, WS_DTRAW);
    SAMPLE_UNITS(u, 65, 160) {
        sgemm_unit<2>(WSP(bf16, WS_XN) + (size_t)u * 256 * 1024, Bt, 1024, 0, 1024, [&](int ct) { return INW + 16 * ct; },
            [&](const f32x4 (&acc)[2][2], int rl, int fq) {
#pragma unroll
                for (int rt = 0; rt < 2; ++rt)
#pragma unroll
                    for (int ct = 0; ct < 2; ++ct) *(f32x4*)(dtraw + (size_t)(u * 256 + rl + 16 * rt) * 32 + 16 * ct + 4 * fq) = acc[rt][ct]; },
            F.wave, F.lane); }
}
__device__ __forceinline__ void sg_resid(Frame& F, const bf16* A, const bf16* Bt, int K) {
    float* slab = WSP(float, WS_SLAB);
    SAMPLE_UNITS(u, 256, 0) { const int c0 = 16 * (u & 63), kq = u >> 6, kl = K / 4;
        sgemm_unit<1>(A, Bt, K, kq * kl, (kq + 1) * kl, [&](int) { return c0; },
            [&](const f32x4 (&acc)[2][1], int rl, int fq) {
#pragma unroll
                for (int rt = 0; rt < 2; ++rt) *(f32x4*)(slab + ((size_t)kq * 256 + rl + 16 * rt) * 1024 + c0 + 4 * fq) = acc[rt][0]; },
            F.wave, F.lane); }
}
__device__ __forceinline__ void sg_rope_store(const f32x4 (&acc)[2][4], int rl, int fq, int T, int h4, const float* rope, float scale, bf16* Ob, float* Of) {
    f32x4 cs[2][2][2];
#pragma unroll
    for (int rt = 0; rt < 2; ++rt) { const int pos = 8192 + ((rl + 16 * rt) & 7);
#pragma unroll
        for (int ct = 0; ct < 2; ++ct) { const int i0 = 16 * ct + 4 * fq; cs[rt][ct][0] = *(const f32x4*)(rope + ((size_t)pos * 32 + i0) * 2); cs[rt][ct][1] = *(const f32x4*)(rope + ((size_t)pos * 32 + i0) * 2 + 4); } }
    __builtin_amdgcn_sched_barrier(0);
#pragma unroll
    for (int rt = 0; rt < 2; ++rt) { const int r = rl + 16 * rt;
#pragma unroll
        for (int ct = 0; ct < 2; ++ct) { const int i0 = 16 * ct + 4 * fq, col = 256 * T + 64 * h4 + i0;
            const f32x4 cs0 = cs[rt][ct][0], cs1 = cs[rt][ct][1];
            const float c[4] = {cs0[0], cs0[2], cs1[0], cs1[2]}, s[4] = {cs0[1], cs0[3], cs1[1], cs1[3]};
            f32x4 o1, o2;
#pragma unroll
            for (int j = 0; j < 4; ++j) { const float x1 = acc[rt][ct][j], x2 = acc[rt][ct + 2][j]; o1[j] = (x1 * c[j] - x2 * s[j]) * scale; o2[j] = (x2 * c[j] + x1 * s[j]) * scale; }
            *(v2u*)(Ob + (size_t)(MP + r) * AW + col) = pack4(o1); *(v2u*)(Ob + (size_t)(MP + r) * AW + col + 32) = pack4(o2);
            if (Of) { *(f32x4*)(Of + (size_t)r * AW + col) = o1; *(f32x4*)(Of + (size_t)r * AW + col + 32) = o2; } } }
}
__device__ __forceinline__ void sg_kv(Frame& F) {
    const bf16* A = WSP(bf16, WS_XNKV) + (size_t)MP * 1024; const bf16* Bt = WSP(bf16, WS_WKV);
    SAMPLE_UNITS(u, 144, 0) {
        if (u < 48) { const int T = u >> 2, h4 = u & 3;
            sgemm_unit<4>(A, Bt, 1024, 0, 1024, [&](int ct) { return 256 * T + 128 * (ct >> 1) + 32 * h4 + 16 * (ct & 1); },
                [&](const f32x4 (&acc)[2][4], int rl, int fq) { sg_rope_store(acc, rl, fq, T, h4, WSP(float, WS_ROPE), 1.0f, WSP(bf16, WS_KB), F.out + O_KS); }, F.wave, F.lane);
        } else { const int c0 = 32 * (u - 48);
            sgemm_unit<2>(A, Bt + (size_t)3072 * 1024, 1024, 0, 1024, [&](int ct) { return c0 + 16 * ct; },
                [&](const f32x4 (&acc)[2][2], int rl, int fq) {
#pragma unroll
                    for (int rt = 0; rt < 2; ++rt)
#pragma unroll
                        for (int ct = 0; ct < 2; ++ct) { const int r = rl + 16 * rt, col = c0 + 16 * ct + 4 * fq;
                            *(v2u*)(WSP(bf16, WS_VB) + (size_t)(MP + r) * AW + col) = pack4(acc[rt][ct]); *(f32x4*)(F.out + O_VS + (size_t)r * AW + col) = acc[rt][ct]; } },
                F.wave, F.lane); }
    }
}
__device__ __forceinline__ void sg_q(Frame& F, int LB, int skip) {
    const bf16* A = WSP(bf16, WS_XN) + (size_t)MP * 1024; const bf16* Bt = WSP(bf16, WS_WQ) + (size_t)LB * AW * 1024;
    SAMPLE_UNITS(u, 48, skip) { const int T = u >> 2, h4 = u & 3;
        sgemm_unit<4>(A, Bt, 1024, 0, 1024, [&](int ct) { return 256 * T + 128 * (ct >> 1) + 32 * h4 + 16 * (ct & 1); },
            [&](const f32x4 (&acc)[2][4], int rl, int fq) { sg_rope_store(acc, rl, fq, T, h4, WSP(float, WS_ROPE), QSCALE, WSP(bf16, WS_QB), nullptr); }, F.wave, F.lane); }
}

__device__ __forceinline__ void vt_phase(Frame& F) {
    const bf16* V = WSP(bf16, WS_VB); bf16* Vt = WSP(bf16, WS_VT);
    LAS unsigned* tile32 = (LAS unsigned*)(F.lds + RING_OFF + F.wave * 16384); LAS bf16* tile16 = (LAS bf16*)tile32;
    const int gw = F.vcu * NWAVES + F.wave, NGW = F.G * NWAVES, lane = F.lane;
    for (int u = gw; u < 2 * 48 * 128; u += NGW) {
        const int blk = u & 127, head = (u >> 7) % 48, b = u / (128 * 48);
        const int gsh = (head >> 4) * 2, dil = 1 << gsh, nsub = 8192 >> gsh, loc0 = blk * 64, r = loc0 / nsub, i0 = loc0 % nsub;
#pragma unroll
        for (int it = 0; it < 8; ++it) { const int tok = 8 * it + (lane >> 3), cg = lane & 7;
            const v4u val = *(const v4u*)(V + (size_t)(b * 8192 + dil * (i0 + tok) + r) * 3072 + head * 64 + 8 * cg);
            LAS unsigned* p = tile32 + tok * 33 + 4 * cg; p[0] = val.x; p[1] = val.y; p[2] = val.z; p[3] = val.w; }
        LDS_WAIT();
#pragma unroll
        for (int it = 0; it < 8; ++it) { const int d = 8 * it + (lane >> 3), ck = lane & 7;
            unsigned e[8];
#pragma unroll
            for (int k = 0; k < 8; ++k) e[k] = tile16[(8 * ck + k) * 66 + d];
            *(v4u*)(Vt + (size_t)((b * 48 + head) * 64 + d) * 8192 + r * nsub + i0 + 8 * ck) = (v4u){e[0] | (e[1] << 16), e[2] | (e[3] << 16), e[4] | (e[5] << 16), e[6] | (e[7] << 16)}; }
        LDS_WAIT();
    }
}
constexpr int AT_KBYTES = 256 * 128, AT_BUF = 2 * AT_KBYTES;
constexpr int AT_NS = 96;
struct AtPre { v4u k[4]; v4u v[4]; bf16x8 q[2]; };
__device__ __forceinline__ void at_decode(int u, int& b, int& head, int& gsh, int& r, int& i0) {
    const int run = u & 63; head = (u >> 6) % 48; b = u / (64 * 48); gsh = (head >> 4) * 2;
    const int nsub = 8192 >> gsh, loc0 = run * 128; r = loc0 / nsub; i0 = loc0 % nsub;
}
__device__ __forceinline__ void at_issue(AtPre& P, const bf16* Qb, const bf16* Kb, const bf16* Vb, int u, int tid) {
    int b, head, gsh, r, i0; at_decode(u, b, head, gsh, r, i0);
#pragma unroll
    for (int j = 0; j < 4; ++j) { const int c = tid + 512 * j, row = c >> 3, ch = c & 7; int si = i0 - 128 + row; si = si < 0 ? 0 : si;
        const size_t off = ((size_t)b * 8192 + ((size_t)si << gsh) + r) * 3072 + head * 64 + 8 * ch;
        P.k[j] = *(const v4u*)(Kb + off); P.v[j] = *(const v4u*)(Vb + off); }
    const int wave = tid >> 6, lane = tid & 63, fr = lane & 15, fq = lane >> 4;
    const size_t qrow = (size_t)b * 8192 + ((size_t)(i0 + 16 * wave + fr) << gsh) + r;
#pragma unroll
    for (int ks = 0; ks < 2; ++ks) P.q[ks] = *(const bf16x8*)(Qb + qrow * 3072 + head * 64 + 32 * ks + 8 * fq);
}
__device__ __forceinline__ void at_write(const AtPre& P, LAS unsigned char* buf, int tid) {
#pragma unroll
    for (int j = 0; j < 4; ++j) { const int c = tid + 512 * j, row = c >> 3, ch = c & 7; *(LAS v4u*)(buf + row * 128 + ((ch ^ (row & 7)) << 4)) = P.k[j]; }
#pragma unroll
    for (int j = 0; j < 4; ++j) { const int c = tid + 512 * j, row = c >> 3, ch = c & 7; *(LAS v4u*)(buf + AT_KBYTES + row * 128 + ((ch ^ (row & 7)) << 4)) = P.v[j]; }
}
__device__ __forceinline__ void at_compute(const LAS unsigned char* buf, const bf16x8 (&qf)[2], int u, int wave, int lane, bf16* Og, f32x2* ML) {
    int b, head, gsh, r, i0; at_decode(u, b, head, gsh, r, i0);
    const int fr = lane & 15, fq = lane >> 4;
    f32x4 s[9];
    { bf16x8 k0[9], k1[9];
#pragma unroll
      for (int kt = 0; kt < 9; ++kt) { const int row = 16 * wave + 16 * kt + fr;
          k0[kt] = *(const LAS bf16x8*)(buf + row * 128 + (((fq) ^ (row & 7)) << 4)); k1[kt] = *(const LAS bf16x8*)(buf + row * 128 + (((4 + fq) ^ (row & 7)) << 4)); }
      __builtin_amdgcn_sched_barrier(0);
#pragma unroll
      for (int kt = 0; kt < 9; ++kt) { s[kt] = MFMA16(k0[kt], qf[0], ((f32x4){0.f, 0.f, 0.f, 0.f})); s[kt] = MFMA16(k1[kt], qf[1], s[kt]); }
      __builtin_amdgcn_sched_barrier(0); }
    const int kbase = i0 - 128 + 16 * wave;
    float mx = -INFINITY;
#pragma unroll
    for (int kt = 0; kt < 9; ++kt)
#pragma unroll
        for (int rho = 0; rho < 4; ++rho) { const int kk = 16 * kt + 4 * fq + rho; const bool ok = kk >= fr && kk <= fr + 128 && (kbase + kk) >= 0;
            s[kt][rho] = ok ? s[kt][rho] : -INFINITY; mx = fmaxf(mx, s[kt][rho]); }
    mx = fmaxf(mx, __shfl_xor(mx, 16)); mx = fmaxf(mx, __shfl_xor(mx, 32));
    float ls = 0.f;
#pragma unroll
    for (int kt = 0; kt < 9; ++kt)
#pragma unroll
        for (int rho = 0; rho < 4; ++rho) { const float p = __builtin_amdgcn_exp2f(s[kt][rho] - mx); s[kt][rho] = p; ls += p; }
    ls += __shfl_xor(ls, 16); ls += __shfl_xor(ls, 32);
    f32x4 o[4];
#pragma unroll
    for (int dt = 0; dt < 4; ++dt) o[dt] = (f32x4){0.f, 0.f, 0.f, 0.f};
#pragma unroll
    for (int k5 = 0; k5 < 5; ++k5) {
        v4u pp; pp.x = pk2(s[2 * k5][0], s[2 * k5][1]); pp.y = pk2(s[2 * k5][2], s[2 * k5][3]);
        if (k5 < 4) { pp.z = pk2(s[2 * k5 + 1][0], s[2 * k5 + 1][1]); pp.w = pk2(s[2 * k5 + 1][2], s[2 * k5 + 1][3]); } else { pp.z = 0u; pp.w = 0u; }
        const bf16x8 pf = __builtin_bit_cast(bf16x8, pp);
        v2u lo[4], hi[4];
        const int vrow = 16 * wave + 32 * k5 + 4 * fq + (fr >> 2);
#pragma unroll
        for (int dt = 0; dt < 4; ++dt) { const int c16 = 2 * dt + ((fr & 3) >> 1), sub = 8 * (fr & 1);
            lo[dt] = __builtin_bit_cast(v2u, __builtin_amdgcn_ds_read_tr16_b64_v4i16((LAS s16x4*)(buf + AT_KBYTES + vrow * 128 + ((c16 ^ (vrow & 7)) << 4) + sub)));
            if (k5 < 4) hi[dt] = __builtin_bit_cast(v2u, __builtin_amdgcn_ds_read_tr16_b64_v4i16((LAS s16x4*)(buf + AT_KBYTES + (vrow + 16) * 128 + ((c16 ^ ((vrow + 16) & 7)) << 4) + sub)));
            else hi[dt] = (v2u){0u, 0u}; }
        __builtin_amdgcn_sched_barrier(0);
#pragma unroll
        for (int dt = 0; dt < 4; ++dt) o[dt] = MFMA16(__builtin_bit_cast(bf16x8, ((v4u){lo[dt].x, lo[dt].y, hi[dt].x, hi[dt].y})), pf, o[dt]);
    }
    const int g = head >> 4, hh = head & 15;
    const size_t row = (size_t)b * 8192 + ((size_t)(i0 + 16 * wave + fr) << gsh) + r;
    const float inv = 1.0f / ls;
    bf16* op = Og + ((size_t)g * MT + row) * 1024 + hh * 64 + 4 * fq;
#pragma unroll
    for (int dt = 0; dt < 4; ++dt) *(v2u*)(op + 16 * dt) = (v2u){pk2(o[dt][0] * inv, o[dt][1] * inv), pk2(o[dt][2] * inv, o[dt][3] * inv)};
    if (fq == 0) ML[((size_t)g * MT + row) * 16 + hh] = (f32x2){mx, ls};
}
__device__ __forceinline__ void attn_prompt_phase(Frame& F, int first, int nwg) {
    const bf16* Qb = WSP(bf16, WS_QB); const bf16* Kb = WSP(bf16, WS_KB); const bf16* Vt = WSP(bf16, WS_VB); bf16* Og = WSP(bf16, WS_OG); f32x2* ML = WSP(f32x2, WS_ML);
    const int me = (int)blockIdx.x - first;
    if (me < 0 || me >= nwg) return;
    AtPre P; int u = me; int par = 0;
    if (u < 6144) { at_issue(P, Qb, Kb, Vt, u, F.tid); at_write(P, F.lds + RING_OFF, F.tid); }
    bf16x8 qf[2] = {P.q[0], P.q[1]};
    LDS_WAIT(); __syncthreads();
    for (; u < 6144; u += nwg) {
        const int un = u + nwg;
        if (un < 6144) at_issue(P, Qb, Kb, Vt, un, F.tid);
        at_compute(F.lds + RING_OFF + par * AT_BUF, qf, u, F.wave, F.lane, Og, ML);
        if (un < 6144) { at_write(P, F.lds + RING_OFF + (par ^ 1) * AT_BUF, F.tid); qf[0] = P.q[0]; qf[1] = P.q[1]; }
        LDS_WAIT(); __syncthreads();
        par ^= 1;
    }
}
__device__ __forceinline__ void sa_load(f32x4 (&buf)[16], int jbase, const float* cache, const float* fresh, int b, int t, int gsh, int h0, int lane) {
#pragma unroll
    for (int jj = 0; jj < 16; ++jj) { int j = jbase + jj; j = j > 128 ? 128 : j; const int idx = 2048 + t - (j << gsh);
        const float* p = idx < 2048 ? cache + ((size_t)(b * 2048 + idx) * 48 + h0) * 64 : fresh + (size_t)(b * 8 + idx - 2048) * 3072 + h0 * 64;
        buf[jj] = *(const f32x4*)(p + 4 * lane); }
}
__device__ __forceinline__ void sa_score(const f32x4 (&buf)[16], int jbase, const float (&q4)[4], LAS float* sc, int hq, int dq) {
#pragma unroll
    for (int jj = 0; jj < 16; ++jj) { const float p = row16_sum((q4[0] * buf[jj].x + q4[1] * buf[jj].y) + (q4[2] * buf[jj].z + q4[3] * buf[jj].w));
        if (dq == 0 && jbase + jj < 129) sc[hq * 132 + jbase + jj] = p; }
}
__device__ __forceinline__ void sa_pv(const f32x4 (&buf)[16], int jbase, const LAS float* sc, int hq, f32x4& o) {
#pragma unroll
    for (int jj = 0; jj < 16; ++jj) { const float pj = (jbase + jj < 129) ? sc[hq * 132 + jbase + jj] : 0.f; o += pj * buf[jj]; }
}
__device__ __forceinline__ void attn_sample_phase(Frame& F, int first, int nwg) {
    const int me = (int)blockIdx.x - first;
    if (me < 0 || me >= nwg) return;
    const bf16* Qb = WSP(bf16, WS_QB); bf16* Og = WSP(bf16, WS_OG); f32x2* ML = WSP(f32x2, WS_ML);
    const float* ck = F.in[I_CK]; const float* cv = F.in[I_CV]; const float* kS = F.out + O_KS; const float* vS = F.out + O_VS;
    LAS float* sc = (LAS float*)(F.lds + RING_OFF + F.wave * 4096);
    const int lane = F.lane, hq = lane >> 4, dq = lane & 15;
    for (int u = me; u < 32 * 3 * 4; u += nwg) {
        const int hquad = u & 3, b = (u >> 2) & 31, g = u >> 7, gsh = 2 * g;
        const int t = F.wave, h0 = 16 * g + 4 * hquad;
        const size_t row = (size_t)(MP + b * 8 + t);
        float q4[4]; unpack4(*(const v2u*)(Qb + row * 3072 + h0 * 64 + 4 * lane), q4);
        f32x4 bA[16], bB[16];
        sa_load(bA, 0, ck, kS, b, t, gsh, h0, lane);
#pragma unroll 1
        for (int j0 = 0; j0 < 128; j0 += 32) {
            sa_load(bB, j0 + 16, ck, kS, b, t, gsh, h0, lane); sa_score(bA, j0, q4, sc, hq, dq);
            sa_load(bA, j0 + 32, ck, kS, b, t, gsh, h0, lane); sa_score(bB, j0 + 16, q4, sc, hq, dq);
        }
        sa_load(bB, 0, cv, vS, b, t, gsh, h0, lane);
        sa_score(bA, 128, q4, sc, hq, dq);
        LDS_WAIT();
        float sv[9]; float mx = -INFINITY;
#pragma unroll
        for (int i = 0; i < 9; ++i) { const int j = dq + 16 * i; sv[i] = j < 129 ? sc[hq * 132 + j] : -INFINITY; mx = fmaxf(mx, sv[i]); }
        mx = fmaxf(mx, __shfl_xor(mx, 1)); mx = fmaxf(mx, __shfl_xor(mx, 2)); mx = fmaxf(mx, __shfl_xor(mx, 4)); mx = fmaxf(mx, __shfl_xor(mx, 8));
        float ls = 0.f;
#pragma unroll
        for (int i = 0; i < 9; ++i) { sv[i] = __builtin_amdgcn_exp2f(sv[i] - mx); ls += sv[i]; }
        ls = row16_sum(ls);
        LDS_WAIT();
#pragma unroll
        for (int i = 0; i < 9; ++i) { const int j = dq + 16 * i; if (j < 129) sc[hq * 132 + j] = sv[i]; }
        LDS_WAIT();
        f32x4 o = (f32x4){0.f, 0.f, 0.f, 0.f};
#pragma unroll 1
        for (int j0 = 0; j0 < 128; j0 += 32) {
            sa_load(bA, j0 + 16, cv, vS, b, t, gsh, h0, lane); sa_pv(bB, j0, sc, hq, o);
            sa_load(bB, j0 + 32, cv, vS, b, t, gsh, h0, lane); sa_pv(bA, j0 + 16, sc, hq, o);
        }
        sa_pv(bB, 128, sc, hq, o);
        LDS_WAIT();
        const int hh = 4 * hquad + hq; const float inv = 1.0f / ls;
        *(v2u*)(Og + ((size_t)g * MT + row) * 1024 + hh * 64 + 4 * dq) = (v2u){pk2(o[0] * inv, o[1] * inv), pk2(o[2] * inv, o[3] * inv)};
        if (dq == 0) ML[((size_t)g * MT + row) * 16 + hh] = (f32x2){mx, ls};
    }
}
struct MgIn { f32x2 a0, a1, a2; v4u x0, x1, x2; };
__device__ __forceinline__ void mg_load(MgIn& I, const bf16* Og, const f32x2* ML, int i) { const int row = i >> 7, c8 = i & 127, hh = c8 >> 3;
    I.a0 = ML[((size_t)0 * MT + row) * 16 + hh]; I.a1 = ML[((size_t)1 * MT + row) * 16 + hh]; I.a2 = ML[((size_t)2 * MT + row) * 16 + hh];
    I.x0 = *(const v4u*)(Og + ((size_t)0 * MT + row) * 1024 + 8 * c8); I.x1 = *(const v4u*)(Og + ((size_t)1 * MT + row) * 1024 + 8 * c8); I.x2 = *(const v4u*)(Og + ((size_t)2 * MT + row) * 1024 + 8 * c8); }
__device__ __forceinline__ void mg_store(const MgIn& I, bf16* Ob, int i) { const int row = i >> 7, c8 = i & 127;
    const f32x2 a0 = I.a0, a1 = I.a1, a2 = I.a2; const v4u x0 = I.x0, x1 = I.x1, x2 = I.x2;
    const float M = fmaxf(a0.x, fmaxf(a1.x, a2.x));
    float w0 = __builtin_amdgcn_exp2f(a0.x - M) * a0.y, w1 = __builtin_amdgcn_exp2f(a1.x - M) * a1.y, w2 = __builtin_amdgcn_exp2f(a2.x - M) * a2.y;
    const float inv = 1.0f / (w0 + w1 + w2); w0 *= inv; w1 *= inv; w2 *= inv;
    v4u o;
    o.x = pk2(w0 * bflo(x0.x) + w1 * bflo(x1.x) + w2 * bflo(x2.x), w0 * bfhi(x0.x) + w1 * bfhi(x1.x) + w2 * bfhi(x2.x));
    o.y = pk2(w0 * bflo(x0.y) + w1 * bflo(x1.y) + w2 * bflo(x2.y), w0 * bfhi(x0.y) + w1 * bfhi(x1.y) + w2 * bfhi(x2.y));
    o.z = pk2(w0 * bflo(x0.z) + w1 * bflo(x1.z) + w2 * bflo(x2.z), w0 * bfhi(x0.z) + w1 * bfhi(x1.z) + w2 * bfhi(x2.z));
    o.w = pk2(w0 * bflo(x0.w) + w1 * bflo(x1.w) + w2 * bflo(x2.w), w0 * bfhi(x0.w) + w1 * bfhi(x1.w) + w2 * bfhi(x2.w));
    *(v4u*)(Ob + (size_t)row * 1024 + 8 * c8) = o; }
__device__ __forceinline__ void attn_merge_phase(Frame& F) {
    const bf16* Og = WSP(bf16, WS_OG); const f32x2* ML = WSP(f32x2, WS_ML); bf16* Ob = WSP(bf16, WS_OB);
    const int gt = F.vcu * (NWAVES * 64) + F.tid, NGT = F.G * NWAVES * 64;
    int i = gt;
#pragma unroll 1
    for (; i + 3 * NGT < MT * 128; i += 4 * NGT) { MgIn A, B, C, D; mg_load(A, Og, ML, i); mg_load(B, Og, ML, i + NGT); mg_load(C, Og, ML, i + 2 * NGT); mg_load(D, Og, ML, i + 3 * NGT);
        __builtin_amdgcn_sched_barrier(0);
        mg_store(A, Ob, i); mg_store(B, Ob, i + NGT); mg_store(C, Ob, i + 2 * NGT); mg_store(D, Ob, i + 3 * NGT);
        __builtin_amdgcn_sched_barrier(0); }
#pragma unroll 1
    for (; i < MT * 128; i += NGT) { MgIn A; mg_load(A, Og, ML, i); mg_store(A, Ob, i); }
}


constexpr int NPHASES = 38;
#ifndef PROBE_MASK
#define PROBE_MASK 0u
#endif
#ifdef PROBE_NULLEPI
#define PROBE_NULLEPI_ON 1
#else
#define PROBE_NULLEPI_ON 0
#endif
#ifndef PROBE_FLAGS
#define PROBE_FLAGS 0
#endif
#ifndef PROBE_SUB
#define PROBE_SUB 3
#endif
#ifndef PROBE_REPS
#define PROBE_REPS 2
#endif
#ifndef AUDIT_SUB
#define AUDIT_SUB 3
#endif
#ifndef AUDIT_SITES
#define AUDIT_SITES 0xffffffffu
#endif
struct Args { const float* in[32]; float* out; unsigned char* ws; int ph_lo, ph_hi, li, pad; };
__device__ __forceinline__ Frame phase_frame(const Frame& F0) {
    Frame F = F0; int tid = F0.wave * 64 + lane_id_v();
    F.tid = tid; F.lane = tid & 63; F.wave = __builtin_amdgcn_readfirstlane(tid >> 6);
    return F;
}
__global__ void __launch_bounds__(NWAVES * 64, 2) yoco_fwd(Args args) {
    extern __shared__ __attribute__((aligned(16))) unsigned char lds[];
    Frame F0;
    F0.lds = (LAS unsigned char*)lds;
    F0.MISC = (volatile LAS unsigned*)(F0.lds + MISC_OFF);
    F0.tid = threadIdx.x; F0.lane = F0.tid & 63; F0.wave = __builtin_amdgcn_readfirstlane(F0.tid >> 6);
    F0.G = gridDim.x; { const int bx = blockIdx.x; F0.vcu = (F0.G % 8 == 0) ? (bx % 8) * (F0.G / 8) + bx / 8 : bx; }
    F0.ws = args.ws; F0.out = args.out; F0.ctl = (gu32*)(args.ws + WS_CTL);
    F0.in = args.in;
    for (int u = F0.tid; u < (LDS_BYTES - LDSCTL_OFF) / 4; u += NWAVES * 64) ((LAS unsigned*)(F0.lds + LDSCTL_OFF))[u] = 0u;
    __syncthreads();
    XcdBarrier bar; bar.bar = (unsigned*)(F0.ctl + CW_BAR); bar.x = 0; bar.st = nullptr;
    if (MK_N_LAUNCHES == 1) bar = xcd_barrier_post((unsigned*)(F0.ctl + CW_BAR), F0.MISC + 8);
    bar.wave = F0.wave;
    const int lo = args.ph_lo, hi = args.ph_hi;
    int ph = 0;
#define PHASE_BEGIN(id) if (((AUDIT_SITES >> (id)) & 1u) && lo <= ph && ph < hi) { _Pragma("unroll 1") for (int rep_ = 0; rep_ < (((PROBE_MASK >> (id)) & 1u) ? 1 + PROBE_REPS : 1); ++rep_) { Frame F = phase_frame(F0); \
    F.pflags = (PROBE_FLAGS != 0 && ((PROBE_MASK >> (id)) & 1u) && rep_ < PROBE_REPS) ? PROBE_FLAGS : 0;
#define PHASE_END } if (ph + 1 < hi) { if (MK_N_LAUNCHES == 1) xcd_barrier(bar); } } ++ph;
#define H_ WSP(float, WS_H)
#define HB_ WSP(bf16, WS_H)
#define HS_ (WSP(float, WS_H) + (size_t)MP * 1024)
#define XN_ WSP(bf16, WS_XN)
#define XNKV_ WSP(bf16, WS_XNKV)
#define MODL_ (WSP(float, WS_MOD) + (size_t)L * NSEQ * 6144)
#define HP_ ((L == 0) ? F.in[I_XP] : H_)
#define HSS_ ((L == 0) ? F.in[I_XS] : HS_)

    PHASE_BEGIN(0) if (AUDIT_SUB & 1) p0_weights(F); __syncthreads(); if (AUDIT_SUB & 2) p0_adaln(F); PHASE_END

#pragma unroll 1
    for (int L = 0; L < 4; ++L) {
        PHASE_BEGIN(1)
            const Pend pd{(L == 0 || rep_ > 0) ? nullptr : WSP(float, WS_SLAB), WSP(float, WS_MOD) + (size_t)(L == 0 ? 0 : L - 1) * NSEQ * 6144 + 5120, HS_, HS_};
            if (L == 2) norm_rows<2, true>(F, pd, HB_, HSS_, F.in[I_NMIX] + L * 1024, MODL_, 0, 1024, XN_, F.in[I_KVN], WSP(float, WS_MOD) + (size_t)4 * NSEQ * 6144, 0, 1024, XNKV_);
            else if (L == 0) norm_rows<1, false>(F, pd, F.in[I_XP], HSS_, F.in[I_NMIX] + L * 1024, MODL_, 0, 1024, XN_, F.in[I_NMIX] + L * 1024, MODL_, 0, 1024, XN_);
            else norm_rows<1, true>(F, pd, HB_, HSS_, F.in[I_NMIX] + L * 1024, MODL_, 0, 1024, XN_, F.in[I_NMIX] + L * 1024, MODL_, 0, 1024, XN_);
        PHASE_END
        if (L < 2) {
            PHASE_BEGIN(2) { pg8::Gemm g{XN_, WSP(bf16, WS_WIN) + (size_t)L * INPAD * 1024, MP, INW, 1024, F.pflags}; pg8::StaticOrder S; S.init(MP, INW, F.G, (int)blockIdx.x);
                pg8::EpiInProj E{WSP(bf16, WS_BIG), WSP(float, WS_DTRAW), (PROBE_NULLEPI_ON && rep_ > 0) || F.pflags != 0};
                if (!(F.pflags & 16)) pg8::gemm_phase<pg8::EpiInProj, pg8::StaticOrder, true, true>(F.lds + RING_OFF, g, S, E, F.tid); }
                if (!(PROBE_NULLEPI_ON && rep_ > 0) && (F.pflags == 0 || (F.pflags & 16))) { sg_inproj(F, L); sg_dt(F, L); } PHASE_END
            PHASE_BEGIN(3) conv_mamba_phase(F, L); PHASE_END
            PHASE_BEGIN(4) if ((AUDIT_SUB & 1) && (rep_ == 0 || (PROBE_SUB & 1))) ssd_s1_phase(F, L); if ((AUDIT_SUB & 2) && (rep_ == 0 || (PROBE_SUB & 2))) { Frame F2 = phase_frame(F0); F2.pflags = 0; ssd_sample_phase(F2, L); } PHASE_END
            PHASE_BEGIN(5) ssd_s2_phase(F, L); PHASE_END
            PHASE_BEGIN(6) ssd_s3_phase(F, L); PHASE_END
        } else {
            PHASE_BEGIN(7)
                if (L == 2) { pg8::Gemm g{XNKV_, WSP(bf16, WS_WKV), MP, 6144, 1024}; pg8::StaticOrder S; S.init(MP, 6144, F.G, (int)blockIdx.x);
                    pg8::EpiRopeKV E{WSP(bf16, WS_KB), WSP(bf16, WS_VB), F.out + O_KP, F.out + O_KS, F.out + O_VP, F.out + O_VS, WSP(float, WS_ROPE)};
                    pg8::gemm_phase<pg8::EpiRopeKV, pg8::StaticOrder, true, true>(F.lds + RING_OFF, g, S, E, F.tid); }
                { pg8::Gemm g{XN_, WSP(bf16, WS_WQ) + (size_t)(L - 2) * AW * 1024, MP, AW, 1024}; pg8::StaticOrder S; S.init(MP, AW, F.G, (int)blockIdx.x);
                    pg8::EpiRopeQ E{WSP(bf16, WS_QB), WSP(float, WS_ROPE), QSCALE};
                    pg8::gemm_phase<pg8::EpiRopeQ, pg8::StaticOrder, true, true>(F.lds + RING_OFF, g, S, E, F.tid); }
                if (L == 2) sg_kv(F);
                sg_q(F, L - 2, L == 2 ? 144 : 0);
            PHASE_END
            PHASE_BEGIN(9) if ((AUDIT_SUB & 2) && (rep_ == 0 || (PROBE_SUB & 2))) attn_sample_phase(F, 0, AT_NS); if ((AUDIT_SUB & 1) && (rep_ == 0 || (PROBE_SUB & 1))) attn_prompt_phase(F, AT_NS, (int)F.G - AT_NS); PHASE_END
            PHASE_BEGIN(16) attn_merge_phase(F); PHASE_END
        }
        PHASE_BEGIN(10) { pg8::Gemm g{L < 2 ? WSP(bf16, WS_Y) : WSP(bf16, WS_OB), L < 2 ? WSP(bf16, WS_WOUT) + (size_t)L * 1024 * 2048 : WSP(bf16, WS_WO) + (size_t)(L - 2) * 1024 * 1024, MP, 1024, L < 2 ? 2048 : 1024};
            pg8::StaticOrder S; S.init(MP, 1024, F.G, (int)blockIdx.x);
            pg8::EpiResid E{L == 0 ? F.in[I_XP] : nullptr, HB_, rep_ > 0 ? WSP(bf16, WS_END) : HB_, MODL_ + 2048};
            pg8::gemm_phase<pg8::EpiResid, pg8::StaticOrder, true, true>(F.lds + RING_OFF, g, S, E, F.tid);
            sg_resid(F, (L < 2 ? WSP(bf16, WS_Y) + (size_t)MP * 2048 : WSP(bf16, WS_OB) + (size_t)MP * 1024), g.Bt, g.K); } PHASE_END
        PHASE_BEGIN(11) { const Pend pd{rep_ > 0 ? nullptr : WSP(float, WS_SLAB), MODL_ + 2048, HSS_, HS_};
            norm_rows<1, true>(F, pd, HB_, HS_, F.in[I_NFFN] + L * 1024, MODL_, 3072, 4096, XN_, F.in[I_NFFN] + L * 1024, MODL_, 3072, 4096, XN_); } PHASE_END
        PHASE_BEGIN(12) { pg8::Gemm g{XN_, WSP(bf16, WS_WUP) + (size_t)L * FF2 * 1024, MT, FF2, 1024}; pg8::StaticOrder S; S.init(MT, FF2, F.G, (int)blockIdx.x);
            pg8::EpiUpConv E{WSP(bf16, WS_ACT), WSP(float, WS_UB), F.in[I_FCW] + (size_t)L * 3 * FF2, F.in[I_FCB] + (size_t)L * FF2, F.out + O_FFNP + (size_t)L * 2 * 2 * FF2, F.out + O_FFNS + (size_t)L * 32 * 2 * FF2, F.in[I_FFNC] + (size_t)L * 32 * 2 * FF2, F.pflags != 0};
            pg8::gemm_phase<pg8::EpiUpConv, pg8::StaticOrder, true, true>(F.lds + RING_OFF, g, S, E, F.tid); } PHASE_END
        PHASE_BEGIN(14) { pg8::Gemm g{WSP(bf16, WS_ACT), WSP(bf16, WS_WDN) + (size_t)L * 1024 * FF, MP, 1024, FF}; pg8::StaticOrder S; S.init(MP, 1024, F.G, (int)blockIdx.x);
            { pg8::Unit u0; if (S.next(0, u0)) ffn_fixup(F, L, u0.pm); else { VM_WAIT(); __syncthreads(); } }
            pg8::EpiResid E{nullptr, HB_, rep_ > 0 ? WSP(bf16, WS_END) : HB_, MODL_ + 5120};
            pg8::gemm_phase<pg8::EpiResid, pg8::StaticOrder, true, true>(F.lds + RING_OFF, g, S, E, F.tid);
            sg_resid(F, WSP(bf16, WS_ACT) + (size_t)MP * FF, g.Bt, FF); } PHASE_END
    }
    PHASE_BEGIN(15) { const Pend pd{rep_ > 0 ? nullptr : WSP(float, WS_SLAB), WSP(float, WS_MOD) + (size_t)3 * NSEQ * 6144 + 5120, HS_, HS_};
        final_norm_phase(F, pd, HB_, HS_, F.in[I_FN], F.out + O_YP); } PHASE_END
#ifdef PROBE_BARRIERS
    if (MK_N_LAUNCHES == 1) { _Pragma("unroll 1") for (int i = 0; i < PROBE_BARRIERS; ++i) xcd_barrier(bar); }
#endif
#undef PHASE_BEGIN
#undef PHASE_END
}

extern "C" void kernel_launch(void* const* d_in, const int* in_sizes, int n_in, void* d_out, int out_size, void* d_ws, size_t ws_size, hipStream_t stream) {
    static int grid = 0;
    if (grid == 0) {
        if (n_in != 32 || (size_t)out_size != O_END || ws_size < WS_END + 80 * MiB) { fprintf(stderr, "kernel_launch: unexpected shapes (n_in %d, out %d, ws %zu, need %zu); nothing launched\n", n_in, out_size, ws_size, (size_t)WS_END); grid = -1; return; }
        int dev = 0, cus = 0;
        if (hipGetDevice(&dev) != hipSuccess || hipDeviceGetAttribute(&cus, hipDeviceAttributeMultiprocessorCount, dev) != hipSuccess) { grid = -1; return; }
        if (hipFuncSetAttribute((const void*)yoco_fwd, hipFuncAttributeMaxDynamicSharedMemorySize, LDS_BYTES) != hipSuccess) { fprintf(stderr, "kernel_launch: hipFuncSetAttribute failed\n"); grid = -1; return; }
        int per_cu = 0;
        if (hipOccupancyMaxActiveBlocksPerMultiprocessor(&per_cu, (const void*)yoco_fwd, NWAVES * 64, LDS_BYTES) != hipSuccess || per_cu < 1)
            fprintf(stderr, "kernel_launch: note: occupancy query reports %d workgroups per CU\n", per_cu);
        (void)hipGetLastError();
        grid = cus;
    }
    if (grid < 0) return;
    if (hipMemsetAsync((char*)d_ws + WS_CTL, 0, CTL_ZERO_BYTES, stream) != hipSuccess) return;
    Args a{};
    for (int i = 0; i < 32; ++i) a.in[i] = (const float*)d_in[i];
    a.out = (float*)d_out; a.ws = (unsigned char*)d_ws; a.li = 0; a.pad = 0;
#if MK_N_LAUNCHES == 1
    a.ph_lo = 0; a.ph_hi = NPHASES;
    hipLaunchKernelGGL(yoco_fwd, dim3(grid), dim3(NWAVES * 64), LDS_BYTES, stream, a);
#else
    for (int k = 0; k < NPHASES; ++k) { a.ph_lo = k; a.ph_hi = k + 1; hipLaunchKernelGGL(yoco_fwd, dim3(grid), dim3(NWAVES * 64), LDS_BYTES, stream, a); }
#endif
    const hipError_t le = hipPeekAtLastError();
    if (le != hipSuccess) fprintf(stderr, "kernel_launch: launch failed: %s\n", hipGetErrorName(le));
}
```

```cpp
#define PROBE_MASK 0x0u
#include <hip/hip_runtime.h>
#ifndef PROBE_FLAGS
#define PROBE_FLAGS 0
#endif
#include <cstdio>
#include <cstdint>
#include <cmath>
namespace pg8 {
#define PG8_LAS __attribute__((address_space(3)))
typedef unsigned short bf16_t;
typedef short bf16x8 __attribute__((ext_vector_type(8)));
typedef float f32x4 __attribute__((ext_vector_type(4)));
typedef unsigned u32x4 __attribute__((ext_vector_type(4)));
constexpr int BM = 256, BK = 64, HALF = 128, HTB = HALF * BK * 2  , STAGE_BYTES = 8 * HTB, NXCD = 8, WGM = 8;

__host__ __device__ __forceinline__ int lds_byte(int r, int c) { const int st = (r >> 4) * 2 + (c >> 5), rr = r & 15, cc = c & 31, ob = rr * 64 + cc * 2; return st * 1024 + (ob ^ (((ob >> 9) & 1) << 5)); }
__host__ __device__ __forceinline__ void stage_rc(int b, int& R, int& C) { const int st = b / 1024, sb = b % 1024, swz = sb ^ (((sb >> 9) & 1) << 5); R = (st >> 1) * 16 + swz / 64; C = (st & 1) * 32 + (swz % 64) / 2; }
__host__ __device__ __forceinline__ int perm32(int rho) { const int n = rho >> 4, i = rho & 15; return 8 * (i >> 2) + 4 * n + (i & 3); }

struct Unit { int pm, pn; };
struct Gemm { const bf16_t* A; const bf16_t* Bt; int M, N, K; int pf = 0; };

struct StaticOrder {
    int nM, nN, nwg, G, c;
    __host__ __device__ __forceinline__ void init(int M, int N, int G_, int c_) { nM = M / BM; nN = N / BM; nwg = nM * nN; G = G_; c = c_; }
    __host__ __device__ __forceinline__ bool next(int i, Unit& u) const {
        const long L = (long)i * G + c; if (L >= nwg) return false;
        int wgid = (int)L; { const int q = nwg / NXCD, r = nwg % NXCD, xcd = wgid % NXCD, off = wgid / NXCD; wgid = (xcd < r ? xcd * (q + 1) : r * (q + 1) + (xcd - r) * q) + off; }
        const int nig = WGM * nN, gid = wgid / nig, fm = gid * WGM, gsz = (nM - fm) < WGM ? (nM - fm) : WGM;
        u.pm = fm + ((wgid % nig) % gsz); u.pn = (wgid % nig) / gsz; return true;
    }
    __device__ __forceinline__ void a_ready(const Unit&) const {}
    __device__ __forceinline__ void done(const Unit&) const {}
};

struct UpOrder {
    StaticOrder P; int G, c, nP;
    __host__ __device__ __forceinline__ void init(int Mp, int N, int G_, int c_) { P.init(Mp, N, G_, c_); G = G_; c = c_; nP = c < P.nwg ? (P.nwg - c + G - 1) / G : 0; }
    __host__ __device__ __forceinline__ bool next(int i, Unit& u) const {
        if (i < nP) return P.next(i, u);
        if (i == nP && G - 1 - c < P.nN) { u.pm = P.nM; u.pn = G - 1 - c; return true; }
        return false;
    }
    __device__ __forceinline__ void a_ready(const Unit&) const {}
    __device__ __forceinline__ void done(const Unit&) const {}
};

__device__ __forceinline__ unsigned cvt_pk_bf16(float lo, float hi) { unsigned r; asm volatile("v_cvt_pk_bf16_f32 %0, %1, %2" : "=v"(r) : "v"(lo), "v"(hi)); return r; }
typedef float f32x2 __attribute__((ext_vector_type(2)));
typedef unsigned u32x2 __attribute__((ext_vector_type(2)));
__device__ __forceinline__ u32x4 pack8(const f32x4 a, const f32x4 b) { u32x4 w; w.x = cvt_pk_bf16(a[0], a[1]); w.y = cvt_pk_bf16(a[2], a[3]); w.z = cvt_pk_bf16(b[0], b[1]); w.w = cvt_pk_bf16(b[2], b[3]); return w; }
struct EpiBf16 {
    static constexpr bool PERM = true, AFTER_DRAIN = false, DEFER_LAST = false;
    bf16_t* O; int ldc;
    __device__ __forceinline__ void operator()(const f32x4 (&acc)[2][2][4][2], const Unit& u, int wr, int wc, int fr, int fq) const {
        const int row0 = u.pm * BM + wr * 64 + fr, col0 = u.pn * BM + wc * 32 + 8 * fq;
#pragma unroll
        for (int ai = 0; ai < 2; ++ai)
#pragma unroll
            for (int m = 0; m < 4; ++m) { bf16_t* rowp = O + (size_t)(row0 + ai * HALF + m * 16) * ldc + col0;
#pragma unroll
                for (int bj = 0; bj < 2; ++bj) *(u32x4*)(rowp + bj * HALF) = pack8(acc[ai][bj][m][0], acc[ai][bj][m][1]); }
    }
};
#ifdef EPI_NT
#define EPI_ST(p, v) __builtin_nontemporal_store((v), (p))
#else
#define EPI_ST(p, v) (*(p) = (v))
#endif
struct EpiNull {
    static constexpr bool PERM = true, AFTER_DRAIN = false, DEFER_LAST = false;
    float* sink;
    __device__ __forceinline__ void operator()(const f32x4 (&acc)[2][2][4][2], const Unit& u, int wr, int wc, int fr, int fq) const {
        float s = 0.f;
#pragma unroll
        for (int ai = 0; ai < 2; ++ai)
#pragma unroll
            for (int bj = 0; bj < 2; ++bj)
#pragma unroll
                for (int m = 0; m < 4; ++m)
#pragma unroll
                    for (int n = 0; n < 2; ++n) s += acc[ai][bj][m][n][0] + acc[ai][bj][m][n][1] + acc[ai][bj][m][n][2] + acc[ai][bj][m][n][3];
        if (s == 1.2345e-30f) sink[0] = s;
    }
};
struct EpiInProj {
    static constexpr bool PERM = true, AFTER_DRAIN = false, DEFER_LAST = false;
    bf16_t* O; float* dtraw; bool skip;
    __device__ __forceinline__ void operator()(const f32x4 (&acc)[2][2][4][2], const Unit& u, int wr, int wc, int fr, int fq) const {
        if (skip) return;
        const int row0 = u.pm * BM + wr * 64 + fr, col0 = u.pn * BM + wc * 32 + 8 * fq;
#pragma unroll
        for (int ai = 0; ai < 2; ++ai)
#pragma unroll
            for (int m = 0; m < 4; ++m) { bf16_t* rowp = O + (size_t)(row0 + ai * HALF + m * 16) * 5120 + col0;
#pragma unroll
                for (int bj = 0; bj < 2; ++bj) EPI_ST((u32x4*)(rowp + bj * HALF), pack8(acc[ai][bj][m][0], acc[ai][bj][m][1])); }
    }
};
struct EpiResid {
    static constexpr bool PERM = true, AFTER_DRAIN = false, DEFER_LAST = false;
    const float* inF; const bf16_t* inB; bf16_t* out; const float* gate;
    __device__ __forceinline__ void operator()(const f32x4 (&acc)[2][2][4][2], const Unit& u, int wr, int wc, int fr, int fq) const {
        const int col0 = u.pn * BM + wc * 32 + 8 * fq;
        f32x4 gv[2][2];
        { const float* g = gate + (size_t)(u.pm >> 5) * 6144 + col0;
#pragma unroll
          for (int bj = 0; bj < 2; ++bj)
#pragma unroll
              for (int n = 0; n < 2; ++n) gv[bj][n] = *(const f32x4*)(g + bj * HALF + 4 * n); }
#pragma unroll
        for (int ai = 0; ai < 2; ++ai) {
            if (inF != nullptr) {
#pragma unroll
                for (int mp = 0; mp < 2; ++mp) {
                    f32x4 bs[2][2][2];
#pragma unroll
                    for (int mm = 0; mm < 2; ++mm) { const int row = u.pm * BM + ai * HALF + wr * 64 + (2 * mp + mm) * 16 + fr; const float* ip = inF + (size_t)row * 1024 + col0;
#pragma unroll
                        for (int bj = 0; bj < 2; ++bj)
#pragma unroll
                            for (int n = 0; n < 2; ++n) bs[mm][bj][n] = *(const f32x4*)(ip + bj * HALF + 4 * n); }
#pragma unroll
                    for (int mm = 0; mm < 2; ++mm) { const int m = 2 * mp + mm, row = u.pm * BM + ai * HALF + wr * 64 + m * 16 + fr; bf16_t* op = out + (size_t)row * 1024 + col0;
#pragma unroll
                        for (int bj = 0; bj < 2; ++bj) *(u32x4*)(op + bj * HALF) = pack8(bs[mm][bj][0] + gv[bj][0] * acc[ai][bj][m][0], bs[mm][bj][1] + gv[bj][1] * acc[ai][bj][m][1]); }
                    asm volatile("" ::: "memory");
                }
            } else {
                u32x4 bb[4][2];
#pragma unroll
                for (int m = 0; m < 4; ++m) { const int row = u.pm * BM + ai * HALF + wr * 64 + m * 16 + fr; const bf16_t* ip = inB + (size_t)row * 1024 + col0;
#pragma unroll
                    for (int bj = 0; bj < 2; ++bj) bb[m][bj] = *(const u32x4*)(ip + bj * HALF); }
#pragma unroll
                for (int m = 0; m < 4; ++m) { const int row = u.pm * BM + ai * HALF + wr * 64 + m * 16 + fr; bf16_t* op = out + (size_t)row * 1024 + col0;
#pragma unroll
                    for (int bj = 0; bj < 2; ++bj) { const u32x4 w = bb[m][bj];
                        const f32x4 x0 = (f32x4){__builtin_bit_cast(float, w.x << 16), __builtin_bit_cast(float, w.x & 0xffff0000u), __builtin_bit_cast(float, w.y << 16), __builtin_bit_cast(float, w.y & 0xffff0000u)};
                        const f32x4 x1 = (f32x4){__builtin_bit_cast(float, w.z << 16), __builtin_bit_cast(float, w.z & 0xffff0000u), __builtin_bit_cast(float, w.w << 16), __builtin_bit_cast(float, w.w & 0xffff0000u)};
                        *(u32x4*)(op + bj * HALF) = pack8(x0 + gv[bj][0] * acc[ai][bj][m][0], x1 + gv[bj][1] * acc[ai][bj][m][1]); } }
            }
        }
    }
};
__device__ __forceinline__ f32x4 dpp_ror(const f32x4 v, const int n) {
    f32x4 r;
#pragma unroll
    for (int j = 0; j < 4; ++j) r[j] = n == 1 ? __builtin_bit_cast(float, __builtin_amdgcn_update_dpp(0, __float_as_int(v[j]), 0x121, 0xf, 0xf, false))
                                              : __builtin_bit_cast(float, __builtin_amdgcn_update_dpp(0, __float_as_int(v[j]), 0x122, 0xf, 0xf, false));
    return r;
}
__device__ __forceinline__ float silu_f(float x) { return x * __builtin_amdgcn_rcpf(1.0f + __expf(-x)); }
struct EpiUpConv {
    static constexpr bool PERM = true, AFTER_DRAIN = false, DEFER_LAST = true;
    bf16_t* G; float* UB; const float* fw; const float* fb; float* ffnP; float* ffnS; const float* st; bool skip;
    __device__ __forceinline__ void operator()(const f32x4 (&acc)[2][2][4][2], const Unit& u, int wr, int wc, int fr, int fq) const {
        if (skip) return;
        const int cg0 = u.pn * 128 + wc * 32 + 8 * fq;
        u32x2 held[2][4];
#pragma unroll
        for (int n = 0; n < 2; ++n) {
            const int ch = cg0 + 4 * n;
            f32x4 w[2][3], bs[2];
#pragma unroll
            for (int pt = 0; pt < 2; ++pt) { bs[pt] = *(const f32x4*)(fb + pt * 2816 + ch);
#pragma unroll
                for (int k = 0; k < 3; ++k) w[pt][k] = *(const f32x4*)(fw + k * 5632 + pt * 2816 + ch); }
#pragma unroll
            for (int ai = 0; ai < 2; ++ai)
#pragma unroll
                for (int m = 0; m < 4; ++m) {
                    int row = u.pm * BM + ai * HALF + wr * 64 + m * 16 + fr; asm volatile("" : "+v"(row));
                    f32x4 a[2];
#pragma unroll
                    for (int pt = 0; pt < 2; ++pt) {
                        const f32x4 cur = acc[ai][pt][m][n];
                        f32x4 p1, p2;
                        {
                            const f32x4 pv = acc[ai][pt][m > 0 ? m - 1 : 0][n];
#pragma unroll
                            for (int j = 0; j < 4; ++j) {
                                const int o1 = __builtin_amdgcn_update_dpp(0, __float_as_int(pv[j]), 0x121, 0xf, 0xf, false);
                                const int o2 = __builtin_amdgcn_update_dpp(0, __float_as_int(pv[j]), 0x122, 0xf, 0xf, false);
                                p1[j] = __builtin_bit_cast(float, __builtin_amdgcn_update_dpp(o1, __float_as_int(cur[j]), 0x111, 0xf, 0xf, false));
                                p2[j] = __builtin_bit_cast(float, __builtin_amdgcn_update_dpp(o2, __float_as_int(cur[j]), 0x112, 0xf, 0xf, false)); }
                        }
                        a[pt] = bs[pt] + w[pt][0] * p2 + w[pt][1] * p1 + w[pt][2] * cur;
                        { const int t = row & 8191;
                            if (t >= 8190) *(f32x4*)(ffnP + ((size_t)(row >> 13) * 2 + (t - 8190)) * 5632 + pt * 2816 + ch) = cur;
                            if ((m == 0 && fr < 2) || (m == 3 && fr >= 14)) *(f32x4*)(UB + ((size_t)(row >> 6) * 4 + (m == 0 ? fr : fr - 12)) * 5632 + pt * 2816 + ch) = cur; }
                    }
                    if (!(m == 0 && fr < 2)) {
                        u32x2 o; o.x = cvt_pk_bf16(silu_f(a[0][0]) * a[1][0], silu_f(a[0][1]) * a[1][1]); o.y = cvt_pk_bf16(silu_f(a[0][2]) * a[1][2], silu_f(a[0][3]) * a[1][3]);
                        if (n == 0) held[ai][m] = o; else *(u32x4*)(G + (size_t)row * 2816 + cg0) = (u32x4){held[ai][m].x, held[ai][m].y, o.x, o.y}; }
                    asm volatile("" ::: "memory");
                }
        }
    }
    __device__ __forceinline__ bool defer(const Unit& u) const { return u.pm >= 64; }
    __device__ __forceinline__ void deferred(const f32x4 (&acc)[2][2][4][2], const Unit& u, PG8_LAS unsigned char* lds, int wid) const {
        if (skip) return;
        int lane; asm volatile("v_mbcnt_lo_u32_b32 %0, -1, 0\n\tv_mbcnt_hi_u32_b32 %0, -1, %0" : "=v"(lane));
        const int wr = wid >> 2, wc = wid & 3, fr = lane & 15, fq = lane >> 4;
#pragma unroll
        for (int k = 0; k < 8; ++k) { const int p = (k * 8 + wid) * 64 + lane, c4 = p & 31, pt = (p >> 5) & 1, rw = (p >> 6) & 1, b = p >> 7;
            __builtin_amdgcn_global_load_lds((const unsigned*)(st + ((size_t)b * 2 + rw) * 5632 + pt * 2816 + u.pn * 128 + c4 * 4), (PG8_LAS unsigned*)(lds + (k * 8 + wid) * 1024), 16, 0, 0); }
        asm volatile("s_waitcnt vmcnt(0)" ::: "memory"); __builtin_amdgcn_s_barrier();
        const int cg0 = u.pn * 128 + wc * 32 + 8 * fq, t = fr & 7;
        u32x2 held[2][4];
#pragma unroll
        for (int n = 0; n < 2; ++n) {
            const int ch = cg0 + 4 * n;
            f32x4 w[2][3], bs[2];
#pragma unroll
            for (int pt = 0; pt < 2; ++pt) { bs[pt] = *(const f32x4*)(fb + pt * 2816 + ch);
#pragma unroll
                for (int k = 0; k < 3; ++k) w[pt][k] = *(const f32x4*)(fw + k * 5632 + pt * 2816 + ch); }
#pragma unroll
            for (int ai = 0; ai < 2; ++ai)
#pragma unroll
                for (int m = 0; m < 4; ++m) {
                    int rl = ai * HALF + wr * 64 + m * 16 + fr; asm volatile("" : "+v"(rl));
                    const int row = u.pm * BM + rl, b = rl >> 3;
                    f32x4 a[2];
#pragma unroll
                    for (int pt = 0; pt < 2; ++pt) {
                        const f32x4 cur = acc[ai][pt][m][n];
                        const PG8_LAS f32x4* sp = (const PG8_LAS f32x4*)lds + b * 128 + pt * 32 + wc * 8 + 2 * fq + n;
                        const f32x4 s0 = sp[0], s1 = sp[64];
                        f32x4 c1, c2;
#pragma unroll
                        for (int j = 0; j < 4; ++j) {
                            c1[j] = __builtin_bit_cast(float, __builtin_amdgcn_update_dpp(0, __float_as_int(cur[j]), 0x111, 0xf, 0xf, false));
                            c2[j] = __builtin_bit_cast(float, __builtin_amdgcn_update_dpp(0, __float_as_int(cur[j]), 0x112, 0xf, 0xf, false)); }
                        const f32x4 p1 = t >= 1 ? c1 : s1, p2 = t >= 2 ? c2 : (t == 1 ? s1 : s0);
                        a[pt] = bs[pt] + w[pt][0] * p2 + w[pt][1] * p1 + w[pt][2] * cur;
                        if (t >= 6) *(f32x4*)(ffnS + ((size_t)(rl >> 3) * 2 + (t - 6)) * 5632 + pt * 2816 + ch) = cur;
                    }
                    u32x2 o; o.x = cvt_pk_bf16(silu_f(a[0][0]) * a[1][0], silu_f(a[0][1]) * a[1][1]); o.y = cvt_pk_bf16(silu_f(a[0][2]) * a[1][2], silu_f(a[0][3]) * a[1][3]);
                    if (n == 0) held[ai][m] = o; else *(u32x4*)(G + (size_t)row * 2816 + cg0) = (u32x4){held[ai][m].x, held[ai][m].y, o.x, o.y};
                    asm volatile("" ::: "memory");
                }
        }
    }
};
struct RopeCS { f32x4 v[4]; };
__device__ __forceinline__ RopeCS rope_load(const float* rp) { RopeCS r;
#pragma unroll
    for (int q = 0; q < 4; ++q) r.v[q] = *(const f32x4*)(rp + 4 * q);
    return r; }
__device__ __forceinline__ void rope8(const f32x4 (&a0)[2], const f32x4 (&a1)[2], const RopeCS& R, float sc, f32x4 (&o1)[2], f32x4 (&o2)[2]) {
#pragma unroll
    for (int n = 0; n < 2; ++n) { const f32x4 cs0 = R.v[2 * n], cs1 = R.v[2 * n + 1];
        const float c[4] = {cs0[0], cs0[2], cs1[0], cs1[2]}, s[4] = {cs0[1], cs0[3], cs1[1], cs1[3]};
#pragma unroll
        for (int j = 0; j < 4; ++j) { const float x1 = a0[n][j], x2 = a1[n][j]; o1[n][j] = (x1 * c[j] - x2 * s[j]) * sc; o2[n][j] = (x2 * c[j] + x1 * s[j]) * sc; } }
}
__device__ __forceinline__ int row_pos(int row) { return row < 16384 ? (row & 8191) : 8192 + ((row - 16384) & 7); }
struct EpiRopeKV {
    static constexpr bool PERM = true, AFTER_DRAIN = false, DEFER_LAST = false;
    bf16_t* Kb; bf16_t* Vb; float* kP; float* kS; float* vP; float* vS; const float* rope;
    __device__ __forceinline__ void operator()(const f32x4 (&acc)[2][2][4][2], const Unit& u, int wr, int wc, int fr, int fq) const {
#pragma unroll
        for (int ai = 0; ai < 2; ++ai) {
            RopeCS R[4];
            if (u.pn < 12) {
#pragma unroll
                for (int m = 0; m < 4; ++m) R[m] = rope_load(rope + ((size_t)row_pos(u.pm * BM + ai * HALF + wr * 64 + m * 16 + fr) * 32 + 8 * fq) * 2); }
#pragma unroll
            for (int m = 0; m < 4; ++m) {
                const int rl = ai * HALF + wr * 64 + m * 16 + fr, row = u.pm * BM + rl;
                bool fo; size_t forow;
                if (u.pm < 64) { const int t = row & 8191; fo = t >= 6144; forow = (size_t)(row >> 13) * 2048 + (t - 6144); } else { fo = true; forow = (size_t)(row - 16384); }
                if (u.pn < 12) {
                    f32x4 o1[2], o2[2]; rope8(acc[ai][0][m], acc[ai][1][m], R[m], 1.0f, o1, o2);
                    const int colA = u.pn * BM + 64 * wc + 8 * fq;
                    bf16_t* kp = Kb + (size_t)row * 3072 + colA;
                    EPI_ST((u32x4*)kp, pack8(o1[0], o1[1])); EPI_ST((u32x4*)(kp + 32), pack8(o2[0], o2[1]));
                    if (fo) { float* f = ((u.pm < 64) ? kP : kS) + forow * 3072 + colA;
                        EPI_ST((f32x4*)f, o1[0]); EPI_ST((f32x4*)(f + 4), o1[1]); EPI_ST((f32x4*)(f + 32), o2[0]); EPI_ST((f32x4*)(f + 36), o2[1]); }
                } else {
#pragma unroll
                    for (int bj = 0; bj < 2; ++bj) { const int vcol = (u.pn - 12) * BM + bj * HALF + wc * 32 + 8 * fq;
                        EPI_ST((u32x4*)(Vb + (size_t)row * 3072 + vcol), pack8(acc[ai][bj][m][0], acc[ai][bj][m][1]));
                        if (fo) { float* f = ((u.pm < 64) ? vP : vS) + forow * 3072 + vcol; EPI_ST((f32x4*)f, acc[ai][bj][m][0]); EPI_ST((f32x4*)(f + 4), acc[ai][bj][m][1]); } }
                }
            }
        }
    }
};
struct EpiRopeQ {
    static constexpr bool PERM = true, AFTER_DRAIN = false, DEFER_LAST = false;
    bf16_t* Qb; const float* rope; float qscale;
    __device__ __forceinline__ void operator()(const f32x4 (&acc)[2][2][4][2], const Unit& u, int wr, int wc, int fr, int fq) const {
#pragma unroll
        for (int ai = 0; ai < 2; ++ai) {
            RopeCS R[4];
#pragma unroll
            for (int m = 0; m < 4; ++m) R[m] = rope_load(rope + ((size_t)row_pos(u.pm * BM + ai * HALF + wr * 64 + m * 16 + fr) * 32 + 8 * fq) * 2);
#pragma unroll
            for (int m = 0; m < 4; ++m) {
                const int rl = ai * HALF + wr * 64 + m * 16 + fr, row = u.pm * BM + rl;
                f32x4 o1[2], o2[2]; rope8(acc[ai][0][m], acc[ai][1][m], R[m], qscale, o1, o2);
                bf16_t* qp = Qb + (size_t)row * 3072 + u.pn * BM + 64 * wc + 8 * fq;
                EPI_ST((u32x4*)qp, pack8(o1[0], o1[1])); EPI_ST((u32x4*)(qp + 32), pack8(o2[0], o2[1]));
            }
        }
    }
};

template <class Epi, class Sched, bool ALIGN_EPI = false, bool SP2 = false>
__device__ __forceinline__ void gemm_phase(PG8_LAS unsigned char* lds, const Gemm g, const Sched& S, const Epi& E, int tid_in) {
    int tid_ = tid_in; asm volatile("" : "+v"(tid_));
    const int tid = tid_, wid = __builtin_amdgcn_readfirstlane(tid >> 6), lane = tid & 63, wr = wid >> 2, wc = wid & 3, fr = lane & 15, fq = lane >> 4;
    const int K = g.K, nt = K / BK;
    unsigned voffA[2], voffB[2];
#pragma unroll
    for (int i = 0; i < 2; ++i) { int R, C; stage_rc(tid * 16 + i * 8192, R, C); const int Rb = Epi::PERM ? ((R & ~31) + perm32(R & 31)) : R;
        voffA[i] = (unsigned)(R * K + C) * 2u; voffB[i] = (unsigned)(Rb * K + C) * 2u; }
    const size_t kstep = (size_t)(BK * 2);
    const size_t hstep = (size_t)HALF * K * 2;
    const size_t tstep = 2 * hstep;
    const unsigned ldsw = (unsigned)wid * 1024u;
    const int aoff = lds_byte(wr * 64 + fr, fq * 8), boff = lds_byte(wc * 32 + fr, fq * 8);
#define PG8_SA(b, h) (((b) * 2 + (h)) * HTB)
#define PG8_SB(b, h) ((4 + (b) * 2 + (h)) * HTB)
#ifndef GEMM_B_AUX
#define GEMM_B_AUX 0
#endif
#ifndef GEMM_A_AUX
#define GEMM_A_AUX 0
#endif
#define PG8_STAGE(bufoff, gbase, voff) do { if ((bufoff) >= 4 * HTB) { _Pragma("unroll") for (int _i = 0; _i < 2; ++_i) \
        __builtin_amdgcn_global_load_lds((const unsigned*)((const char*)(gbase) + (voff)[_i]), (PG8_LAS unsigned*)(lds + (bufoff) + ldsw + _i * 8192), 16, 0, GEMM_B_AUX); } else { _Pragma("unroll") for (int _i = 0; _i < 2; ++_i) \
        __builtin_amdgcn_global_load_lds((const unsigned*)((const char*)(gbase) + (voff)[_i]), (PG8_LAS unsigned*)(lds + (bufoff) + ldsw + _i * 8192), 16, 0, GEMM_A_AUX); } } while (0)
#define PG8_LDA(dst, b, h) do { _Pragma("unroll") for (int m = 0; m < 4; ++m) _Pragma("unroll") for (int k = 0; k < 2; ++k) dst[m][k] = *(const PG8_LAS bf16x8*)(lds + PG8_SA(b, h) + aoff + m * 2048 + k * 1024); } while (0)
#define PG8_LDB(dst, b, h) do { _Pragma("unroll") for (int n = 0; n < 2; ++n) _Pragma("unroll") for (int k = 0; k < 2; ++k) dst[n][k] = *(const PG8_LAS bf16x8*)(lds + PG8_SB(b, h) + boff + n * 2048 + k * 1024); } while (0)
#define PG8_MMA(ai, bj, At, Bt) do { __builtin_amdgcn_s_setprio(1); _Pragma("unroll") for (int m = 0; m < 4; ++m) _Pragma("unroll") for (int n = 0; n < 2; ++n) _Pragma("unroll") for (int k = 0; k < 2; ++k) \
        acc[ai][bj][m][n] = __builtin_amdgcn_mfma_f32_16x16x32_bf16(Bt[n][k], At[m][k], acc[ai][bj][m][n], 0, 0, 0); __builtin_amdgcn_s_setprio(0); } while (0)
#if PROBE_FLAGS != 0
#define PG8_STAGE_P(bufoff, gbase, voff) do { if (!(g.pf & 1)) PG8_STAGE(bufoff, gbase, voff); } while (0)
#define PG8_LDA_P(dst, b, h) do { if (!(g.pf & 2)) PG8_LDA(dst, b, h); } while (0)
#define PG8_MMA_P(ai, bj, At, Bt) do { if (!(g.pf & 4)) PG8_MMA(ai, bj, At, Bt); } while (0)
#else
#define PG8_STAGE_P PG8_STAGE
#define PG8_LDA_P PG8_LDA
#define PG8_MMA_P PG8_MMA
#endif
#define PG8_WAIT_V(n) asm volatile("s_waitcnt vmcnt(" #n ")" ::: "memory")
#define PG8_WAIT_L(n) asm volatile("s_waitcnt lgkmcnt(" #n ")" ::: "memory")
#define PG8_BAR __builtin_amdgcn_s_barrier()
#define PG8_SCHED __builtin_amdgcn_sched_barrier(0)
    Unit cur, nxt; int ui = 0;
    if (!S.next(0, cur)) return;
    f32x4 acc[2][2][4][2];
#pragma unroll
    for (int a = 0; a < 2; ++a)
#pragma unroll
        for (int b = 0; b < 2; ++b)
#pragma unroll
            for (int m = 0; m < 4; ++m)
#pragma unroll
                for (int n = 0; n < 2; ++n) acc[a][b][m][n] = (f32x4){0.f, 0.f, 0.f, 0.f};
    bf16x8 At[4][2], B0[2][2], B1[2][2];
    const char* cA = (const char*)g.A + (size_t)cur.pm * tstep; const char* cB = (const char*)g.Bt + (size_t)cur.pn * tstep;
    S.a_ready(cur);
    if constexpr (SP2) {
        PG8_STAGE(PG8_SB(0, 0), cB, voffB); PG8_STAGE(PG8_SB(0, 1), cB + hstep, voffB); PG8_STAGE(PG8_SA(0, 0), cA, voffA); PG8_STAGE(PG8_SA(0, 1), cA + hstep, voffA);
        if (wr == 1) PG8_BAR;
        PG8_WAIT_V(2); PG8_BAR;
        PG8_STAGE(PG8_SB(1, 0), cB + kstep, voffB); PG8_STAGE(PG8_SA(1, 0), cA + kstep, voffA); PG8_STAGE(PG8_SB(1, 1), cB + hstep + kstep, voffB);
        PG8_WAIT_V(6); PG8_BAR;
    } else {
        PG8_STAGE(PG8_SB(0, 0), cB, voffB); PG8_STAGE(PG8_SA(0, 0), cA, voffA); PG8_STAGE(PG8_SB(0, 1), cB + hstep, voffB); PG8_STAGE(PG8_SA(0, 1), cA + hstep, voffA);
        if (wr == 1) PG8_BAR;
        PG8_WAIT_V(4); PG8_BAR;
        PG8_STAGE(PG8_SB(1, 0), cB + kstep, voffB); PG8_STAGE(PG8_SA(1, 0), cA + kstep, voffA); PG8_STAGE(PG8_SB(1, 1), cB + hstep + kstep, voffB);
        PG8_WAIT_V(6); PG8_BAR;
    }
    for (;;) {
        const bool has_next = S.next(ui + 1, nxt);
        const char* nA = has_next ? (const char*)g.A + (size_t)nxt.pm * tstep : cA; const char* nB = has_next ? (const char*)g.Bt + (size_t)nxt.pn * tstep : cB;
        for (int t = 0; t < nt; t += 2) {
            const bool last = (t == nt - 2);
            const char* a1 = cA + (size_t)(t + 1) * kstep;
            const char* a2 = last ? nA : cA + (size_t)(t + 2) * kstep; const char* b2 = last ? nB : cB + (size_t)(t + 2) * kstep;
            const char* a3 = a2 + kstep; const char* b3 = b2 + kstep;
            if (last && has_next) S.a_ready(nxt);
            if constexpr (SP2) {
            PG8_LDB(B0, 0, 0); PG8_LDB(B1, 0, 1); PG8_SCHED; PG8_LDA(At, 0, 0); PG8_STAGE_P(PG8_SA(1, 1), a1 + hstep, voffA);
            PG8_WAIT_V(8); PG8_WAIT_L(0); PG8_BAR; PG8_MMA_P(0, 0, At, B0); PG8_MMA_P(0, 1, At, B1); PG8_BAR; PG8_SCHED;
            PG8_LDA_P(At, 0, 1); PG8_STAGE_P(PG8_SB(0, 0), b2, voffB); PG8_STAGE_P(PG8_SB(0, 1), b2 + hstep, voffB); PG8_STAGE_P(PG8_SA(0, 0), a2, voffA);
            PG8_WAIT_V(8); PG8_WAIT_L(0); PG8_BAR; PG8_MMA_P(1, 0, At, B0); PG8_MMA_P(1, 1, At, B1); PG8_BAR; PG8_SCHED;
            PG8_LDB(B0, 1, 0); PG8_LDB(B1, 1, 1); PG8_SCHED; PG8_LDA(At, 1, 0); PG8_STAGE_P(PG8_SA(0, 1), a2 + hstep, voffA);
            PG8_WAIT_V(8); PG8_WAIT_L(0); PG8_BAR; PG8_MMA_P(0, 0, At, B0); PG8_MMA_P(0, 1, At, B1); PG8_BAR; PG8_SCHED;
            PG8_LDA_P(At, 1, 1); PG8_STAGE_P(PG8_SB(1, 0), b3, voffB); PG8_STAGE_P(PG8_SB(1, 1), b3 + hstep, voffB); PG8_STAGE_P(PG8_SA(1, 0), a3, voffA);
            PG8_WAIT_V(8); PG8_WAIT_L(0); PG8_BAR; PG8_MMA_P(1, 0, At, B0); PG8_MMA_P(1, 1, At, B1); PG8_BAR; PG8_SCHED;
            } else {
            PG8_LDB(B0, 0, 0); PG8_SCHED; PG8_LDA(At, 0, 0); PG8_STAGE(PG8_SA(1, 1), a1 + hstep, voffA);
            PG8_WAIT_L(8); PG8_BAR; PG8_WAIT_L(0); PG8_MMA(0, 0, At, B0); PG8_BAR; PG8_SCHED;
            PG8_LDB(B1, 0, 1); PG8_STAGE(PG8_SB(0, 0), b2, voffB);
            PG8_BAR; PG8_WAIT_L(0); PG8_MMA(0, 1, At, B1); PG8_BAR;
            PG8_LDA(At, 0, 1); PG8_STAGE(PG8_SA(0, 0), a2, voffA);
            PG8_BAR; PG8_WAIT_L(0); PG8_MMA(1, 0, At, B0); PG8_BAR; PG8_SCHED;
            PG8_STAGE(PG8_SB(0, 1), b2 + hstep, voffB);
            PG8_WAIT_V(6); PG8_BAR; PG8_MMA(1, 1, At, B1); PG8_BAR;
            PG8_LDB(B0, 1, 0); PG8_SCHED; PG8_LDA(At, 1, 0); PG8_STAGE(PG8_SA(0, 1), a2 + hstep, voffA);
            PG8_WAIT_L(8); PG8_BAR; PG8_WAIT_L(0); PG8_MMA(0, 0, At, B0); PG8_BAR; PG8_SCHED;
            PG8_LDB(B1, 1, 1); PG8_STAGE(PG8_SB(1, 0), b3, voffB);
            PG8_BAR; PG8_WAIT_L(0); PG8_MMA(0, 1, At, B1); PG8_BAR;
            PG8_LDA(At, 1, 1); PG8_STAGE(PG8_SA(1, 0), a3, voffA);
            PG8_BAR; PG8_WAIT_L(0); PG8_MMA(1, 0, At, B0); PG8_BAR; PG8_SCHED;
            PG8_STAGE(PG8_SB(1, 1), b3 + hstep, voffB);
            PG8_WAIT_V(6); PG8_BAR; PG8_MMA(1, 1, At, B1); PG8_BAR;
            }
        }
        if constexpr (ALIGN_EPI) { if (wr == 0) PG8_BAR; }
        if constexpr (Epi::DEFER_LAST) { if (!E.defer(cur)) E(acc, cur, wr, wc, fr, fq); S.done(cur); }
        else if constexpr (!Epi::AFTER_DRAIN) { E(acc, cur, wr, wc, fr, fq); S.done(cur); }
        if (!has_next) break;
#pragma unroll
        for (int a = 0; a < 2; ++a)
#pragma unroll
            for (int b = 0; b < 2; ++b)
#pragma unroll
                for (int m = 0; m < 4; ++m)
#pragma unroll
                    for (int n = 0; n < 2; ++n) acc[a][b][m][n] = (f32x4){0.f, 0.f, 0.f, 0.f};
        cur = nxt; cA = nA; cB = nB; ++ui;
        if constexpr (ALIGN_EPI) { if (wr == 1) PG8_BAR; }
    }
    PG8_WAIT_V(0);
    if constexpr (!ALIGN_EPI) { if (wr == 0) PG8_BAR; }
    PG8_BAR;
    if constexpr (Epi::AFTER_DRAIN) { E.fused(acc, cur, wr, wc, fr, fq, lds, wid, lane); S.done(cur); }
    if constexpr (Epi::DEFER_LAST) { if (E.defer(cur)) E.deferred(acc, cur, lds, wid); }
#undef PG8_SA
#undef PG8_SB
#undef PG8_STAGE
#undef PG8_LDA
#undef PG8_LDB
#undef PG8_MMA
#undef PG8_WAIT_V
#undef PG8_WAIT_L
#undef PG8_BAR
#undef PG8_SCHED
}
}

constexpr int NWAVES = 8;
#ifndef MK_N_LAUNCHES
#define MK_N_LAUNCHES 1
#endif

constexpr int DM = 1024, TP = 8192, MP = 16384, SB = 32, ST = 8, MT = 16640, NSEQ = 34;
constexpr int INW = 5120, INPAD = 5376, NHEAD = 32, FF = 2816, FF2 = 5632, AW = 3072;
constexpr float EPS = 1e-6f;
constexpr float QSCALE = 0.125f * 1.4426950408889634f;
constexpr size_t O_YP = 0, O_YS = 16777216, O_SSMP = 17039360, O_SSMS = 18087936, O_CONVP = 34865152, O_CONVS = 34902016, O_FFNP = 35491840, O_FFNS = 35581952,
                 O_KP = 37023744, O_KS = 49606656, O_VP = 50393088, O_VS = 62976000, O_END = 63762432;
enum { I_XP = 0, I_XS, I_SSM, I_CONV, I_FFNC, I_CK, I_CV, I_CP, I_CS, I_ADAW, I_ADAB, I_NMIX, I_NFFN, I_WIN, I_CW, I_CB, I_DTB, I_ALOG, I_D, I_MNORM, I_WOUT, I_KVN, I_KVAW, I_KVAB, I_WKV, I_WQ, I_WO, I_WUP, I_FCW, I_FCB, I_WDN, I_FN };

constexpr size_t MiB = 1u << 20;
constexpr size_t al(size_t x) { return (x + MiB - 1) / MiB * MiB; }
constexpr size_t WS_CTL = 0, CTL_ZERO_BYTES = 1 * MiB;
constexpr size_t WS_MOD = 1 * MiB;
constexpr size_t WS_ROPE = WS_MOD + al((size_t)5 * NSEQ * 6144 * 4);
constexpr size_t WS_DTRAW = WS_ROPE + al((size_t)8200 * 32 * 8);
constexpr size_t WS_DTV = WS_DTRAW + al((size_t)MT * 32 * 4);
constexpr size_t WS_ACUM = WS_DTV + al((size_t)MT * 32 * 4);
constexpr size_t WS_DECAY = WS_ACUM + al((size_t)MT * 32 * 4);
constexpr size_t WS_WIN = WS_DECAY + MiB;
constexpr size_t WS_WOUT = WS_WIN + al((size_t)2 * INPAD * 1024 * 2);
constexpr size_t WS_WUP = WS_WOUT + al((size_t)2 * 1024 * 2048 * 2);
constexpr size_t WS_WDN = WS_WUP + al((size_t)4 * FF2 * 1024 * 2);
constexpr size_t WS_WKV = WS_WDN + al((size_t)4 * 1024 * FF * 2);
constexpr size_t WS_WQ = WS_WKV + al((size_t)6144 * 1024 * 2);
constexpr size_t WS_WO = WS_WQ + al((size_t)2 * AW * 1024 * 2);
constexpr size_t WS_H = WS_WO + al((size_t)2 * 1024 * 1024 * 2);
constexpr size_t WS_XN = WS_H + al((size_t)MT * 1024 * 4);
constexpr size_t WS_XNKV = WS_XN + al((size_t)MT * 1024 * 2);
constexpr size_t WS_BIG = WS_XNKV + al((size_t)MT * 1024 * 2);
constexpr size_t WS_ACT = WS_BIG + al((size_t)MT * FF2 * 2);
constexpr size_t WS_CT = WS_ACT + al((size_t)MT * 3072 * 2);
constexpr size_t WS_STATES = WS_CT + al((size_t)2 * 2560 * 8192 * 2);
constexpr size_t WS_HPREV = WS_STATES + al((size_t)2 * 64 * 32 * 8192 * 4);
constexpr size_t WS_Y = WS_HPREV + al((size_t)2 * 64 * 32 * 8192 * 2);
constexpr size_t WS_KB = WS_Y + al((size_t)MT * 2048 * 2);
constexpr size_t WS_VB = WS_KB + al((size_t)MT * AW * 2);
constexpr size_t WS_QB = WS_VB + al((size_t)MT * AW * 2);
constexpr size_t WS_VT = WS_QB + al((size_t)MT * AW * 2) + MiB;
constexpr size_t WS_OB = WS_VT + al((size_t)2 * 48 * 64 * 8192 * 2) + MiB;
constexpr size_t WS_OG = WS_OB + al((size_t)MT * 1024 * 2);
constexpr size_t WS_ML = WS_OG + al((size_t)3 * MT * 1024 * 2);
constexpr size_t WS_SLAB = WS_ML + al((size_t)3 * MT * 16 * 8);
constexpr size_t WS_UB = WS_SLAB + 4 * MiB;
constexpr size_t WS_END = WS_UB + al((size_t)256 * 4 * 5632 * 4);
constexpr int CW_TMO = 0, CW_CODE = 1, CW_BAR = 4096;

constexpr int RING_OFF = 0, RING_BYTES = 147456;
constexpr int LDSCTL_OFF = RING_BYTES, MISC_OFF = LDSCTL_OFF + 320;
constexpr int LDS_BYTES = RING_BYTES + 1024;

#define GAS __attribute__((address_space(1)))
#define LAS __attribute__((address_space(3)))
typedef unsigned short bf16;
typedef unsigned v4u __attribute__((ext_vector_type(4)));
typedef unsigned v2u __attribute__((ext_vector_type(2)));
typedef float f32x4 __attribute__((ext_vector_type(4)));
typedef float f32x2 __attribute__((ext_vector_type(2)));
typedef short bf16x8 __attribute__((ext_vector_type(8)));
typedef short s16x4 __attribute__((ext_vector_type(4)));
typedef GAS unsigned gu32;
#define RLX_AGENT __ATOMIC_RELAXED, __HIP_MEMORY_SCOPE_AGENT
#define LDS_WAIT() asm volatile("s_waitcnt lgkmcnt(0)" ::: "memory")
#define VM_WAIT() asm volatile("s_waitcnt vmcnt(0)" ::: "memory")
__device__ __forceinline__ int lane_id_v() { int l; asm volatile("v_mbcnt_lo_u32_b32 %0, -1, 0\n\tv_mbcnt_hi_u32_b32 %0, -1, %0" : "=v"(l)); return l; }
__device__ __forceinline__ unsigned f2bf(float f) { unsigned u = __builtin_bit_cast(unsigned, f); return (u + 0x7fffu + ((u >> 16) & 1u)) >> 16; }
__device__ __forceinline__ unsigned pk2(float lo, float hi) { unsigned r; asm("v_cvt_pk_bf16_f32 %0, %1, %2" : "=v"(r) : "v"(lo), "v"(hi)); return r; }
__device__ __forceinline__ float bflo(unsigned w) { return __builtin_bit_cast(float, w << 16); }
__device__ __forceinline__ float bfhi(unsigned w) { return __builtin_bit_cast(float, w & 0xffff0000u); }
__device__ __forceinline__ float bf2f(bf16 h) { return __builtin_bit_cast(float, (unsigned)h << 16); }
__device__ __forceinline__ float silu(float x) { return x * __builtin_amdgcn_rcpf(1.0f + __expf(-x)); }
__device__ __forceinline__ float softplus(float x) { const float y = __expf(x);
    return x > 20.f ? x : (y < 0.03125f ? y * (1.0f + y * (-0.5f + y * (0.33333334f + y * (-0.25f + y * 0.2f)))) : __logf(1.0f + y)); }
__device__ __forceinline__ float row16_sum(float x) {
    x += __builtin_bit_cast(float, __builtin_amdgcn_update_dpp(0, __builtin_bit_cast(int, x), 0x128, 0xf, 0xf, false));
    x += __builtin_bit_cast(float, __builtin_amdgcn_update_dpp(0, __builtin_bit_cast(int, x), 0x124, 0xf, 0xf, false));
    x += __builtin_bit_cast(float, __builtin_amdgcn_update_dpp(0, __builtin_bit_cast(int, x), 0x122, 0xf, 0xf, false));
    x += __builtin_bit_cast(float, __builtin_amdgcn_update_dpp(0, __builtin_bit_cast(int, x), 0x121, 0xf, 0xf, false));
    return x;
}
__device__ __forceinline__ float wave_sum(float v) {
#pragma unroll
    for (int o = 1; o < 64; o <<= 1) v += __shfl_xor(v, o);
    return v;
}
__device__ __forceinline__ float wave_max(float v) {
#pragma unroll
    for (int o = 1; o < 64; o <<= 1) v = fmaxf(v, __shfl_xor(v, o));
    return v;
}
template <int N> struct TR {
    static __device__ __forceinline__ float run(float (&v)[N], int lane) {
        constexpr int H = N / 2; float r[H];
        const bool up = (lane & H) != 0;
#pragma unroll
        for (int i = 0; i < H; ++i) { const float keep = up ? v[i + H] : v[i], send = up ? v[i] : v[i + H]; r[i] = keep + __shfl_xor(send, H); }
        return TR<H>::run(r, lane);
    }
};
template <> struct TR<1> { static __device__ __forceinline__ float run(float (&v)[1], int) { return v[0]; } };

#define XB_TMO      128
#define XB_XCNT(j)  (256  + 64 * (j))
#define XB_XSUB(j)  (1280 + 64 * (j))
#define XB_XGEN(j)  (2304 + 64 * (j))
#define XB_TOP      3328
#define XB_TOPGEN   3392
#define XCD_BAR_WORDS 3456
#define XB_SPIN_CAP (1u << 18)

__device__ __forceinline__ unsigned xb_ld(unsigned* p)              { return __hip_atomic_load(p, __ATOMIC_RELAXED, __HIP_MEMORY_SCOPE_AGENT); }
__device__ __forceinline__ unsigned xb_add(unsigned* p, unsigned v) { return __hip_atomic_fetch_add(p, v, __ATOMIC_RELAXED, __HIP_MEMORY_SCOPE_AGENT); }
__device__ __forceinline__ unsigned xb_xcc_id() { return (unsigned)__builtin_amdgcn_s_getreg((3 << 11) | 20) & 0xFu; }
#define XB_SPIN(cond, bar) do { unsigned _sp = 0; while (cond) { __builtin_amdgcn_s_sleep(1); \
    if ((++_sp & 255u) == 0u) { if (xb_ld(&(bar)[XB_TMO])) break; if (_sp > XB_SPIN_CAP) { atomicAdd(&(bar)[XB_TMO], 1u); break; } } } } while (0)

struct XcdBarrier {
    unsigned* bar; unsigned x;
    volatile LAS unsigned* st; int wave;
};

__device__ __forceinline__ XcdBarrier xcd_barrier_post(unsigned* bar, volatile LAS unsigned* st) {
    XcdBarrier b; b.bar = bar; b.x = xb_xcc_id(); b.st = st;
    if (threadIdx.x == 0) (void)xb_add(&bar[XB_XCNT(b.x)], 1u);
    return b;
}
__device__ __forceinline__ void xcd_barrier_complete(unsigned* bar, unsigned x, unsigned& nloc, unsigned& nx) {
    const unsigned G = gridDim.x * gridDim.y * gridDim.z;
    unsigned sum, cnt, mine, sp = 0u;
    for (;;) {
        sum = 0u; cnt = 0u; mine = 0u;
#pragma unroll
        for (unsigned j = 0; j < 16; ++j) { const unsigned c = xb_ld(&bar[XB_XCNT(j)]); sum += c; cnt += (c > 0u) ? 1u : 0u; mine = (j == x) ? c : mine; }
        if (sum == G) break;
        __builtin_amdgcn_s_sleep(1);
        if ((++sp & 255u) == 0u) { if (xb_ld(&bar[XB_TMO])) break; if (sp > XB_SPIN_CAP) { atomicAdd(&bar[XB_TMO], 1u); break; } }
    }
    nloc = mine > 0u ? mine : 1u; nx = cnt > 0u ? cnt : 1u;
}

__device__ __forceinline__ void xcd_barrier(const XcdBarrier& b) {
    asm volatile("s_waitcnt vmcnt(0)" ::: "memory");
    __syncthreads();
    if (b.wave == 0 && lane_id_v() == 0) {
        unsigned* bar = b.bar;
        __builtin_amdgcn_s_waitcnt(0);
        unsigned nloc = b.st[0], nx = b.st[1];
        if (nloc == 0u) { xcd_barrier_complete(bar, b.x, nloc, nx); b.st[0] = nloc; b.st[1] = nx; }
        const unsigned old = xb_add(&bar[XB_XSUB(b.x)], 1u);
        const unsigned gen = old / nloc;
        if (old + 1u == (gen + 1u) * nloc) {
            __builtin_amdgcn_fence(__ATOMIC_RELEASE, "agent");
            asm volatile("s_waitcnt vmcnt(0)" ::: "memory");
            const unsigned og = xb_add(&bar[XB_TOP], 1u);
            const unsigned tg = og / nx;
            if (og + 1u == (tg + 1u) * nx) xb_add(&bar[XB_TOPGEN], 1u);
            else XB_SPIN(xb_ld(&bar[XB_TOPGEN]) == tg, bar);
            __builtin_amdgcn_fence(__ATOMIC_ACQUIRE, "agent");
            xb_add(&bar[XB_XGEN(b.x)], 1u);
            asm volatile("s_waitcnt vmcnt(0)" ::: "memory");
        } else {
            XB_SPIN(xb_ld(&bar[XB_XGEN(b.x)]) == gen, bar);
            __builtin_amdgcn_fence(__ATOMIC_ACQUIRE, "agent");
            asm volatile("s_waitcnt vmcnt(0)" ::: "memory");
        }
    }
    __syncthreads();
}

struct Frame {
    LAS unsigned char* lds;
    volatile LAS unsigned* MISC;
    gu32* ctl;
    int tid, lane, wave, G, vcu, pflags;
    const float* const* in; float* out; unsigned char* ws;
};
#define WSP(T, off) ((T*)(F.ws + (off)))

struct TrJob { const float* src; bf16* dst; int ldw, K, n0, k0, mode; };
__device__ __forceinline__ TrJob tr_job(const float* W, int ldw, int col_base, int K, int ncols, bf16* WT, int mode, int item) {
    const int nblk = ncols / 32, kb = item / nblk, nb = item % nblk; TrJob j; j.k0 = 64 * kb; j.n0 = 32 * nb; j.src = W + (size_t)j.k0 * ldw + col_base + j.n0; j.dst = WT; j.ldw = ldw; j.K = K; j.mode = mode; return j;
}
__device__ __forceinline__ void tr_load(const TrJob& j, f32x4 (&buf)[8], int lane) {
    const int r8 = lane >> 3, c4 = lane & 7;
#pragma unroll
    for (int i = 0; i < 8; ++i) buf[i] = *(const f32x4*)(j.src + (size_t)(8 * i + r8) * j.ldw + 4 * c4);
}
__device__ __forceinline__ void tr_store(const TrJob& j, const f32x4 (&buf)[8], LAS float* scr, int lane) {
    const int r8 = lane >> 3, c4 = lane & 7;
#pragma unroll
    for (int i = 0; i < 8; ++i) *(LAS f32x4*)(scr + (8 * i + r8) * 36 + 4 * c4) = buf[i];
    LDS_WAIT();
    const int c = lane & 7;
#pragma unroll
    for (int jj = 0; jj < 4; ++jj) { const int n = (lane >> 3) + 8 * jj; const LAS float* s = scr + (8 * c) * 36 + n;
        v4u o; o.x = pk2(s[0 * 36], s[1 * 36]); o.y = pk2(s[2 * 36], s[3 * 36]); o.z = pk2(s[4 * 36], s[5 * 36]); o.w = pk2(s[6 * 36], s[7 * 36]);
        int dn = j.n0 + n; if (j.mode == 1) { const int sidx = dn & 255; dn = (dn & ~255) + ((sidx >> 5) & 1) * 128 + (sidx >> 6) * 32 + (sidx & 31); }
        else if (j.mode == 2) { const int part = dn >= 2816 ? 1 : 0, c = dn - part * 2816; dn = (c >> 7) * 256 + part * 128 + (c & 127); }
        *(v4u*)(j.dst + (size_t)dn * j.K + j.k0 + 8 * c) = o; }
    LDS_WAIT();
}
__device__ __forceinline__ TrJob p0_job(Frame& F, int it) {
    constexpr int I_IN = 16 * 161, I_OUT = 32 * 32, I_UP = 16 * 176, I_DN = 44 * 32, I_KV = 16 * 96, I_Q = 16 * 96, I_O = 16 * 32;
    int r = it;
    if (r < 2 * I_IN) { const int L = r / I_IN; return tr_job(F.in[I_WIN] + (size_t)L * 1024 * 5152, 5152, 0, 1024, 5152, WSP(bf16, WS_WIN) + (size_t)L * INPAD * 1024, 0, r % I_IN); } r -= 2 * I_IN;
    if (r < 2 * I_OUT) { const int L = r / I_OUT; return tr_job(F.in[I_WOUT] + (size_t)L * 2048 * 1024, 1024, 0, 2048, 1024, WSP(bf16, WS_WOUT) + (size_t)L * 1024 * 2048, 0, r % I_OUT); } r -= 2 * I_OUT;
    if (r < 4 * I_UP) { const int L = r / I_UP; return tr_job(F.in[I_WUP] + (size_t)L * 1024 * FF2, FF2, 0, 1024, FF2, WSP(bf16, WS_WUP) + (size_t)L * FF2 * 1024, 2, r % I_UP); } r -= 4 * I_UP;
    if (r < 4 * I_DN) { const int L = r / I_DN; return tr_job(F.in[I_WDN] + (size_t)L * FF * 1024, 1024, 0, FF, 1024, WSP(bf16, WS_WDN) + (size_t)L * 1024 * FF, 0, r % I_DN); } r -= 4 * I_DN;
    if (r < 2 * I_KV) { const int hv = r / I_KV; return tr_job(F.in[I_WKV], 6144, hv * 3072, 1024, 3072, WSP(bf16, WS_WKV) + (size_t)hv * 3072 * 1024, hv == 0 ? 1 : 0, r % I_KV); } r -= 2 * I_KV;
    if (r < 2 * I_Q) { const int L = r / I_Q; return tr_job(F.in[I_WQ] + (size_t)L * 1024 * AW, AW, 0, 1024, AW, WSP(bf16, WS_WQ) + (size_t)L * AW * 1024, 1, r % I_Q); } r -= 2 * I_Q;
    { const int L = r / I_O; return tr_job(F.in[I_WO] + (size_t)L * 1024 * 1024, 1024, 0, 1024, 1024, WSP(bf16, WS_WO) + (size_t)L * 1024 * 1024, 0, r % I_O); }
}
__device__ __forceinline__ void p0_weights(Frame& F) {
    LAS float* scr = (LAS float*)(F.lds + RING_OFF + F.wave * 16384);
    const int gw = F.vcu * NWAVES + F.wave, NGW = F.G * NWAVES, lane = F.lane;
    constexpr int NITEMS = 2 * 16 * 161 + 2 * 32 * 32 + 4 * 16 * 176 + 4 * 44 * 32 + 2 * 16 * 96 + 2 * 16 * 96 + 2 * 16 * 32;
    f32x4 bA[8], bB[8]; TrJob jA, jB;
    int it = gw;
    if (it < NITEMS) { jA = p0_job(F, it); tr_load(jA, bA, lane); }
#pragma unroll 1
    for (; it < NITEMS; it += 2 * NGW) {
        const bool hasB = it + NGW < NITEMS, hasA2 = it + 2 * NGW < NITEMS;
        if (hasB) { jB = p0_job(F, it + NGW); tr_load(jB, bB, lane); }
        tr_store(jA, bA, scr, lane);
        if (hasA2) { jA = p0_job(F, it + 2 * NGW); tr_load(jA, bA, lane); }
        if (hasB) tr_store(jB, bB, scr, lane);
    }
    const int gt = F.vcu * (NWAVES * 64) + F.tid, NGT = F.G * NWAVES * 64;
    for (int i = gt; i < 2 * 224 * 128; i += NGT) { const int L = i / (224 * 128), j = i % (224 * 128);
        *(v4u*)(WSP(bf16, WS_WIN) + (size_t)L * INPAD * 1024 + (size_t)5152 * 1024 + (size_t)j * 8) = (v4u){0u, 0u, 0u, 0u}; }
    for (int i = gt; i < 8200 * 32; i += NGT) { const int pos = i >> 5, k = i & 31;
        const float inv = (float)exp(-(double)k * (9.210340371976184 / 32.0)); const float ang = (float)pos * inv;
        float s, c; sincosf(ang, &s, &c); *(f32x2*)(WSP(float, WS_ROPE) + (size_t)i * 2) = (f32x2){c, s}; }
}
__device__ __forceinline__ void p0_adaln(Frame& F) {
    LAS float* cs = (LAS float*)(F.lds + RING_OFF);
    LAS float* ob = (LAS float*)(F.lds + RING_OFF + 512 * 34 * 4);
    const int tid = F.tid, cq = F.lane, kq = F.wave;
    for (int chunk = blockIdx.x; chunk < 208; chunk += F.G) {
        const int l = chunk < 192 ? chunk / 48 : 4, cc = chunk < 192 ? chunk % 48 : chunk - 192;
        const float* W = l < 4 ? F.in[I_ADAW] + (size_t)l * 1024 * 6144 : F.in[I_KVAW]; const int ldw = l < 4 ? 6144 : 2048, col0 = cc * 128;
        const float* bias = l < 4 ? F.in[I_ADAB] + l * 6144 : F.in[I_KVAB];
        f32x2 acc[NSEQ];
#pragma unroll
        for (int s = 0; s < NSEQ; ++s) acc[s] = (f32x2){0.f, 0.f};
#pragma unroll 1
        for (int hf = 0; hf < 2; ++hf) {
            __syncthreads();
            int t1 = tid; asm volatile("" : "+v"(t1));
            { float cv[NSEQ];
#pragma unroll
              for (int i = 0; i < NSEQ; ++i) { const int idx = t1 + i * (NWAVES * 64), k = idx / NSEQ, s = idx % NSEQ;
                  cv[i] = s < 2 ? F.in[I_CP][s * 1024 + hf * 512 + k] : F.in[I_CS][(s - 2) * 1024 + hf * 512 + k]; }
              __builtin_amdgcn_sched_barrier(0);
#pragma unroll
              for (int i = 0; i < NSEQ; ++i) cs[t1 + i * (NWAVES * 64)] = silu(cv[i]); }
            __syncthreads();
            f32x2 wn[8];
#pragma unroll
            for (int i = 0; i < 8; ++i) wn[i] = *(const f32x2*)(W + (size_t)(hf * 512 + kq * 64 + i) * ldw + col0 + 2 * cq);
#pragma unroll 1
            for (int kk0 = 0; kk0 < 64; kk0 += 8) {
                f32x2 wv[8];
#pragma unroll
                for (int i = 0; i < 8; ++i) wv[i] = wn[i];
                if (kk0 + 8 < 64) {
#pragma unroll
                    for (int i = 0; i < 8; ++i) wn[i] = *(const f32x2*)(W + (size_t)(hf * 512 + kq * 64 + kk0 + 8 + i) * ldw + col0 + 2 * cq); }
                __builtin_amdgcn_sched_barrier(0);
#pragma unroll
                for (int i = 0; i < 8; ++i) { const int k = kq * 64 + kk0 + i;
#pragma unroll
                    for (int s2 = 0; s2 < NSEQ / 2; ++s2) { const f32x2 a = *(const LAS f32x2*)(cs + k * NSEQ + 2 * s2); acc[2 * s2] += a.x * wv[i]; acc[2 * s2 + 1] += a.y * wv[i]; } }
                __builtin_amdgcn_sched_barrier(0); }
        }
#pragma unroll 1
        for (int w = 0; w < NWAVES; ++w) {
            if (F.wave == w) {
#pragma unroll
                for (int s = 0; s < NSEQ; ++s) { LAS f32x2* p = (LAS f32x2*)(ob + s * 128 + 2 * cq); if (w == 0) *p = acc[s]; else *p = *p + acc[s]; } }
            __syncthreads();
        }
        int t2 = tid; asm volatile("" : "+v"(t2));
        for (int idx = t2; idx < NSEQ * 128; idx += NWAVES * 64) { const int s = idx >> 7, c = idx & 127;
            WSP(float, WS_MOD)[((size_t)l * NSEQ + s) * 6144 + col0 + c] = ob[idx] + bias[col0 + c]; }
    }
    __syncthreads();
}

__device__ __forceinline__ const float* rowsrc(const float* P, const float* S, int m) { return m < MP ? P + (size_t)m * 1024 : S + (size_t)(m - MP) * 1024; }
__device__ __forceinline__ int row_seq(int m) { return m < MP ? (m >> 13) : 2 + ((m - MP) >> 3); }
__device__ __forceinline__ float load_row_rstd(const float* xrow, int lane, f32x4 (&v)[4]) {
    const f32x4* xr = (const f32x4*)xrow + lane; float s = 0.f;
#pragma unroll
    for (int j = 0; j < 4; ++j) { v[j] = xr[64 * j]; s += (v[j].x * v[j].x + v[j].y * v[j].y) + (v[j].z * v[j].z + v[j].w * v[j].w); }
    return 1.0f / sqrtf(wave_sum(s) * (1.f / 1024.f) + EPS);
}
__device__ __forceinline__ void store_mod_row(const f32x4 (&v)[4], float rstd, const float* g, const float* mrow, int sh, int sc, bf16* orow, int lane) {
    unsigned long long* o8 = (unsigned long long*)orow + lane;
    f32x4 gv[4], sv[4], hv[4];
#pragma unroll
    for (int j = 0; j < 4; ++j) { const int col = 4 * lane + 256 * j; gv[j] = *(const f32x4*)(g + col); sv[j] = *(const f32x4*)(mrow + sc + col); hv[j] = *(const f32x4*)(mrow + sh + col); }
    __builtin_amdgcn_sched_barrier(0);
#pragma unroll
    for (int j = 0; j < 4; ++j) { const f32x4 r = v[j] * rstd * gv[j] * (sv[j] + 1.0f) + hv[j];
        o8[64 * j] = (unsigned long long)pk2(r.x, r.y) | ((unsigned long long)pk2(r.z, r.w) << 32); }
}
__device__ __forceinline__ float load_row_ssq(const float* xrow, int lane, f32x4 (&v)[4]) {
    const f32x4* xr = (const f32x4*)xrow + lane; float s = 0.f;
#pragma unroll
    for (int j = 0; j < 4; ++j) { v[j] = xr[64 * j]; s += (v[j].x * v[j].x + v[j].y * v[j].y) + (v[j].z * v[j].z + v[j].w * v[j].w); }
    return s;
}
struct Pend { const float* slab; const float* gate; const float* in; float* hout; };
__device__ __forceinline__ float load_row_any(const Pend& pd, const float* P, const float* S, int m, int lane, f32x4 (&v)[4]) {
    if (pd.slab == nullptr || m < MP) return load_row_ssq(rowsrc(P, S, m), lane, v);
    const int r = m - MP; const float* gp = pd.gate + (size_t)(2 + (r >> 3)) * 6144; float s = 0.f;
    f32x4 p0[4], p1[4], p2[4], p3[4], xin[4], gt[4];
#pragma unroll
    for (int j = 0; j < 4; ++j) { const int col = 4 * lane + 256 * j; const size_t o = (size_t)r * 1024 + col;
        p0[j] = *(const f32x4*)(pd.slab + o); p1[j] = *(const f32x4*)(pd.slab + 262144 + o); p2[j] = *(const f32x4*)(pd.slab + 524288 + o); p3[j] = *(const f32x4*)(pd.slab + 786432 + o);
        xin[j] = *(const f32x4*)(pd.in + o); gt[j] = *(const f32x4*)(gp + col); }
    __builtin_amdgcn_sched_barrier(0);
#pragma unroll
    for (int j = 0; j < 4; ++j) { const int col = 4 * lane + 256 * j; const size_t o = (size_t)r * 1024 + col;
        const f32x4 p = (p0[j] + p1[j]) + (p2[j] + p3[j]);
        v[j] = xin[j] + gt[j] * p; *(f32x4*)(pd.hout + o) = v[j];
        s += (v[j].x * v[j].x + v[j].y * v[j].y) + (v[j].z * v[j].z + v[j].w * v[j].w); }
    return s;
}
struct ModV { f32x4 a[4], h[4]; };
__device__ __forceinline__ void modv_load(ModV& M, const float* g, const float* mrow, int sh, int sc, int lane) {
    f32x4 gv[4], sv[4];
#pragma unroll
    for (int j = 0; j < 4; ++j) { const int col = 4 * lane + 256 * j; gv[j] = *(const f32x4*)(g + col); sv[j] = *(const f32x4*)(mrow + sc + col); M.h[j] = *(const f32x4*)(mrow + sh + col); }
    __builtin_amdgcn_sched_barrier(0);
#pragma unroll
    for (int j = 0; j < 4; ++j) M.a[j] = gv[j] * (sv[j] + 1.0f);
}
template <bool BF> struct RowRaw;
template <> struct RowRaw<false> { f32x4 v[4];
    __device__ __forceinline__ void load(const void* base, int m, int lane) { const f32x4* xr = (const f32x4*)((const float*)base + (size_t)m * 1024) + lane;
#pragma unroll
        for (int j = 0; j < 4; ++j) v[j] = xr[64 * j]; }
    __device__ __forceinline__ void get(f32x4 (&f)[4]) const {
#pragma unroll
        for (int j = 0; j < 4; ++j) f[j] = v[j]; } };
template <> struct RowRaw<true> { v2u v[4];
    __device__ __forceinline__ void load(const void* base, int m, int lane) { const v2u* xr = (const v2u*)((const bf16*)base + (size_t)m * 1024) + lane;
#pragma unroll
        for (int j = 0; j < 4; ++j) v[j] = xr[64 * j]; }
    __device__ __forceinline__ void get(f32x4 (&f)[4]) const {
#pragma unroll
        for (int j = 0; j < 4; ++j) f[j] = (f32x4){bflo(v[j].x), bfhi(v[j].x), bflo(v[j].y), bfhi(v[j].y)}; } };
__device__ __forceinline__ float row_rstd(const f32x4 (&v)[4]) { float s = 0.f;
#pragma unroll
    for (int j = 0; j < 4; ++j) s += (v[j].x * v[j].x + v[j].y * v[j].y) + (v[j].z * v[j].z + v[j].w * v[j].w);
    return 1.0f / sqrtf(wave_sum(s) * (1.f / 1024.f) + EPS); }
__device__ __forceinline__ void store_modv_row(const f32x4 (&v)[4], float rstd, const ModV& M, bf16* orow, int lane) {
    unsigned long long* o8 = (unsigned long long*)orow + lane;
#pragma unroll
    for (int j = 0; j < 4; ++j) { const f32x4 r = v[j] * rstd * M.a[j] + M.h[j]; o8[64 * j] = (unsigned long long)pk2(r.x, r.y) | ((unsigned long long)pk2(r.z, r.w) << 32); }
}
template <int NOUT, bool BF>
__device__ __forceinline__ void norm_rows(Frame& F, const Pend pd, const void* P, const float* S, const float* g1, const float* mod1, int sh1, int sc1, bf16* out1, const float* g2, const float* mod2, int sh2, int sc2, bf16* out2) {
    const int gw = F.vcu * NWAVES + F.wave, NGW = F.G * NWAVES, lane = F.lane;
    if (NGW == 2048) {
        RowRaw<BF> va, vb;
        va.load(P, gw, lane); vb.load(P, gw + 2048, lane);
        ModV M1, M2;
#pragma unroll 1
        for (int i = 0; i < 4; ++i) {
            const int m = gw + 4096 * i;
            if ((i & 1) == 0) { modv_load(M1, g1, mod1 + (size_t)(i >> 1) * 6144, sh1, sc1, lane); if (NOUT == 2) modv_load(M2, g2, mod2 + (size_t)(i >> 1) * 6144, sh2, sc2, lane); }
            RowRaw<BF> na, nb;
            if (i < 3) { na.load(P, m + 4096, lane); nb.load(P, m + 6144, lane); }
            __builtin_amdgcn_sched_barrier(0);
            f32x4 fa[4], fb[4]; va.get(fa); vb.get(fb);
            const float ra = row_rstd(fa), rb = row_rstd(fb);
            store_modv_row(fa, ra, M1, out1 + (size_t)m * 1024, lane); store_modv_row(fb, rb, M1, out1 + (size_t)(m + 2048) * 1024, lane);
            if (NOUT == 2) { store_modv_row(fa, ra, M2, out2 + (size_t)m * 1024, lane); store_modv_row(fb, rb, M2, out2 + (size_t)(m + 2048) * 1024, lane); }
            __builtin_amdgcn_sched_barrier(0);
            if (i < 3) { va = na; vb = nb; }
        }
        if (F.wave == 0) { const int m = MP + F.vcu; f32x4 v[4]; const float rs = 1.0f / sqrtf(wave_sum(load_row_any(pd, S, S, m, lane, v)) * (1.f / 1024.f) + EPS); const int seq = row_seq(m);
            store_mod_row(v, rs, g1, mod1 + (size_t)seq * 6144, sh1, sc1, out1 + (size_t)m * 1024, lane);
            if (NOUT == 2) store_mod_row(v, rs, g2, mod2 + (size_t)seq * 6144, sh2, sc2, out2 + (size_t)m * 1024, lane); }
        return;
    }
    for (int m = gw; m < MT; m += NGW) { f32x4 v[4]; float rs;
        if (m < MP) { RowRaw<BF> r; r.load(P, m, lane); r.get(v); rs = row_rstd(v); }
        else rs = 1.0f / sqrtf(wave_sum(load_row_any(pd, S, S, m, lane, v)) * (1.f / 1024.f) + EPS);
        const int seq = row_seq(m);
        store_mod_row(v, rs, g1, mod1 + (size_t)seq * 6144, sh1, sc1, out1 + (size_t)m * 1024, lane);
        if (NOUT == 2) store_mod_row(v, rs, g2, mod2 + (size_t)seq * 6144, sh2, sc2, out2 + (size_t)m * 1024, lane); }
}
__device__ __forceinline__ void final_norm_phase(Frame& F, const Pend pd, const bf16* HB, const float* HSr, const float* g, float* out) {
    const int gw = F.vcu * NWAVES + F.wave, NGW = F.G * NWAVES, lane = F.lane;
    f32x4 gv[4];
#pragma unroll
    for (int j = 0; j < 4; ++j) gv[j] = *(const f32x4*)(g + 4 * lane + 256 * j);
    if (NGW == 2048) {
        RowRaw<true> va, vb;
        va.load(HB, gw, lane); vb.load(HB, gw + 2048, lane);
#pragma unroll 1
        for (int i = 0; i < 4; ++i) {
            const int m = gw + 4096 * i;
            RowRaw<true> na, nb;
            if (i < 3) { na.load(HB, m + 4096, lane); nb.load(HB, m + 6144, lane); }
            __builtin_amdgcn_sched_barrier(0);
            f32x4 fa[4], fb[4]; va.get(fa); vb.get(fb);
            const float ra = row_rstd(fa), rb = row_rstd(fb);
            f32x4* oa = (f32x4*)(out + (size_t)m * 1024) + lane; f32x4* ob = (f32x4*)(out + (size_t)(m + 2048) * 1024) + lane;
#pragma unroll
            for (int j = 0; j < 4; ++j) { oa[64 * j] = fa[j] * ra * gv[j]; ob[64 * j] = fb[j] * rb * gv[j]; }
            __builtin_amdgcn_sched_barrier(0);
            if (i < 3) { va = na; vb = nb; }
        }
        if (F.wave == 0) { const int m = MP + F.vcu; f32x4 v[4]; const float rstd = 1.0f / sqrtf(wave_sum(load_row_any(pd, HSr, HSr, m, lane, v)) * (1.f / 1024.f) + EPS);
            f32x4* o = (f32x4*)(out + (size_t)m * 1024) + lane;
#pragma unroll
            for (int j = 0; j < 4; ++j) o[64 * j] = v[j] * rstd * gv[j]; }
        return;
    }
    for (int m = gw; m < MT; m += NGW) { f32x4 v[4]; float rstd;
        if (m < MP) { RowRaw<true> r; r.load(HB, m, lane); r.get(v); rstd = row_rstd(v); }
        else rstd = 1.0f / sqrtf(wave_sum(load_row_any(pd, HSr, HSr, m, lane, v)) * (1.f / 1024.f) + EPS);
        f32x4* o = (f32x4*)(out + (size_t)m * 1024) + lane;
#pragma unroll
        for (int j = 0; j < 4; ++j) o[64 * j] = v[j] * rstd * gv[j]; }
}


__device__ __forceinline__ void unpack4(const v2u w, float (&x)[4]) { x[0] = bflo(w.x); x[1] = bfhi(w.x); x[2] = bflo(w.y); x[3] = bfhi(w.y); }
struct CvIn { v2u x[11]; f32x4 st[3]; f32x4 w[4], bias; };
__device__ __forceinline__ void cvm_load(Frame& F, int L, int u, int lane, CvIn& I) {
    const bf16* Z = WSP(bf16, WS_BIG); const float* st = F.in[I_CONV] + (size_t)L * 32 * 3 * 3072;
    const int rb = u / 48, cgp = u % 48, ch0 = cgp * 64 + 4 * (lane & 15), seg = lane >> 4, row0 = rb * 32 + seg * 8; const bool sample = rb >= 512;
#pragma unroll
    for (int r = 3; r < 11; ++r) I.x[r] = *(const v2u*)(Z + (size_t)(row0 + r - 3) * 5120 + 2048 + ch0);
    { const float* cw = F.in[I_CW] + (size_t)L * 4 * 3072; const float* cb = F.in[I_CB] + (size_t)L * 3072;
#pragma unroll
      for (int k = 0; k < 4; ++k) I.w[k] = *(const f32x4*)(cw + k * 3072 + ch0);
      I.bias = *(const f32x4*)(cb + ch0); }
    if (sample) { const int b = (row0 - MP) >> 3;
#pragma unroll
        for (int r = 0; r < 3; ++r) I.st[r] = *(const f32x4*)(st + ((size_t)b * 3 + r) * 3072 + ch0); }
    else if ((row0 & 8191) != 0) {
#pragma unroll
        for (int r = 0; r < 3; ++r) I.x[r] = *(const v2u*)(Z + (size_t)(row0 + r - 3) * 5120 + 2048 + ch0); }
    else {
#pragma unroll
        for (int r = 0; r < 3; ++r) I.x[r] = (v2u){0u, 0u}; }
}
__device__ __forceinline__ void cvm_compute(Frame& F, int L, int u, int lane, const CvIn& I) {
    bf16* A = WSP(bf16, WS_ACT); bf16* CT = WSP(bf16, WS_CT);
    const float* cw = F.in[I_CW] + (size_t)L * 4 * 3072; const float* cb = F.in[I_CB] + (size_t)L * 3072;
    float* convP = F.out + O_CONVP + (size_t)L * 2 * 3 * 3072; float* convS = F.out + O_CONVS + (size_t)L * 32 * 3 * 3072;
    const int rb = u / 48, cgp = u % 48, ch0 = cgp * 64 + 4 * (lane & 15), seg = lane >> 4, row0 = rb * 32 + seg * 8; const bool sample = rb >= 512;
    float xw[11][4];
#pragma unroll
    for (int r = 3; r < 11; ++r) unpack4(I.x[r], xw[r]);
    if (sample) {
#pragma unroll
        for (int r = 0; r < 3; ++r) { xw[r][0] = I.st[r].x; xw[r][1] = I.st[r].y; xw[r][2] = I.st[r].z; xw[r][3] = I.st[r].w; } }
    else {
#pragma unroll
        for (int r = 0; r < 3; ++r) unpack4(I.x[r], xw[r]); }
    f32x4 w[4];
#pragma unroll
    for (int k = 0; k < 4; ++k) w[k] = I.w[k];
    const f32x4 bias = I.bias;
    float o[8][4];
#pragma unroll
    for (int tt = 0; tt < 8; ++tt)
#pragma unroll
        for (int c = 0; c < 4; ++c) o[tt][c] = silu(bias[c] + w[0][c] * xw[tt][c] + w[1][c] * xw[tt + 1][c] + w[2][c] * xw[tt + 2][c] + w[3][c] * xw[tt + 3][c]);
    if (sample || cgp >= 32) {
#pragma unroll
        for (int tt = 0; tt < 8; ++tt) *(v2u*)(A + (size_t)(row0 + tt) * 3072 + ch0) = (v2u){pk2(o[tt][0], o[tt][1]), pk2(o[tt][2], o[tt][3])}; }
    if (!sample && cgp < 40) { const int b = row0 >> 13, t0 = row0 & 8191;
#pragma unroll
        for (int c = 0; c < 4; ++c) *(v4u*)(CT + (size_t)(b * 2560 + ch0 + c) * 8192 + t0) = (v4u){pk2(o[0][c], o[1][c]), pk2(o[2][c], o[3][c]), pk2(o[4][c], o[5][c]), pk2(o[6][c], o[7][c])}; }
    if (sample) { const int b = (row0 - MP) >> 3;
#pragma unroll
        for (int j = 0; j < 3; ++j) *(f32x4*)(convS + ((size_t)b * 3 + j) * 3072 + ch0) = (f32x4){xw[8 + j][0], xw[8 + j][1], xw[8 + j][2], xw[8 + j][3]}; }
    else if ((row0 & 8191) == 8184) { const int b = row0 >> 13;
#pragma unroll
        for (int j = 0; j < 3; ++j) *(f32x4*)(convP + ((size_t)b * 3 + j) * 3072 + ch0) = (f32x4){xw[8 + j][0], xw[8 + j][1], xw[8 + j][2], xw[8 + j][3]}; }
}
__device__ __forceinline__ void conv_mamba_phase(Frame& F, int L) {
    const int gw = F.vcu * NWAVES + F.wave, NGW = F.G * NWAVES, lane = F.lane; constexpr int NU = 520 * 48;
    CvIn A, B; int u = gw;
    if (u < NU) cvm_load(F, L, u, lane, A);
#pragma unroll 1
    for (; u < NU; u += 2 * NGW) {
        const bool hasB = u + NGW < NU, hasA2 = u + 2 * NGW < NU;
        if (hasB) cvm_load(F, L, u + NGW, lane, B);
        cvm_compute(F, L, u, lane, A);
        if (hasA2) cvm_load(F, L, u + 2 * NGW, lane, A);
        if (hasB) cvm_compute(F, L, u + NGW, lane, B);
    }
}
struct FfIn { v2u x[2][10]; f32x4 st[2][2]; };
__device__ __forceinline__ void cvf_load(Frame& F, int L, int u, int lane, FfIn& I) {
    const bf16* U = WSP(bf16, WS_BIG); const float* st = F.in[I_FFNC] + (size_t)L * 32 * 2 * FF2;
    const int rb = u / 44, cgp = u % 44, ch0 = cgp * 64 + 4 * (lane & 15), seg = lane >> 4, row0 = rb * 32 + seg * 8; const bool sample = rb >= 512;
#pragma unroll
    for (int part = 0; part < 2; ++part) { const int ch = ch0 + part * FF;
#pragma unroll
        for (int r = 2; r < 10; ++r) I.x[part][r] = *(const v2u*)(U + (size_t)(row0 + r - 2) * FF2 + ch);
        if (sample) { const int b = (row0 - MP) >> 3;
#pragma unroll
            for (int r = 0; r < 2; ++r) I.st[part][r] = *(const f32x4*)(st + ((size_t)b * 2 + r) * FF2 + ch); }
        else if ((row0 & 8191) != 0) {
#pragma unroll
            for (int r = 0; r < 2; ++r) I.x[part][r] = *(const v2u*)(U + (size_t)(row0 + r - 2) * FF2 + ch); }
        else {
#pragma unroll
            for (int r = 0; r < 2; ++r) I.x[part][r] = (v2u){0u, 0u}; } }
}
__device__ __forceinline__ void cvf_compute(Frame& F, int L, int u, int lane, const FfIn& I) {
    bf16* Gh = WSP(bf16, WS_ACT);
    const float* fw = F.in[I_FCW] + (size_t)L * 3 * FF2; const float* fb = F.in[I_FCB] + (size_t)L * FF2;
    float* ffnP = F.out + O_FFNP + (size_t)L * 2 * 2 * FF2; float* ffnS = F.out + O_FFNS + (size_t)L * 32 * 2 * FF2;
    const int rb = u / 44, cgp = u % 44, ch0 = cgp * 64 + 4 * (lane & 15), seg = lane >> 4, row0 = rb * 32 + seg * 8; const bool sample = rb >= 512;
    float og[8][4];
#pragma unroll
    for (int part = 0; part < 2; ++part) {
        const int ch = ch0 + part * FF;
        float xw[10][4];
#pragma unroll
        for (int r = 2; r < 10; ++r) unpack4(I.x[part][r], xw[r]);
        if (sample) {
#pragma unroll
            for (int r = 0; r < 2; ++r) { xw[r][0] = I.st[part][r].x; xw[r][1] = I.st[part][r].y; xw[r][2] = I.st[part][r].z; xw[r][3] = I.st[part][r].w; } }
        else {
#pragma unroll
            for (int r = 0; r < 2; ++r) unpack4(I.x[part][r], xw[r]); }
        f32x4 w[3];
#pragma unroll
        for (int k = 0; k < 3; ++k) w[k] = *(const f32x4*)(fw + k * FF2 + ch);
        const f32x4 bias = *(const f32x4*)(fb + ch);
#pragma unroll
        for (int tt = 0; tt < 8; ++tt)
#pragma unroll
            for (int c = 0; c < 4; ++c) { const float a = bias[c] + w[0][c] * xw[tt][c] + w[1][c] * xw[tt + 1][c] + w[2][c] * xw[tt + 2][c];
                if (part == 0) og[tt][c] = silu(a); else og[tt][c] *= a; }
        if (sample) { const int b = (row0 - MP) >> 3;
#pragma unroll
            for (int j = 0; j < 2; ++j) *(f32x4*)(ffnS + ((size_t)b * 2 + j) * FF2 + ch) = (f32x4){xw[8 + j][0], xw[8 + j][1], xw[8 + j][2], xw[8 + j][3]}; }
        else if ((row0 & 8191) == 8184) { const int b = row0 >> 13;
#pragma unroll
            for (int j = 0; j < 2; ++j) *(f32x4*)(ffnP + ((size_t)b * 2 + j) * FF2 + ch) = (f32x4){xw[8 + j][0], xw[8 + j][1], xw[8 + j][2], xw[8 + j][3]}; }
    }
#pragma unroll
    for (int tt = 0; tt < 8; ++tt) *(v2u*)(Gh + (size_t)(row0 + tt) * FF + ch0) = (v2u){pk2(og[tt][0], og[tt][1]), pk2(og[tt][2], og[tt][3])};
}
__device__ __forceinline__ void conv_ffn_phase(Frame& F, int L) {
    const int gw = F.vcu * NWAVES + F.wave, NGW = F.G * NWAVES, lane = F.lane; constexpr int NU = 520 * 44;
    FfIn A, B; int u = gw;
    if (u < NU) cvf_load(F, L, u, lane, A);
#pragma unroll 1
    for (; u < NU; u += 2 * NGW) {
        const bool hasB = u + NGW < NU, hasA2 = u + 2 * NGW < NU;
        if (hasB) cvf_load(F, L, u + NGW, lane, B);
        cvf_compute(F, L, u, lane, A);
        if (hasA2) cvf_load(F, L, u + 2 * NGW, lane, A);
        if (hasB) cvf_compute(F, L, u + NGW, lane, B);
    }
}

struct FxIn { f32x4 u0[2], u1[2], u2[2], b[2], w0[2], w1[2], w2[2]; };
__device__ __forceinline__ void fx_load(FxIn& I, const float* UB, const float* fw, const float* fb, int pm, int i) {
    const int ri = i / 704, cq = i % 704, ch = 4 * cq, k = ri & 1, row = pm * 256 + (ri >> 1) * 64 + k, blk = row >> 6, t = row & 8191;
#pragma unroll
    for (int pt = 0; pt < 2; ++pt) { const int c = pt * 2816 + ch; const f32x4 z4 = (f32x4){0.f, 0.f, 0.f, 0.f};
        I.u0[pt] = *(const f32x4*)(UB + ((size_t)blk * 4 + k) * 5632 + c);
        I.u1[pt] = k == 1 ? *(const f32x4*)(UB + ((size_t)blk * 4 + 0) * 5632 + c) : (t >= 1 ? *(const f32x4*)(UB + ((size_t)(blk - 1) * 4 + 3) * 5632 + c) : z4);
        I.u2[pt] = t >= 2 ? *(const f32x4*)(UB + ((size_t)(blk - 1) * 4 + (k == 1 ? 3 : 2)) * 5632 + c) : z4;
        I.b[pt] = *(const f32x4*)(fb + c); I.w0[pt] = *(const f32x4*)(fw + c); I.w1[pt] = *(const f32x4*)(fw + 5632 + c); I.w2[pt] = *(const f32x4*)(fw + 2 * 5632 + c); }
}
__device__ __forceinline__ void fx_store(const FxIn& I, bf16* Gh, int pm, int i) {
    const int ri = i / 704, cq = i % 704, ch = 4 * cq, k = ri & 1, row = pm * 256 + (ri >> 1) * 64 + k;
    f32x4 a[2];
#pragma unroll
    for (int pt = 0; pt < 2; ++pt) a[pt] = I.b[pt] + I.w0[pt] * I.u2[pt] + I.w1[pt] * I.u1[pt] + I.w2[pt] * I.u0[pt];
    *(v2u*)(Gh + (size_t)row * FF + ch) = (v2u){pk2(silu(a[0][0]) * a[1][0], silu(a[0][1]) * a[1][1]), pk2(silu(a[0][2]) * a[1][2], silu(a[0][3]) * a[1][3])};
}
__device__ __forceinline__ void ffn_fixup(Frame& F, int L, int pm) {
    const float* UB = WSP(float, WS_UB); bf16* Gh = WSP(bf16, WS_ACT);
    const float* fw = F.in[I_FCW] + (size_t)L * 3 * FF2; const float* fb = F.in[I_FCB] + (size_t)L * FF2;
    int i = F.tid;
#pragma unroll 1
    for (; i + NWAVES * 64 < 8 * 704; i += 2 * NWAVES * 64) { FxIn A, B; fx_load(A, UB, fw, fb, pm, i); fx_load(B, UB, fw, fb, pm, i + NWAVES * 64);
        __builtin_amdgcn_sched_barrier(0);
        fx_store(A, Gh, pm, i); fx_store(B, Gh, pm, i + NWAVES * 64);
        __builtin_amdgcn_sched_barrier(0); }
    if (i < 8 * 704) { FxIn A; fx_load(A, UB, fw, fb, pm, i); fx_store(A, Gh, pm, i); }
    VM_WAIT(); __syncthreads();
}

#define MFMA16(a, b, c) __builtin_amdgcn_mfma_f32_16x16x32_bf16((a), (b), (c), 0, 0, 0)
__device__ __forceinline__ void ssd_s1_phase(Frame& F, int L) {
    const float* dtraw = WSP(float, WS_DTRAW); float* dtv = WSP(float, WS_DTV); float* acum = WSP(float, WS_ACUM); float* decay = WSP(float, WS_DECAY);
    const bf16* CT = WSP(bf16, WS_CT); bf16* STS = WSP(bf16, WS_STATES);
    const int gw = F.vcu * NWAVES + F.wave, NGW = F.G * NWAVES, lane = F.lane, fr = lane & 15, fq = lane >> 4;
    const bool light = F.G == 256 && (int)blockIdx.x < 128;
    const int wv = (int)blockIdx.x * NWAVES + F.wave;
    const int ufirst = F.G == 256 ? (light ? wv : 1024 + (wv - 1024) * 3) : gw, ucnt = F.G == 256 ? (light ? 1 : 3) : 0;
    for (int ui = 0, u = ufirst; F.G == 256 ? ui < ucnt : u < 4096; ++ui, u = F.G == 256 ? ufirst + ui : u + NGW) {
        const int hd = u & 31, c = (u >> 5) & 63, b = u >> 11, g = hd >> 3;
        const float Aneg = -__expf(F.in[I_ALOG][L * 32 + hd]), dtb = F.in[I_DTB][L * 32 + hd];
        const int rowc = b * 8192 + c * 128, tc = c * 128;
        const float dt0 = softplus(dtraw[(size_t)(rowc + 2 * lane) * 32 + hd] + dtb), dt1 = softplus(dtraw[(size_t)(rowc + 2 * lane + 1) * 32 + hd] + dtb);
        const float a0 = dt0 * Aneg, a1 = dt1 * Aneg;
        float incl = a0 + a1;
#pragma unroll
        for (int o = 1; o < 64; o <<= 1) { const float t = __shfl_up(incl, o); if (lane >= o) incl += t; }
        const float excl = incl - (a0 + a1), ac0 = excl + a0, ac1 = ac0 + a1, total = __shfl(incl, 63);
        dtv[(size_t)(rowc + 2 * lane) * 32 + hd] = dt0; dtv[(size_t)(rowc + 2 * lane + 1) * 32 + hd] = dt1;
        acum[(size_t)(rowc + 2 * lane) * 32 + hd] = ac0; acum[(size_t)(rowc + 2 * lane + 1) * 32 + hd] = ac1;
        if (lane == 0) decay[(b * 64 + c) * 32 + hd] = __expf(total);
        const float w0 = dt0 * __expf(total - ac0), w1 = dt1 * __expf(total - ac1);
        f32x4 acc[8][4];
#pragma unroll
        for (int nt = 0; nt < 8; ++nt)
#pragma unroll
            for (int pt = 0; pt < 4; ++pt) acc[nt][pt] = (f32x4){0.f, 0.f, 0.f, 0.f};
        const bf16* CTb = CT + (size_t)b * 2560 * 8192 + tc;
#pragma unroll 1
        for (int ks = 0; ks < 4; ++ks) {
            float wv[8];
#pragma unroll
            for (int jp = 0; jp < 4; ++jp) { const int sl = 16 * ks + 4 * fq + jp; wv[2 * jp] = __shfl(w0, sl); wv[2 * jp + 1] = __shfl(w1, sl); }
            v4u raw[4]; bf16x8 a[8];
#pragma unroll
            for (int pt = 0; pt < 4; ++pt) raw[pt] = *(const v4u*)(CTb + (size_t)(hd * 64 + 16 * pt + fr) * 8192 + 32 * ks + 8 * fq);
#pragma unroll
            for (int nt = 0; nt < 8; ++nt) a[nt] = *(const bf16x8*)(CTb + (size_t)(2048 + g * 128 + 16 * nt + fr) * 8192 + 32 * ks + 8 * fq);
            __builtin_amdgcn_sched_barrier(0);
            bf16x8 xb[4];
#pragma unroll
            for (int pt = 0; pt < 4; ++pt) {
                v4u sc; sc.x = pk2(bflo(raw[pt].x) * wv[0], bfhi(raw[pt].x) * wv[1]); sc.y = pk2(bflo(raw[pt].y) * wv[2], bfhi(raw[pt].y) * wv[3]);
                sc.z = pk2(bflo(raw[pt].z) * wv[4], bfhi(raw[pt].z) * wv[5]); sc.w = pk2(bflo(raw[pt].w) * wv[6], bfhi(raw[pt].w) * wv[7]); xb[pt] = __builtin_bit_cast(bf16x8, sc); }
#pragma unroll
            for (int nt = 0; nt < 8; ++nt)
#pragma unroll
                for (int pt = 0; pt < 4; ++pt) acc[nt][pt] = MFMA16(a[nt], xb[pt], acc[nt][pt]);
            __builtin_amdgcn_sched_barrier(0);
        }
        bf16* sp = STS + (size_t)((b * 64 + c) * 32 + hd) * 8192;
#pragma unroll
        for (int nt = 0; nt < 8; ++nt)
#pragma unroll
            for (int pt = 0; pt < 4; ++pt) *(v2u*)(sp + (16 * pt + fr) * 128 + 16 * nt + 4 * fq) = (v2u){pk2(acc[nt][pt][0], acc[nt][pt][1]), pk2(acc[nt][pt][2], acc[nt][pt][3])};
    }
}
__device__ __forceinline__ void ssd_sample_phase(Frame& F, int L) {
    const float* dtraw = WSP(float, WS_DTRAW); const bf16* ACT = WSP(bf16, WS_ACT); const bf16* Z = WSP(bf16, WS_BIG); bf16* Y = WSP(bf16, WS_Y);
    LAS float* part = (LAS float*)(F.lds + RING_OFF);
    LAS float* yb = (LAS float*)(F.lds + RING_OFF + 4096 + F.wave * 2048);
    const int lane = F.lane;
    for (int u = blockIdx.x; u < 128; u += F.G) {
        const int b = u >> 2, g = u & 3, hd = 8 * g + F.wave;
        const float Aneg = -__expf(F.in[I_ALOG][L * 32 + hd]), dtb = F.in[I_DTB][L * 32 + hd], Dh = F.in[I_D][L * 32 + hd];
        const float dt_l = softplus(dtraw[(size_t)(MP + b * 8 + (lane & 7)) * 32 + hd] + dtb);
        const float* h0 = F.in[I_SSM] + ((size_t)(L * 32 + b) * 32 + hd) * 8192;
        float* hs = F.out + O_SSMS + ((size_t)(L * 32 + b) * 32 + hd) * 8192;
#pragma unroll 1
        for (int ph = 0; ph < 2; ++ph) {
            f32x2 h[32];
#pragma unroll
            for (int i = 0; i < 32; ++i) h[i] = *(const f32x2*)(h0 + (32 * ph + i) * 128 + 2 * lane);
            const bf16* arow = ACT + (size_t)(MP + b * 8) * 3072;
            float xl_n = bf2f(arow[hd * 64 + lane]); unsigned bw_n = *(const unsigned*)(arow + 2048 + g * 128 + 2 * lane), cw_n = *(const unsigned*)(arow + 2560 + g * 128 + 2 * lane);
#pragma unroll 1
            for (int t = 0; t < 8; ++t) {
                const float dt = __shfl(dt_l, t), dA = __expf(dt * Aneg);
                const float xl = xl_n; const unsigned bw = bw_n, cw = cw_n;
                if (t < 7) { const bf16* nrow = arow + (size_t)(t + 1) * 3072;
                    xl_n = bf2f(nrow[hd * 64 + lane]); bw_n = *(const unsigned*)(nrow + 2048 + g * 128 + 2 * lane); cw_n = *(const unsigned*)(nrow + 2560 + g * 128 + 2 * lane); }
                const float B0 = bflo(bw), B1 = bfhi(bw), C0 = bflo(cw), C1 = bfhi(cw);
                float yp[32];
#pragma unroll
                for (int i = 0; i < 32; ++i) { const float coef = dt * __shfl(xl, 32 * ph + i);
                    h[i].x = h[i].x * dA + coef * B0; h[i].y = h[i].y * dA + coef * B1; yp[i] = h[i].x * C0 + h[i].y * C1; }
                float y = TR<32>::run(yp, lane); y += __shfl_xor(y, 32);
                if (lane < 32) yb[t * 64 + 32 * ph + lane] = y;
            }
#pragma unroll
            for (int i = 0; i < 32; ++i) *(f32x2*)(hs + (32 * ph + i) * 128 + 2 * lane) = h[i];
        }
        LDS_WAIT();
        { float xs[8], zs[8];
#pragma unroll
          for (int t = 0; t < 8; ++t) { const size_t row = (size_t)(MP + b * 8 + t); xs[t] = bf2f(ACT[row * 3072 + hd * 64 + lane]); zs[t] = bf2f(Z[row * 5120 + hd * 64 + lane]); }
#pragma unroll
          for (int t = 0; t < 8; ++t) { const float y = yb[t * 64 + lane] + Dh * xs[t], yg = y * silu(zs[t]);
            yb[t * 64 + lane] = yg;
            const float ss = wave_sum(yg * yg); if (lane == 0) part[F.wave * 8 + t] = ss; } }
        LDS_WAIT();
        __syncthreads();
        const float nw = F.in[I_MNORM][L * 2048 + hd * 64 + lane];
#pragma unroll 1
        for (int t = 0; t < 8; ++t) { float tot = 0.f;
#pragma unroll
            for (int w = 0; w < 8; ++w) tot += part[w * 8 + t];
            const float rstd = 1.0f / sqrtf(tot * (1.f / 512.f) + EPS);
            Y[(size_t)(MP + b * 8 + t) * 2048 + hd * 64 + lane] = (bf16)f2bf(yb[t * 64 + lane] * rstd * nw); }
        LDS_WAIT();
        __syncthreads();
    }
}
__device__ __forceinline__ void ssd_s2_phase(Frame& F, int L) {
    const bf16* STS = WSP(bf16, WS_STATES); const float* decay = WSP(float, WS_DECAY); bf16* HP = WSP(bf16, WS_HPREV);
    const int gt = F.vcu * (NWAVES * 64) + F.tid, NGT = F.G * NWAVES * 64;
    for (int gi = gt; gi < 131072; gi += NGT) {
        const int nq = gi & 31, p = (gi >> 5) & 63, hd = (gi >> 11) & 31, b = gi >> 16;
        const size_t base = ((size_t)(b * 64) * 32 + hd) * 8192 + p * 128 + 4 * nq;
        f32x4 h = (f32x4){0.f, 0.f, 0.f, 0.f};
#pragma unroll 1
        for (int c0 = 0; c0 < 64; c0 += 16) {
            v2u sw[16]; float d[16];
#pragma unroll
            for (int i = 0; i < 16; ++i) { sw[i] = *(const v2u*)(STS + base + (size_t)(c0 + i) * 32 * 8192); d[i] = decay[(b * 64 + c0 + i) * 32 + hd]; }
            __builtin_amdgcn_sched_barrier(0);
#pragma unroll
            for (int i = 0; i < 16; ++i) { const f32x4 s = (f32x4){bflo(sw[i].x), bfhi(sw[i].x), bflo(sw[i].y), bfhi(sw[i].y)};
                *(v2u*)(HP + base + (size_t)(c0 + i) * 32 * 8192) = (v2u){pk2(h.x, h.y), pk2(h.z, h.w)}; h = h * d[i] + s; }
            __builtin_amdgcn_sched_barrier(0);
        }
        *(f32x4*)(F.out + O_SSMP + ((size_t)(L * 2 + b) * 32 + hd) * 8192 + p * 128 + 4 * nq) = h;
    }
}
__device__ __forceinline__ void ssd_s3_phase(Frame& F, int L) {
    const float* dtv = WSP(float, WS_DTV); const float* acum = WSP(float, WS_ACUM); const bf16* ACT = WSP(bf16, WS_ACT); const bf16* Z = WSP(bf16, WS_BIG);
    const bf16* CT = WSP(bf16, WS_CT); const bf16* HP = WSP(bf16, WS_HPREV); bf16* Y = WSP(bf16, WS_Y);
    LAS unsigned char* tB = F.lds + RING_OFF; LAS unsigned char* tC = tB + 32768;
    LAS float* sA = (LAS float*)(F.lds + RING_OFF + 65536 + F.wave * 1024); LAS float* sD = sA + 128;
    LAS float* part = (LAS float*)(F.lds + RING_OFF + 65536 + 8192);
    LAS unsigned char* zs = F.lds + RING_OFF + 77824 + F.wave * 8192;
    const int lane = F.lane, fr = lane & 15, fq = lane >> 4, tid = F.tid;
    const int srow = lane >> 2, sk = lane & 3;
    for (int u = blockIdx.x; u < 512; u += F.G) {
        const int g = u & 3, c = (u >> 2) & 63, b = u >> 8, hd = 8 * g + F.wave;
        const int rowc = b * 8192 + c * 128;
#pragma unroll
        for (int jj = 0; jj < 4; ++jj) { const int ci = tid + 512 * jj, row = ci >> 4, ch = ci & 15; const bf16* src = ACT + (size_t)(rowc + row) * 3072 + 2048 + g * 128 + 8 * ch;
            const v4u vb = *(const v4u*)src, vc = *(const v4u*)(src + 512); const int off = row * 256 + ((ch ^ (row & 15)) << 4);
            *(LAS v4u*)(tB + off) = vb; *(LAS v4u*)(tC + off) = vc; }
        *(LAS f32x2*)(sA + 2 * lane) = (f32x2){acum[(size_t)(rowc + 2 * lane) * 32 + hd], acum[(size_t)(rowc + 2 * lane + 1) * 32 + hd]};
        *(LAS f32x2*)(sD + 2 * lane) = (f32x2){dtv[(size_t)(rowc + 2 * lane) * 32 + hd], dtv[(size_t)(rowc + 2 * lane + 1) * 32 + hd]};
        LDS_WAIT(); __syncthreads();
        const float Dh = F.in[I_D][L * 32 + hd];
        const bf16* hb = HP + (size_t)((b * 64 + c) * 32 + hd) * 8192;
        const bf16* CTx = CT + (size_t)(b * 2560 + hd * 64) * 8192 + c * 128;
#pragma unroll 1
        for (int half = 0; half < 2; ++half) {
            bf16x8 hp[2][4], xf[4][2];
#pragma unroll
            for (int pt = 0; pt < 2; ++pt) {
#pragma unroll
                for (int ks = 0; ks < 4; ++ks) { if (F.pflags & 16) hp[pt][ks] = (bf16x8){0, 0, 0, 0, 0, 0, 0, 0}; else hp[pt][ks] = *(const bf16x8*)(hb + (32 * half + 16 * pt + fr) * 128 + 32 * ks + 8 * fq); }
#pragma unroll
                for (int k2 = 0; k2 < 4; ++k2) { const bf16* xp = CTx + (size_t)(32 * half + 16 * pt + fr) * 8192 + 32 * k2 + 4 * fq;
                    if (F.pflags & 8) xf[k2][pt] = (bf16x8){0, 0, 0, 0, 0, 0, 0, 0}; else {
                    const v2u lo = *(const v2u*)xp, hi = *(const v2u*)(xp + 16); xf[k2][pt] = __builtin_bit_cast(bf16x8, ((v4u){lo.x, lo.y, hi.x, hi.y})); } } }
            { v4u zz[8];
#pragma unroll
              for (int i = 0; i < 8; ++i) zz[i] = *(const v4u*)(Z + (size_t)(rowc + 16 * i + srow) * 5120 + hd * 64 + 32 * half + 8 * sk);
              __builtin_amdgcn_sched_barrier(0);
#pragma unroll
              for (int i = 0; i < 8; ++i) { const int row = 16 * i + srow; *(LAS v4u*)(zs + row * 64 + ((sk ^ ((row >> 1) & 3)) << 4)) = zz[i]; } }
            LDS_WAIT();
#pragma unroll 1
            for (int j = 0; j < ((F.pflags & 4) ? 0 : 8); ++j) {
                const int l = 16 * j + fr;
                const float al = sA[l];
                bf16x8 cf[4];
#pragma unroll
                for (int ks = 0; ks < 4; ++ks) cf[ks] = *(const LAS bf16x8*)(tC + l * 256 + (((4 * ks + fq) ^ (l & 15)) << 4));
                f32x4 ya[2], yo[2];
#pragma unroll
                for (int pt = 0; pt < 2; ++pt) { ya[pt] = (f32x4){0.f, 0.f, 0.f, 0.f}; yo[pt] = (f32x4){0.f, 0.f, 0.f, 0.f}; }
#pragma unroll
                for (int pt = 0; pt < 2; ++pt)
#pragma unroll
                    for (int ks = 0; ks < 4; ++ks) yo[pt] = MFMA16(hp[pt][ks], cf[ks], yo[pt]);
#pragma unroll
                for (int ks2 = 0; ks2 < 4; ++ks2) if (ks2 <= (j >> 1) && !(F.pflags & 1)) {
                    const int i0 = 2 * ks2, i1 = i0 + 1; const bool has1 = i1 <= j;
                    const int r0 = 16 * i0 + fr, r1 = 16 * i1 + fr;
                    f32x4 g0 = (f32x4){0.f, 0.f, 0.f, 0.f}, g1 = (f32x4){0.f, 0.f, 0.f, 0.f};
#pragma unroll
                    for (int ks = 0; ks < 4; ++ks) { const bf16x8 bf0 = *(const LAS bf16x8*)(tB + r0 * 256 + (((4 * ks + fq) ^ (r0 & 15)) << 4)); g0 = MFMA16(bf0, cf[ks], g0); }
                    if (has1) {
#pragma unroll
                        for (int ks = 0; ks < 4; ++ks) { const bf16x8 bf1 = *(const LAS bf16x8*)(tB + r1 * 256 + (((4 * ks + fq) ^ (r1 & 15)) << 4)); g1 = MFMA16(bf1, cf[ks], g1); } }
                    const f32x4 sa0 = *(const LAS f32x4*)(sA + 16 * i0 + 4 * fq), sd0 = *(const LAS f32x4*)(sD + 16 * i0 + 4 * fq);
                    const f32x4 sa1 = *(const LAS f32x4*)(sA + 16 * i1 + 4 * fq), sd1 = *(const LAS f32x4*)(sD + 16 * i1 + 4 * fq);
                    float m0[4], m1[4];
#pragma unroll
                    for (int r = 0; r < 4; ++r) { const int s0 = 16 * i0 + 4 * fq + r, s1 = 16 * i1 + 4 * fq + r;
                        m0[r] = (s0 <= l) ? g0[r] * __expf(al - sa0[r]) * sd0[r] : 0.f;
                        m1[r] = (has1 && s1 <= l) ? g1[r] * __expf(al - sa1[r]) * sd1[r] : 0.f;
                        if (s0 == l) m0[r] += Dh;
                        if (has1 && s1 == l) m1[r] += Dh; }
                    v4u mp; mp.x = pk2(m0[0], m0[1]); mp.y = pk2(m0[2], m0[3]); mp.z = pk2(m1[0], m1[1]); mp.w = pk2(m1[2], m1[3]);
                    const bf16x8 mf = __builtin_bit_cast(bf16x8, mp);
#pragma unroll
                    for (int pt = 0; pt < 2; ++pt) ya[pt] = MFMA16(xf[ks2][pt], mf, ya[pt]);
                }
                const float el = __expf(al);
                float ssq = 0.f;
#pragma unroll
                for (int pt = 0; pt < 2; ++pt) {
                    LAS v2u* zp = (LAS v2u*)(zs + l * 64 + (((2 * pt + (fq >> 1)) ^ ((l >> 1) & 3)) << 4) + 8 * (fq & 1));
                    float zv[4]; unpack4(*zp, zv);
                    float yg[4];
#pragma unroll
                    for (int r = 0; r < 4; ++r) { const float y = ya[pt][r] + el * yo[pt][r]; yg[r] = y * silu(zv[r]); ssq += yg[r] * yg[r]; }
                    *zp = (v2u){pk2(yg[0], yg[1]), pk2(yg[2], yg[3])}; }
                ssq += __shfl_xor(ssq, 16); ssq += __shfl_xor(ssq, 32);
                if (fq == 0) { if (half == 0) part[F.wave * 128 + l] = ssq; else part[F.wave * 128 + l] += ssq; }
            }
            LDS_WAIT();
            { v4u yy[8];
#pragma unroll
              for (int i = 0; i < 8; ++i) { const int row = 16 * i + srow; yy[i] = *(const LAS v4u*)(zs + row * 64 + ((sk ^ ((row >> 1) & 3)) << 4)); }
#pragma unroll
              for (int i = 0; i < 8; ++i) *(v4u*)(Y + (size_t)(rowc + 16 * i + srow) * 2048 + hd * 64 + 32 * half + 8 * sk) = yy[i]; }
        }
        VM_WAIT(); LDS_WAIT();
        __syncthreads();
        if (!(F.pflags & 2)) {
        v4u yy[2][8]; f32x4 nw[2][2];
#pragma unroll
        for (int half = 0; half < 2; ++half) {
#pragma unroll
            for (int i = 0; i < 8; ++i) yy[half][i] = *(const v4u*)(Y + (size_t)(rowc + 16 * i + srow) * 2048 + hd * 64 + 32 * half + 8 * sk);
#pragma unroll
            for (int q = 0; q < 2; ++q) nw[half][q] = *(const f32x4*)(F.in[I_MNORM] + L * 2048 + hd * 64 + 32 * half + 8 * sk + 4 * q); }
        __builtin_amdgcn_sched_barrier(0);
#pragma unroll
        for (int i = 0; i < 8; ++i) {
            const int l = 16 * i + srow;
            float tot = 0.f;
#pragma unroll
            for (int w = 0; w < 8; ++w) tot += part[w * 128 + l];
            const float rstd = 1.0f / sqrtf(tot * (1.f / 512.f) + EPS);
#pragma unroll
            for (int half = 0; half < 2; ++half) { const v4u v = yy[half][i]; const f32x4 w0 = nw[half][0] * rstd, w1 = nw[half][1] * rstd;
                *(v4u*)(Y + (size_t)(rowc + l) * 2048 + hd * 64 + 32 * half + 8 * sk) =
                    (v4u){pk2(bflo(v.x) * w0.x, bfhi(v.x) * w0.y), pk2(bflo(v.y) * w0.z, bfhi(v.y) * w0.w), pk2(bflo(v.z) * w1.x, bfhi(v.z) * w1.y), pk2(bflo(v.w) * w1.z, bfhi(v.w) * w1.w)}; }
        }
        }
        LDS_WAIT();
        __syncthreads();
    }
}


template <int NT, int KB>
__device__ __forceinline__ void sg_batch(const bf16* a0, const bf16* a1, const bf16* const (&bp)[NT], int k, f32x4 (&acc)[2][NT]) {
    bf16x8 af0[KB], af1[KB], bf[KB][NT];
#pragma unroll
    for (int i = 0; i < KB; ++i) { af0[i] = *(const bf16x8*)(a0 + k + 32 * i); af1[i] = *(const bf16x8*)(a1 + k + 32 * i);
#pragma unroll
        for (int ct = 0; ct < NT; ++ct) bf[i][ct] = *(const bf16x8*)(bp[ct] + k + 32 * i); }
    __builtin_amdgcn_sched_barrier(0);
#pragma unroll
    for (int i = 0; i < KB; ++i)
#pragma unroll
        for (int ct = 0; ct < NT; ++ct) { acc[0][ct] = MFMA16(bf[i][ct], af0[i], acc[0][ct]); acc[1][ct] = MFMA16(bf[i][ct], af1[i], acc[1][ct]); }
    __builtin_amdgcn_sched_barrier(0);
}
template <int NT, class CB, class EP>
__device__ __forceinline__ void sgemm_unit(const bf16* A, const bf16* Bt, int K, int kbeg, int kend, const CB& cb, const EP& ep, int wave, int lane) {
    const int fr = lane & 15, fq = lane >> 4;
    f32x4 acc[2][NT];
#pragma unroll
    for (int rt = 0; rt < 2; ++rt)
#pragma unroll
        for (int ct = 0; ct < NT; ++ct) acc[rt][ct] = (f32x4){0.f, 0.f, 0.f, 0.f};
    const bf16* a0 = A + (size_t)(32 * wave + fr) * K + 8 * fq; const bf16* a1 = a0 + (size_t)16 * K;
    const bf16* bp[NT];
#pragma unroll
    for (int ct = 0; ct < NT; ++ct) bp[ct] = Bt + (size_t)(cb(ct) + fr) * K + 8 * fq;
    constexpr int KB = NT >= 4 ? 4 : 8;
    int k = kbeg;
#pragma unroll 1
    for (; k + 32 * KB <= kend; k += 32 * KB) sg_batch<NT, KB>(a0, a1, bp, k, acc);
#pragma unroll 1
    for (; k + 64 <= kend; k += 64) sg_batch<NT, 2>(a0, a1, bp, k, acc);
    if (k < kend) sg_batch<NT, 1>(a0, a1, bp, k, acc);
    ep(acc, 32 * wave + fr, fq);
}
__device__ __forceinline__ v2u pack4(const f32x4 a) { return (v2u){pk2(a[0], a[1]), pk2(a[2], a[3])}; }
#define SAMPLE_UNITS(u, NU, skip) for (int u = (int)F.G - 1 - (skip) - (int)blockIdx.x; u >= 0 && u < (NU); u += (int)F.G)

__device__ __forceinline__ void sg_inproj(Frame& F, int L) {
    const bf16* A = WSP(bf16, WS_XN) + (size_t)MP * 1024; const bf16* Bt = WSP(bf16, WS_WIN) + (size_t)L * INPAD * 1024;
    bf16* O = WSP(bf16, WS_BIG);
    SAMPLE_UNITS(u, 160, 0) { const int c0 = 32 * u;
        sgemm_unit<2>(A, Bt, 1024, 0, 1024, [&](int ct) { return c0 + 16 * ct; },
            [&](const f32x4 (&acc)[2][2], int rl, int fq) {
#pragma unroll
                for (int rt = 0; rt < 2; ++rt)
#pragma unroll
                    for (int ct = 0; ct < 2; ++ct) *(v2u*)(O + (size_t)(MP + rl + 16 * rt) * INW + c0 + 16 * ct + 4 * fq) = pack4(acc[rt][ct]); },
            F.wave, F.lane); }
}
__device__ __forceinline__ void sg_dt(Frame& F, int L) {
    const bf16* Bt = WSP(bf16, WS_WIN) + (size_t)L * INPAD * 1024; float* dtraw = WSP(float, WS_DTRAW);
    SAMPLE_UNITS(u, 65, 160) {
        sgemm_unit<2>(WSP(bf16, WS_XN) + (size_t)u * 256 * 1024, Bt, 1024, 0, 1024, [&](int ct) { return INW + 16 * ct; },
            [&](const f32x4 (&acc)[2][2], int rl, int fq) {
#pragma unroll
                for (int rt = 0; rt < 2; ++rt)
#pragma unroll
                    for (int ct = 0; ct < 2; ++ct) *(f32x4*)(dtraw + (size_t)(u * 256 + rl + 16 * rt) * 32 + 16 * ct + 4 * fq) = acc[rt][ct]; },
            F.wave, F.lane); }
}
__device__ __forceinline__ void sg_resid(Frame& F, const bf16* A, const bf16* Bt, int K) {
    float* slab = WSP(float, WS_SLAB);
    SAMPLE_UNITS(u, 256, 0) { const int c0 = 16 * (u & 63), kq = u >> 6, kl = K / 4;
        sgemm_unit<1>(A, Bt, K, kq * kl, (kq + 1) * kl, [&](int) { return c0; },
            [&](const f32x4 (&acc)[2][1], int rl, int fq) {
#pragma unroll
                for (int rt = 0; rt < 2; ++rt) *(f32x4*)(slab + ((size_t)kq * 256 + rl + 16 * rt) * 1024 + c0 + 4 * fq) = acc[rt][0]; },
            F.wave, F.lane); }
}
__device__ __forceinline__ void sg_rope_store(const f32x4 (&acc)[2][4], int rl, int fq, int T, int h4, const float* rope, float scale, bf16* Ob, float* Of) {
    f32x4 cs[2][2][2];
#pragma unroll
    for (int rt = 0; rt < 2; ++rt) { const int pos = 8192 + ((rl + 16 * rt) & 7);
#pragma unroll
        for (int ct = 0; ct < 2; ++ct) { const int i0 = 16 * ct + 4 * fq; cs[rt][ct][0] = *(const f32x4*)(rope + ((size_t)pos * 32 + i0) * 2); cs[rt][ct][1] = *(const f32x4*)(rope + ((size_t)pos * 32 + i0) * 2 + 4); } }
    __builtin_amdgcn_sched_barrier(0);
#pragma unroll
    for (int rt = 0; rt < 2; ++rt) { const int r = rl + 16 * rt;
#pragma unroll
        for (int ct = 0; ct < 2; ++ct) { const int i0 = 16 * ct + 4 * fq, col = 256 * T + 64 * h4 + i0;
            const f32x4 cs0 = cs[rt][ct][0], cs1 = cs[rt][ct][1];
            const float c[4] = {cs0[0], cs0[2], cs1[0], cs1[2]}, s[4] = {cs0[1], cs0[3], cs1[1], cs1[3]};
            f32x4 o1, o2;
#pragma unroll
            for (int j = 0; j < 4; ++j) { const float x1 = acc[rt][ct][j], x2 = acc[rt][ct + 2][j]; o1[j] = (x1 * c[j] - x2 * s[j]) * scale; o2[j] = (x2 * c[j] + x1 * s[j]) * scale; }
            *(v2u*)(Ob + (size_t)(MP + r) * AW + col) = pack4(o1); *(v2u*)(Ob + (size_t)(MP + r) * AW + col + 32) = pack4(o2);
            if (Of) { *(f32x4*)(Of + (size_t)r * AW + col) = o1; *(f32x4*)(Of + (size_t)r * AW + col + 32) = o2; } } }
}
__device__ __forceinline__ void sg_kv(Frame& F) {
    const bf16* A = WSP(bf16, WS_XNKV) + (size_t)MP * 1024; const bf16* Bt = WSP(bf16, WS_WKV);
    SAMPLE_UNITS(u, 144, 0) {
        if (u < 48) { const int T = u >> 2, h4 = u & 3;
            sgemm_unit<4>(A, Bt, 1024, 0, 1024, [&](int ct) { return 256 * T + 128 * (ct >> 1) + 32 * h4 + 16 * (ct & 1); },
                [&](const f32x4 (&acc)[2][4], int rl, int fq) { sg_rope_store(acc, rl, fq, T, h4, WSP(float, WS_ROPE), 1.0f, WSP(bf16, WS_KB), F.out + O_KS); }, F.wave, F.lane);
        } else { const int c0 = 32 * (u - 48);
            sgemm_unit<2>(A, Bt + (size_t)3072 * 1024, 1024, 0, 1024, [&](int ct) { return c0 + 16 * ct; },
                [&](const f32x4 (&acc)[2][2], int rl, int fq) {
#pragma unroll
                    for (int rt = 0; rt < 2; ++rt)
#pragma unroll
                        for (int ct = 0; ct < 2; ++ct) { const int r = rl + 16 * rt, col = c0 + 16 * ct + 4 * fq;
                            *(v2u*)(WSP(bf16, WS_VB) + (size_t)(MP + r) * AW + col) = pack4(acc[rt][ct]); *(f32x4*)(F.out + O_VS + (size_t)r * AW + col) = acc[rt][ct]; } },
                F.wave, F.lane); }
    }
}
__device__ __forceinline__ void sg_q(Frame& F, int LB, int skip) {
    const bf16* A = WSP(bf16, WS_XN) + (size_t)MP * 1024; const bf16* Bt = WSP(bf16, WS_WQ) + (size_t)LB * AW * 1024;
    SAMPLE_UNITS(u, 48, skip) { const int T = u >> 2, h4 = u & 3;
        sgemm_unit<4>(A, Bt, 1024, 0, 1024, [&](int ct) { return 256 * T + 128 * (ct >> 1) + 32 * h4 + 16 * (ct & 1); },
            [&](const f32x4 (&acc)[2][4], int rl, int fq) { sg_rope_store(acc, rl, fq, T, h4, WSP(float, WS_ROPE), QSCALE, WSP(bf16, WS_QB), nullptr); }, F.wave, F.lane); }
}

__device__ __forceinline__ void vt_phase(Frame& F) {
    const bf16* V = WSP(bf16, WS_VB); bf16* Vt = WSP(bf16, WS_VT);
    LAS unsigned* tile32 = (LAS unsigned*)(F.lds + RING_OFF + F.wave * 16384); LAS bf16* tile16 = (LAS bf16*)tile32;
    const int gw = F.vcu * NWAVES + F.wave, NGW = F.G * NWAVES, lane = F.lane;
    for (int u = gw; u < 2 * 48 * 128; u += NGW) {
        const int blk = u & 127, head = (u >> 7) % 48, b = u / (128 * 48);
        const int gsh = (head >> 4) * 2, dil = 1 << gsh, nsub = 8192 >> gsh, loc0 = blk * 64, r = loc0 / nsub, i0 = loc0 % nsub;
#pragma unroll
        for (int it = 0; it < 8; ++it) { const int tok = 8 * it + (lane >> 3), cg = lane & 7;
            const v4u val = *(const v4u*)(V + (size_t)(b * 8192 + dil * (i0 + tok) + r) * 3072 + head * 64 + 8 * cg);
            LAS unsigned* p = tile32 + tok * 33 + 4 * cg; p[0] = val.x; p[1] = val.y; p[2] = val.z; p[3] = val.w; }
        LDS_WAIT();
#pragma unroll
        for (int it = 0; it < 8; ++it) { const int d = 8 * it + (lane >> 3), ck = lane & 7;
            unsigned e[8];
#pragma unroll
            for (int k = 0; k < 8; ++k) e[k] = tile16[(8 * ck + k) * 66 + d];
            *(v4u*)(Vt + (size_t)((b * 48 + head) * 64 + d) * 8192 + r * nsub + i0 + 8 * ck) = (v4u){e[0] | (e[1] << 16), e[2] | (e[3] << 16), e[4] | (e[5] << 16), e[6] | (e[7] << 16)}; }
        LDS_WAIT();
    }
}
constexpr int AT_KBYTES = 256 * 128, AT_BUF = 2 * AT_KBYTES;
constexpr int AT_NS = 96;
struct AtPre { v4u k[4]; v4u v[4]; bf16x8 q[2]; };
__device__ __forceinline__ void at_decode(int u, int& b, int& head, int& gsh, int& r, int& i0) {
    const int run = u & 63; head = (u >> 6) % 48; b = u / (64 * 48); gsh = (head >> 4) * 2;
    const int nsub = 8192 >> gsh, loc0 = run * 128; r = loc0 / nsub; i0 = loc0 % nsub;
}
__device__ __forceinline__ void at_issue(AtPre& P, const bf16* Qb, const bf16* Kb, const bf16* Vb, int u, int tid) {
    int b, head, gsh, r, i0; at_decode(u, b, head, gsh, r, i0);
#pragma unroll
    for (int j = 0; j < 4; ++j) { const int c = tid + 512 * j, row = c >> 3, ch = c & 7; int si = i0 - 128 + row; si = si < 0 ? 0 : si;
        const size_t off = ((size_t)b * 8192 + ((size_t)si << gsh) + r) * 3072 + head * 64 + 8 * ch;
        P.k[j] = *(const v4u*)(Kb + off); P.v[j] = *(const v4u*)(Vb + off); }
    const int wave = tid >> 6, lane = tid & 63, fr = lane & 15, fq = lane >> 4;
    const size_t qrow = (size_t)b * 8192 + ((size_t)(i0 + 16 * wave + fr) << gsh) + r;
#pragma unroll
    for (int ks = 0; ks < 2; ++ks) P.q[ks] = *(const bf16x8*)(Qb + qrow * 3072 + head * 64 + 32 * ks + 8 * fq);
}
__device__ __forceinline__ void at_write(const AtPre& P, LAS unsigned char* buf, int tid) {
#pragma unroll
    for (int j = 0; j < 4; ++j) { const int c = tid + 512 * j, row = c >> 3, ch = c & 7; *(LAS v4u*)(buf + row * 128 + ((ch ^ (row & 7)) << 4)) = P.k[j]; }
#pragma unroll
    for (int j = 0; j < 4; ++j) { const int c = tid + 512 * j, row = c >> 3, ch = c & 7; *(LAS v4u*)(buf + AT_KBYTES + row * 128 + ((ch ^ (row & 7)) << 4)) = P.v[j]; }
}
__device__ __forceinline__ void at_compute(const LAS unsigned char* buf, const bf16x8 (&qf)[2], int u, int wave, int lane, bf16* Og, f32x2* ML) {
    int b, head, gsh, r, i0; at_decode(u, b, head, gsh, r, i0);
    const int fr = lane & 15, fq = lane >> 4;
    f32x4 s[9];
    { bf16x8 k0[9], k1[9];
#pragma unroll
      for (int kt = 0; kt < 9; ++kt) { const int row = 16 * wave + 16 * kt + fr;
          k0[kt] = *(const LAS bf16x8*)(buf + row * 128 + (((fq) ^ (row & 7)) << 4)); k1[kt] = *(const LAS bf16x8*)(buf + row * 128 + (((4 + fq) ^ (row & 7)) << 4)); }
      __builtin_amdgcn_sched_barrier(0);
#pragma unroll
      for (int kt = 0; kt < 9; ++kt) { s[kt] = MFMA16(k0[kt], qf[0], ((f32x4){0.f, 0.f, 0.f, 0.f})); s[kt] = MFMA16(k1[kt], qf[1], s[kt]); }
      __builtin_amdgcn_sched_barrier(0); }
    const int kbase = i0 - 128 + 16 * wave;
    float mx = -INFINITY;
#pragma unroll
    for (int kt = 0; kt < 9; ++kt)
#pragma unroll
        for (int rho = 0; rho < 4; ++rho) { const int kk = 16 * kt + 4 * fq + rho; const bool ok = kk >= fr && kk <= fr + 128 && (kbase + kk) >= 0;
            s[kt][rho] = ok ? s[kt][rho] : -INFINITY; mx = fmaxf(mx, s[kt][rho]); }
    mx = fmaxf(mx, __shfl_xor(mx, 16)); mx = fmaxf(mx, __shfl_xor(mx, 32));
    float ls = 0.f;
#pragma unroll
    for (int kt = 0; kt < 9; ++kt)
#pragma unroll
        for (int rho = 0; rho < 4; ++rho) { const float p = __builtin_amdgcn_exp2f(s[kt][rho] - mx); s[kt][rho] = p; ls += p; }
    ls += __shfl_xor(ls, 16); ls += __shfl_xor(ls, 32);
    f32x4 o[4];
#pragma unroll
    for (int dt = 0; dt < 4; ++dt) o[dt] = (f32x4){0.f, 0.f, 0.f, 0.f};
#pragma unroll
    for (int k5 = 0; k5 < 5; ++k5) {
        v4u pp; pp.x = pk2(s[2 * k5][0], s[2 * k5][1]); pp.y = pk2(s[2 * k5][2], s[2 * k5][3]);
        if (k5 < 4) { pp.z = pk2(s[2 * k5 + 1][0], s[2 * k5 + 1][1]); pp.w = pk2(s[2 * k5 + 1][2], s[2 * k5 + 1][3]); } else { pp.z = 0u; pp.w = 0u; }
        const bf16x8 pf = __builtin_bit_cast(bf16x8, pp);
        v2u lo[4], hi[4];
        const int vrow = 16 * wave + 32 * k5 + 4 * fq + (fr >> 2);
#pragma unroll
        for (int dt = 0; dt < 4; ++dt) { const int c16 = 2 * dt + ((fr & 3) >> 1), sub = 8 * (fr & 1);
            lo[dt] = __builtin_bit_cast(v2u, __builtin_amdgcn_ds_read_tr16_b64_v4i16((LAS s16x4*)(buf + AT_KBYTES + vrow * 128 + ((c16 ^ (vrow & 7)) << 4) + sub)));
            if (k5 < 4) hi[dt] = __builtin_bit_cast(v2u, __builtin_amdgcn_ds_read_tr16_b64_v4i16((LAS s16x4*)(buf + AT_KBYTES + (vrow + 16) * 128 + ((c16 ^ ((vrow + 16) & 7)) << 4) + sub)));
            else hi[dt] = (v2u){0u, 0u}; }
        __builtin_amdgcn_sched_barrier(0);
#pragma unroll
        for (int dt = 0; dt < 4; ++dt) o[dt] = MFMA16(__builtin_bit_cast(bf16x8, ((v4u){lo[dt].x, lo[dt].y, hi[dt].x, hi[dt].y})), pf, o[dt]);
    }
    const int g = head >> 4, hh = head & 15;
    const size_t row = (size_t)b * 8192 + ((size_t)(i0 + 16 * wave + fr) << gsh) + r;
    const float inv = 1.0f / ls;
    bf16* op = Og + ((size_t)g * MT + row) * 1024 + hh * 64 + 4 * fq;
#pragma unroll
    for (int dt = 0; dt < 4; ++dt) *(v2u*)(op + 16 * dt) = (v2u){pk2(o[dt][0] * inv, o[dt][1] * inv), pk2(o[dt][2] * inv, o[dt][3] * inv)};
    if (fq == 0) ML[((size_t)g * MT + row) * 16 + hh] = (f32x2){mx, ls};
}
__device__ __forceinline__ void attn_prompt_phase(Frame& F, int first, int nwg) {
    const bf16* Qb = WSP(bf16, WS_QB); const bf16* Kb = WSP(bf16, WS_KB); const bf16* Vt = WSP(bf16, WS_VB); bf16* Og = WSP(bf16, WS_OG); f32x2* ML = WSP(f32x2, WS_ML);
    const int me = (int)blockIdx.x - first;
    if (me < 0 || me >= nwg) return;
    AtPre P; int u = me; int par = 0;
    if (u < 6144) { at_issue(P, Qb, Kb, Vt, u, F.tid); at_write(P, F.lds + RING_OFF, F.tid); }
    bf16x8 qf[2] = {P.q[0], P.q[1]};
    LDS_WAIT(); __syncthreads();
    for (; u < 6144; u += nwg) {
        const int un = u + nwg;
        if (un < 6144) at_issue(P, Qb, Kb, Vt, un, F.tid);
        at_compute(F.lds + RING_OFF + par * AT_BUF, qf, u, F.wave, F.lane, Og, ML);
        if (un < 6144) { at_write(P, F.lds + RING_OFF + (par ^ 1) * AT_BUF, F.tid); qf[0] = P.q[0]; qf[1] = P.q[1]; }
        LDS_WAIT(); __syncthreads();
        par ^= 1;
    }
}
__device__ __forceinline__ void sa_load(f32x4 (&buf)[16], int jbase, const float* cache, const float* fresh, int b, int t, int gsh, int h0, int lane) {
#pragma unroll
    for (int jj = 0; jj < 16; ++jj) { int j = jbase + jj; j = j > 128 ? 128 : j; const int idx = 2048 + t - (j << gsh);
        const float* p = idx < 2048 ? cache + ((size_t)(b * 2048 + idx) * 48 + h0) * 64 : fresh + (size_t)(b * 8 + idx - 2048) * 3072 + h0 * 64;
        buf[jj] = *(const f32x4*)(p + 4 * lane); }
}
__device__ __forceinline__ void sa_score(const f32x4 (&buf)[16], int jbase, const float (&q4)[4], LAS float* sc, int hq, int dq) {
#pragma unroll
    for (int jj = 0; jj < 16; ++jj) { const float p = row16_sum((q4[0] * buf[jj].x + q4[1] * buf[jj].y) + (q4[2] * buf[jj].z + q4[3] * buf[jj].w));
        if (dq == 0 && jbase + jj < 129) sc[hq * 132 + jbase + jj] = p; }
}
__device__ __forceinline__ void sa_pv(const f32x4 (&buf)[16], int jbase, const LAS float* sc, int hq, f32x4& o) {
#pragma unroll
    for (int jj = 0; jj < 16; ++jj) { const float pj = (jbase + jj < 129) ? sc[hq * 132 + jbase + jj] : 0.f; o += pj * buf[jj]; }
}
__device__ __forceinline__ void attn_sample_phase(Frame& F, int first, int nwg) {
    const int me = (int)blockIdx.x - first;
    if (me < 0 || me >= nwg) return;
    const bf16* Qb = WSP(bf16, WS_QB); bf16* Og = WSP(bf16, WS_OG); f32x2* ML = WSP(f32x2, WS_ML);
    const float* ck = F.in[I_CK]; const float* cv = F.in[I_CV]; const float* kS = F.out + O_KS; const float* vS = F.out + O_VS;
    LAS float* sc = (LAS float*)(F.lds + RING_OFF + F.wave * 4096);
    const int lane = F.lane, hq = lane >> 4, dq = lane & 15;
    for (int u = me; u < 32 * 3 * 4; u += nwg) {
        const int hquad = u & 3, b = (u >> 2) & 31, g = u >> 7, gsh = 2 * g;
        const int t = F.wave, h0 = 16 * g + 4 * hquad;
        const size_t row = (size_t)(MP + b * 8 + t);
        float q4[4]; unpack4(*(const v2u*)(Qb + row * 3072 + h0 * 64 + 4 * lane), q4);
        f32x4 bA[16], bB[16];
        sa_load(bA, 0, ck, kS, b, t, gsh, h0, lane);
#pragma unroll 1
        for (int j0 = 0; j0 < 128; j0 += 32) {
            sa_load(bB, j0 + 16, ck, kS, b, t, gsh, h0, lane); sa_score(bA, j0, q4, sc, hq, dq);
            sa_load(bA, j0 + 32, ck, kS, b, t, gsh, h0, lane); sa_score(bB, j0 + 16, q4, sc, hq, dq);
        }
        sa_load(bB, 0, cv, vS, b, t, gsh, h0, lane);
        sa_score(bA, 128, q4, sc, hq, dq);
        LDS_WAIT();
        float sv[9]; float mx = -INFINITY;
#pragma unroll
        for (int i = 0; i < 9; ++i) { const int j = dq + 16 * i; sv[i] = j < 129 ? sc[hq * 132 + j] : -INFINITY; mx = fmaxf(mx, sv[i]); }
        mx = fmaxf(mx, __shfl_xor(mx, 1)); mx = fmaxf(mx, __shfl_xor(mx, 2)); mx = fmaxf(mx, __shfl_xor(mx, 4)); mx = fmaxf(mx, __shfl_xor(mx, 8));
        float ls = 0.f;
#pragma unroll
        for (int i = 0; i < 9; ++i) { sv[i] = __builtin_amdgcn_exp2f(sv[i] - mx); ls += sv[i]; }
        ls = row16_sum(ls);
        LDS_WAIT();
#pragma unroll
        for (int i = 0; i < 9; ++i) { const int j = dq + 16 * i; if (j < 129) sc[hq * 132 + j] = sv[i]; }
        LDS_WAIT();
        f32x4 o = (f32x4){0.f, 0.f, 0.f, 0.f};
#pragma unroll 1
        for (int j0 = 0; j0 < 128; j0 += 32) {
            sa_load(bA, j0 + 16, cv, vS, b, t, gsh, h0, lane); sa_pv(bB, j0, sc, hq, o);
            sa_load(bB, j0 + 32, cv, vS, b, t, gsh, h0, lane); sa_pv(bA, j0 + 16, sc, hq, o);
        }
        sa_pv(bB, 128, sc, hq, o);
        LDS_WAIT();
        const int hh = 4 * hquad + hq; const float inv = 1.0f / ls;
        *(v2u*)(Og + ((size_t)g * MT + row) * 1024 + hh * 64 + 4 * dq) = (v2u){pk2(o[0] * inv, o[1] * inv), pk2(o[2] * inv, o[3] * inv)};
        if (dq == 0) ML[((size_t)g * MT + row) * 16 + hh] = (f32x2){mx, ls};
    }
}
struct MgIn { f32x2 a0, a1, a2; v4u x0, x1, x2; };
__device__ __forceinline__ void mg_load(MgIn& I, const bf16* Og, const f32x2* ML, int i) { const int row = i >> 7, c8 = i & 127, hh = c8 >> 3;
    I.a0 = ML[((size_t)0 * MT + row) * 16 + hh]; I.a1 = ML[((size_t)1 * MT + row) * 16 + hh]; I.a2 = ML[((size_t)2 * MT + row) * 16 + hh];
    I.x0 = *(const v4u*)(Og + ((size_t)0 * MT + row) * 1024 + 8 * c8); I.x1 = *(const v4u*)(Og + ((size_t)1 * MT + row) * 1024 + 8 * c8); I.x2 = *(const v4u*)(Og + ((size_t)2 * MT + row) * 1024 + 8 * c8); }
__device__ __forceinline__ void mg_store(const MgIn& I, bf16* Ob, int i) { const int row = i >> 7, c8 = i & 127;
    const f32x2 a0 = I.a0, a1 = I.a1, a2 = I.a2; const v4u x0 = I.x0, x1 = I.x1, x2 = I.x2;
    const float M = fmaxf(a0.x, fmaxf(a1.x, a2.x));
    float w0 = __builtin_amdgcn_exp2f(a0.x - M) * a0.y, w1 = __builtin_amdgcn_exp2f(a1.x - M) * a1.y, w2 = __builtin_amdgcn_exp2f(a2.x - M) * a2.y;
    const float inv = 1.0f / (w0 + w1 + w2); w0 *= inv; w1 *= inv; w2 *= inv;
    v4u o;
    o.x = pk2(w0 * bflo(x0.x) + w1 * bflo(x1.x) + w2 * bflo(x2.x), w0 * bfhi(x0.x) + w1 * bfhi(x1.x) + w2 * bfhi(x2.x));
    o.y = pk2(w0 * bflo(x0.y) + w1 * bflo(x1.y) + w2 * bflo(x2.y), w0 * bfhi(x0.y) + w1 * bfhi(x1.y) + w2 * bfhi(x2.y));
    o.z = pk2(w0 * bflo(x0.z) + w1 * bflo(x1.z) + w2 * bflo(x2.z), w0 * bfhi(x0.z) + w1 * bfhi(x1.z) + w2 * bfhi(x2.z));
    o.w = pk2(w0 * bflo(x0.w) + w1 * bflo(x1.w) + w2 * bflo(x2.w), w0 * bfhi(x0.w) + w1 * bfhi(x1.w) + w2 * bfhi(x2.w));
    *(v4u*)(Ob + (size_t)row * 1024 + 8 * c8) = o; }
__device__ __forceinline__ void attn_merge_phase(Frame& F) {
    const bf16* Og = WSP(bf16, WS_OG); const f32x2* ML = WSP(f32x2, WS_ML); bf16* Ob = WSP(bf16, WS_OB);
    const int gt = F.vcu * (NWAVES * 64) + F.tid, NGT = F.G * NWAVES * 64;
    int i = gt;
#pragma unroll 1
    for (; i + 3 * NGT < MT * 128; i += 4 * NGT) { MgIn A, B, C, D; mg_load(A, Og, ML, i); mg_load(B, Og, ML, i + NGT); mg_load(C, Og, ML, i + 2 * NGT); mg_load(D, Og, ML, i + 3 * NGT);
        __builtin_amdgcn_sched_barrier(0);
        mg_store(A, Ob, i); mg_store(B, Ob, i + NGT); mg_store(C, Ob, i + 2 * NGT); mg_store(D, Ob, i + 3 * NGT);
        __builtin_amdgcn_sched_barrier(0); }
#pragma unroll 1
    for (; i < MT * 128; i += NGT) { MgIn A; mg_load(A, Og, ML, i); mg_store(A, Ob, i); }
}


constexpr int NPHASES = 38;
#ifndef PROBE_MASK
#define PROBE_MASK 0u
#endif
#ifdef PROBE_NULLEPI
#define PROBE_NULLEPI_ON 1
#else
#define PROBE_NULLEPI_ON 0
#endif
#ifndef PROBE_FLAGS
#define PROBE_FLAGS 0
#endif
#ifndef PROBE_SUB
#define PROBE_SUB 3
#endif
#ifndef PROBE_REPS
#define PROBE_REPS 2
#endif
#ifndef AUDIT_SUB
#define AUDIT_SUB 3
#endif
#ifndef AUDIT_SITES
#define AUDIT_SITES 0xffffffffu
#endif
struct Args { const float* in[32]; float* out; unsigned char* ws; int ph_lo, ph_hi, li, pad; };
__device__ __forceinline__ Frame phase_frame(const Frame& F0) {
    Frame F = F0; int tid = F0.wave * 64 + lane_id_v();
    F.tid = tid; F.lane = tid & 63; F.wave = __builtin_amdgcn_readfirstlane(tid >> 6);
    return F;
}
__global__ void __launch_bounds__(NWAVES * 64, 2) yoco_fwd(Args args) {
    extern __shared__ __attribute__((aligned(16))) unsigned char lds[];
    Frame F0;
    F0.lds = (LAS unsigned char*)lds;
    F0.MISC = (volatile LAS unsigned*)(F0.lds + MISC_OFF);
    F0.tid = threadIdx.x; F0.lane = F0.tid & 63; F0.wave = __builtin_amdgcn_readfirstlane(F0.tid >> 6);
    F0.G = gridDim.x; { const int bx = blockIdx.x; F0.vcu = (F0.G % 8 == 0) ? (bx % 8) * (F0.G / 8) + bx / 8 : bx; }
    F0.ws = args.ws; F0.out = args.out; F0.ctl = (gu32*)(args.ws + WS_CTL);
    F0.in = args.in;
    for (int u = F0.tid; u < (LDS_BYTES - LDSCTL_OFF) / 4; u += NWAVES * 64) ((LAS unsigned*)(F0.lds + LDSCTL_OFF))[u] = 0u;
    __syncthreads();
    XcdBarrier bar; bar.bar = (unsigned*)(F0.ctl + CW_BAR); bar.x = 0; bar.st = nullptr;
    if (MK_N_LAUNCHES == 1) bar = xcd_barrier_post((unsigned*)(F0.ctl + CW_BAR), F0.MISC + 8);
    bar.wave = F0.wave;
    const int lo = args.ph_lo, hi = args.ph_hi;
    int ph = 0;
#define PHASE_BEGIN(id) if (((AUDIT_SITES >> (id)) & 1u) && lo <= ph && ph < hi) { _Pragma("unroll 1") for (int rep_ = 0; rep_ < (((PROBE_MASK >> (id)) & 1u) ? 1 + PROBE_REPS : 1); ++rep_) { Frame F = phase_frame(F0); \
    F.pflags = (PROBE_FLAGS != 0 && ((PROBE_MASK >> (id)) & 1u) && rep_ < PROBE_REPS) ? PROBE_FLAGS : 0;
#define PHASE_END } if (ph + 1 < hi) { if (MK_N_LAUNCHES == 1) xcd_barrier(bar); } } ++ph;
#define H_ WSP(float, WS_H)
#define HB_ WSP(bf16, WS_H)
#define HS_ (WSP(float, WS_H) + (size_t)MP * 1024)
#define XN_ WSP(bf16, WS_XN)
#define XNKV_ WSP(bf16, WS_XNKV)
#define MODL_ (WSP(float, WS_MOD) + (size_t)L * NSEQ * 6144)
#define HP_ ((L == 0) ? F.in[I_XP] : H_)
#define HSS_ ((L == 0) ? F.in[I_XS] : HS_)

    PHASE_BEGIN(0) if (AUDIT_SUB & 1) p0_weights(F); __syncthreads(); if (AUDIT_SUB & 2) p0_adaln(F); PHASE_END

#pragma unroll 1
    for (int L = 0; L < 4; ++L) {
        PHASE_BEGIN(1)
            const Pend pd{(L == 0 || rep_ > 0) ? nullptr : WSP(float, WS_SLAB), WSP(float, WS_MOD) + (size_t)(L == 0 ? 0 : L - 1) * NSEQ * 6144 + 5120, HS_, HS_};
            if (L == 2) norm_rows<2, true>(F, pd, HB_, HSS_, F.in[I_NMIX] + L * 1024, MODL_, 0, 1024, XN_, F.in[I_KVN], WSP(float, WS_MOD) + (size_t)4 * NSEQ * 6144, 0, 1024, XNKV_);
            else if (L == 0) norm_rows<1, false>(F, pd, F.in[I_XP], HSS_, F.in[I_NMIX] + L * 1024, MODL_, 0, 1024, XN_, F.in[I_NMIX] + L * 1024, MODL_, 0, 1024, XN_);
            else norm_rows<1, true>(F, pd, HB_, HSS_, F.in[I_NMIX] + L * 1024, MODL_, 0, 1024, XN_, F.in[I_NMIX] + L * 1024, MODL_, 0, 1024, XN_);
        PHASE_END
        if (L < 2) {
            PHASE_BEGIN(2) { pg8::Gemm g{XN_, WSP(bf16, WS_WIN) + (size_t)L * INPAD * 1024, MP, INW, 1024, F.pflags}; pg8::StaticOrder S; S.init(MP, INW, F.G, (int)blockIdx.x);
                pg8::EpiInProj E{WSP(bf16, WS_BIG), WSP(float, WS_DTRAW), (PROBE_NULLEPI_ON && rep_ > 0) || F.pflags != 0};
                if (!(F.pflags & 16)) pg8::gemm_phase<pg8::EpiInProj, pg8::StaticOrder, true, true>(F.lds + RING_OFF, g, S, E, F.tid); }
                if (!(PROBE_NULLEPI_ON && rep_ > 0) && (F.pflags == 0 || (F.pflags & 16))) { sg_inproj(F, L); sg_dt(F, L); } PHASE_END
            PHASE_BEGIN(3) conv_mamba_phase(F, L); PHASE_END
            PHASE_BEGIN(4) if ((AUDIT_SUB & 1) && (rep_ == 0 || (PROBE_SUB & 1))) ssd_s1_phase(F, L); if ((AUDIT_SUB & 2) && (rep_ == 0 || (PROBE_SUB & 2))) { Frame F2 = phase_frame(F0); F2.pflags = 0; ssd_sample_phase(F2, L); } PHASE_END
            PHASE_BEGIN(5) ssd_s2_phase(F, L); PHASE_END
            PHASE_BEGIN(6) ssd_s3_phase(F, L); PHASE_END
        } else {
            PHASE_BEGIN(7)
                if (L == 2) { pg8::Gemm g{XNKV_, WSP(bf16, WS_WKV), MP, 6144, 1024}; pg8::StaticOrder S; S.init(MP, 6144, F.G, (int)blockIdx.x);
                    pg8::EpiRopeKV E{WSP(bf16, WS_KB), WSP(bf16, WS_VB), F.out + O_KP, F.out + O_KS, F.out + O_VP, F.out + O_VS, WSP(float, WS_ROPE)};
                    pg8::gemm_phase<pg8::EpiRopeKV, pg8::StaticOrder, true, true>(F.lds + RING_OFF, g, S, E, F.tid); }
                { pg8::Gemm g{XN_, WSP(bf16, WS_WQ) + (size_t)(L - 2) * AW * 1024, MP, AW, 1024}; pg8::StaticOrder S; S.init(MP, AW, F.G, (int)blockIdx.x);
                    pg8::EpiRopeQ E{WSP(bf16, WS_QB), WSP(float, WS_ROPE), QSCALE};
                    pg8::gemm_phase<pg8::EpiRopeQ, pg8::StaticOrder, true, true>(F.lds + RING_OFF, g, S, E, F.tid); }
                if (L == 2) sg_kv(F);
                sg_q(F, L - 2, L == 2 ? 144 : 0);
            PHASE_END
            PHASE_BEGIN(9) if ((AUDIT_SUB & 2) && (rep_ == 0 || (PROBE_SUB & 2))) attn_sample_phase(F, 0, AT_NS); if ((AUDIT_SUB & 1) && (rep_ == 0 || (PROBE_SUB & 1))) attn_prompt_phase(F, AT_NS, (int)F.G - AT_NS); PHASE_END
            PHASE_BEGIN(16) attn_merge_phase(F); PHASE_END
        }
        PHASE_BEGIN(10) { pg8::Gemm g{L < 2 ? WSP(bf16, WS_Y) : WSP(bf16, WS_OB), L < 2 ? WSP(bf16, WS_WOUT) + (size_t)L * 1024 * 2048 : WSP(bf16, WS_WO) + (size_t)(L - 2) * 1024 * 1024, MP, 1024, L < 2 ? 2048 : 1024};
            pg8::StaticOrder S; S.init(MP, 1024, F.G, (int)blockIdx.x);
            pg8::EpiResid E{L == 0 ? F.in[I_XP] : nullptr, HB_, rep_ > 0 ? WSP(bf16, WS_END) : HB_, MODL_ + 2048};
            pg8::gemm_phase<pg8::EpiResid, pg8::StaticOrder, true, true>(F.lds + RING_OFF, g, S, E, F.tid);
            sg_resid(F, (L < 2 ? WSP(bf16, WS_Y) + (size_t)MP * 2048 : WSP(bf16, WS_OB) + (size_t)MP * 1024), g.Bt, g.K); } PHASE_END
        PHASE_BEGIN(11) { const Pend pd{rep_ > 0 ? nullptr : WSP(float, WS_SLAB), MODL_ + 2048, HSS_, HS_};
            norm_rows<1, true>(F, pd, HB_, HS_, F.in[I_NFFN] + L * 1024, MODL_, 3072, 4096, XN_, F.in[I_NFFN] + L * 1024, MODL_, 3072, 4096, XN_); } PHASE_END
        PHASE_BEGIN(12) { pg8::Gemm g{XN_, WSP(bf16, WS_WUP) + (size_t)L * FF2 * 1024, MT, FF2, 1024}; pg8::UpOrder S; S.init(MP, FF2, F.G, (int)blockIdx.x);
            pg8::EpiUpConv E{WSP(bf16, WS_ACT), WSP(float, WS_UB), F.in[I_FCW] + (size_t)L * 3 * FF2, F.in[I_FCB] + (size_t)L * FF2, F.out + O_FFNP + (size_t)L * 2 * 2 * FF2, F.out + O_FFNS + (size_t)L * 32 * 2 * FF2, F.in[I_FFNC] + (size_t)L * 32 * 2 * FF2, F.pflags != 0};
            pg8::gemm_phase<pg8::EpiUpConv, pg8::UpOrder, true, true>(F.lds + RING_OFF, g, S, E, F.tid); } PHASE_END
        PHASE_BEGIN(14) { pg8::Gemm g{WSP(bf16, WS_ACT), WSP(bf16, WS_WDN) + (size_t)L * 1024 * FF, MP, 1024, FF}; pg8::StaticOrder S; S.init(MP, 1024, F.G, (int)blockIdx.x);
            { pg8::Unit u0; if (S.next(0, u0)) ffn_fixup(F, L, u0.pm); else { VM_WAIT(); __syncthreads(); } }
            pg8::EpiResid E{nullptr, HB_, rep_ > 0 ? WSP(bf16, WS_END) : HB_, MODL_ + 5120};
            pg8::gemm_phase<pg8::EpiResid, pg8::StaticOrder, true, true>(F.lds + RING_OFF, g, S, E, F.tid);
            sg_resid(F, WSP(bf16, WS_ACT) + (size_t)MP * FF, g.Bt, FF); } PHASE_END
    }
    PHASE_BEGIN(15) { const Pend pd{rep_ > 0 ? nullptr : WSP(float, WS_SLAB), WSP(float, WS_MOD) + (size_t)3 * NSEQ * 6144 + 5120, HS_, HS_};
        final_norm_phase(F, pd, HB_, HS_, F.in[I_FN], F.out + O_YP); } PHASE_END
#ifdef PROBE_BARRIERS
    if (MK_N_LAUNCHES == 1) { _Pragma("unroll 1") for (int i = 0; i < PROBE_BARRIERS; ++i) xcd_barrier(bar); }
#endif
#undef PHASE_BEGIN
#undef PHASE_END
}

extern "C" void kernel_launch(void* const* d_in, const int* in_sizes, int n_in, void* d_out, int out_size, void* d_ws, size_t ws_size, hipStream_t stream) {
    static int grid = 0;
    if (grid == 0) {
        if (n_in != 32 || (size_t)out_size != O_END || ws_size < WS_END + 80 * MiB) { fprintf(stderr, "kernel_launch: unexpected shapes (n_in %d, out %d, ws %zu, need %zu); nothing launched\n", n_in, out_size, ws_size, (size_t)WS_END); grid = -1; return; }
        int dev = 0, cus = 0;
        if (hipGetDevice(&dev) != hipSuccess || hipDeviceGetAttribute(&cus, hipDeviceAttributeMultiprocessorCount, dev) != hipSuccess) { grid = -1; return; }
        if (hipFuncSetAttribute((const void*)yoco_fwd, hipFuncAttributeMaxDynamicSharedMemorySize, LDS_BYTES) != hipSuccess) { fprintf(stderr, "kernel_launch: hipFuncSetAttribute failed\n"); grid = -1; return; }
        int per_cu = 0;
        if (hipOccupancyMaxActiveBlocksPerMultiprocessor(&per_cu, (const void*)yoco_fwd, NWAVES * 64, LDS_BYTES) != hipSuccess || per_cu < 1)
            fprintf(stderr, "kernel_launch: note: occupancy query reports %d workgroups per CU\n", per_cu);
        (void)hipGetLastError();
        grid = cus;
        if (grid < 22) { fprintf(stderr, "kernel_launch: %d CUs: the up-projection's schedule needs at least 22 workgroups; nothing launched\n", grid); grid = -1; return; }
    }
    if (grid < 0) return;
    if (hipMemsetAsync((char*)d_ws + WS_CTL, 0, CTL_ZERO_BYTES, stream) != hipSuccess) return;
    Args a{};
    for (int i = 0; i < 32; ++i) a.in[i] = (const float*)d_in[i];
    a.out = (float*)d_out; a.ws = (unsigned char*)d_ws; a.li = 0; a.pad = 0;
#if MK_N_LAUNCHES == 1
    a.ph_lo = 0; a.ph_hi = NPHASES;
    hipLaunchKernelGGL(yoco_fwd, dim3(grid), dim3(NWAVES * 64), LDS_BYTES, stream, a);
#else
    for (int k = 0; k < NPHASES; ++k) { a.ph_lo = k; a.ph_hi = k + 1; hipLaunchKernelGGL(yoco_fwd, dim3(grid), dim3(NWAVES * 64), LDS_BYTES, stream, a); }
#endif
    const hipError_t le = hipPeekAtLastError();
    if (le != hipSuccess) fprintf(stderr, "kernel_launch: launch failed: %s\n", hipGetErrorName(le));
}
```

```cpp
#define PROBE_MASK 0x0u
#include <hip/hip_runtime.h>
#ifndef PROBE_FLAGS
#define PROBE_FLAGS 0
#endif
#include <cstdio>
#include <cstdint>
#include <cmath>
namespace pg8 {
#define PG8_LAS __attribute__((address_space(3)))
typedef unsigned short bf16_t;
typedef short bf16x8 __attribute__((ext_vector_type(8)));
typedef float f32x4 __attribute__((ext_vector_type(4)));
typedef unsigned u32x4 __attribute__((ext_vector_type(4)));
constexpr int BM = 256, BK = 64, HALF = 128, HTB = HALF * BK * 2  , STAGE_BYTES = 8 * HTB, NXCD = 8, WGM = 8;

__host__ __device__ __forceinline__ int lds_byte(int r, int c) { const int st = (r >> 4) * 2 + (c >> 5), rr = r & 15, cc = c & 31, ob = rr * 64 + cc * 2; return st * 1024 + (ob ^ (((ob >> 9) & 1) << 5)); }
__host__ __device__ __forceinline__ void stage_rc(int b, int& R, int& C) { const int st = b / 1024, sb = b % 1024, swz = sb ^ (((sb >> 9) & 1) << 5); R = (st >> 1) * 16 + swz / 64; C = (st & 1) * 32 + (swz % 64) / 2; }
__host__ __device__ __forceinline__ int perm32(int rho) { const int n = rho >> 4, i = rho & 15; return 8 * (i >> 2) + 4 * n + (i & 3); }

struct Unit { int pm, pn; };
struct Gemm { const bf16_t* A; const bf16_t* Bt; int M, N, K; int pf = 0; };

struct StaticOrder {
    int nM, nN, nwg, G, c;
    __host__ __device__ __forceinline__ void init(int M, int N, int G_, int c_) { nM = M / BM; nN = N / BM; nwg = nM * nN; G = G_; c = c_; }
    __host__ __device__ __forceinline__ bool next(int i, Unit& u) const {
        const long L = (long)i * G + c; if (L >= nwg) return false;
        int wgid = (int)L; { const int q = nwg / NXCD, r = nwg % NXCD, xcd = wgid % NXCD, off = wgid / NXCD; wgid = (xcd < r ? xcd * (q + 1) : r * (q + 1) + (xcd - r) * q) + off; }
        const int nig = WGM * nN, gid = wgid / nig, fm = gid * WGM, gsz = (nM - fm) < WGM ? (nM - fm) : WGM;
        u.pm = fm + ((wgid % nig) % gsz); u.pn = (wgid % nig) / gsz; return true;
    }
    __device__ __forceinline__ void a_ready(const Unit&) const {}
    __device__ __forceinline__ void done(const Unit&) const {}
};

struct UpOrder {
    StaticOrder P; int G, c, nP;
    __host__ __device__ __forceinline__ void init(int Mp, int N, int G_, int c_) { P.init(Mp, N, G_, c_); G = G_; c = c_; nP = c < P.nwg ? (P.nwg - c + G - 1) / G : 0; }
    __host__ __device__ __forceinline__ bool next(int i, Unit& u) const {
        if (i < nP) return P.next(i, u);
        if (i == nP && G - 1 - c < P.nN) { u.pm = P.nM; u.pn = G - 1 - c; return true; }
        return false;
    }
    __device__ __forceinline__ void a_ready(const Unit&) const {}
    __device__ __forceinline__ void done(const Unit&) const {}
};

__device__ __forceinline__ unsigned cvt_pk_bf16(float lo, float hi) { unsigned r; asm volatile("v_cvt_pk_bf16_f32 %0, %1, %2" : "=v"(r) : "v"(lo), "v"(hi)); return r; }
typedef float f32x2 __attribute__((ext_vector_type(2)));
typedef unsigned u32x2 __attribute__((ext_vector_type(2)));
__device__ __forceinline__ u32x4 pack8(const f32x4 a, const f32x4 b) { u32x4 w; w.x = cvt_pk_bf16(a[0], a[1]); w.y = cvt_pk_bf16(a[2], a[3]); w.z = cvt_pk_bf16(b[0], b[1]); w.w = cvt_pk_bf16(b[2], b[3]); return w; }
struct EpiBf16 {
    static constexpr bool PERM = true, AFTER_DRAIN = false, DEFER_LAST = false;
    bf16_t* O; int ldc;
    __device__ __forceinline__ void operator()(const f32x4 (&acc)[2][2][4][2], const Unit& u, int wr, int wc, int fr, int fq) const {
        const int row0 = u.pm * BM + wr * 64 + fr, col0 = u.pn * BM + wc * 32 + 8 * fq;
#pragma unroll
        for (int ai = 0; ai < 2; ++ai)
#pragma unroll
            for (int m = 0; m < 4; ++m) { bf16_t* rowp = O + (size_t)(row0 + ai * HALF + m * 16) * ldc + col0;
#pragma unroll
                for (int bj = 0; bj < 2; ++bj) *(u32x4*)(rowp + bj * HALF) = pack8(acc[ai][bj][m][0], acc[ai][bj][m][1]); }
    }
};
#ifdef EPI_NT
#define EPI_ST(p, v) __builtin_nontemporal_store((v), (p))
#else
#define EPI_ST(p, v) (*(p) = (v))
#endif
struct EpiNull {
    static constexpr bool PERM = true, AFTER_DRAIN = false, DEFER_LAST = false;
    float* sink;
    __device__ __forceinline__ void operator()(const f32x4 (&acc)[2][2][4][2], const Unit& u, int wr, int wc, int fr, int fq) const {
        float s = 0.f;
#pragma unroll
        for (int ai = 0; ai < 2; ++ai)
#pragma unroll
            for (int bj = 0; bj < 2; ++bj)
#pragma unroll
                for (int m = 0; m < 4; ++m)
#pragma unroll
                    for (int n = 0; n < 2; ++n) s += acc[ai][bj][m][n][0] + acc[ai][bj][m][n][1] + acc[ai][bj][m][n][2] + acc[ai][bj][m][n][3];
        if (s == 1.2345e-30f) sink[0] = s;
    }
};
struct EpiInProj {
    static constexpr bool PERM = true, AFTER_DRAIN = false, DEFER_LAST = false;
    bf16_t* O; float* dtraw; bool skip;
    __device__ __forceinline__ void operator()(const f32x4 (&acc)[2][2][4][2], const Unit& u, int wr, int wc, int fr, int fq) const {
        if (skip) return;
        const int row0 = u.pm * BM + wr * 64 + fr, col0 = u.pn * BM + wc * 32 + 8 * fq;
#pragma unroll
        for (int ai = 0; ai < 2; ++ai)
#pragma unroll
            for (int m = 0; m < 4; ++m) { bf16_t* rowp = O + (size_t)(row0 + ai * HALF + m * 16) * 5120 + col0;
#pragma unroll
                for (int bj = 0; bj < 2; ++bj) EPI_ST((u32x4*)(rowp + bj * HALF), pack8(acc[ai][bj][m][0], acc[ai][bj][m][1])); }
    }
};
struct EpiResid {
    static constexpr bool PERM = true, AFTER_DRAIN = false, DEFER_LAST = false;
    const float* inF; const bf16_t* inB; bf16_t* out; const float* gate;
    __device__ __forceinline__ void operator()(const f32x4 (&acc)[2][2][4][2], const Unit& u, int wr, int wc, int fr, int fq) const {
        const int col0 = u.pn * BM + wc * 32 + 8 * fq;
        f32x4 gv[2][2];
        { const float* g = gate + (size_t)(u.pm >> 5) * 6144 + col0;
#pragma unroll
          for (int bj = 0; bj < 2; ++bj)
#pragma unroll
              for (int n = 0; n < 2; ++n) gv[bj][n] = *(const f32x4*)(g + bj * HALF + 4 * n); }
#pragma unroll
        for (int ai = 0; ai < 2; ++ai) {
            if (inF != nullptr) {
#pragma unroll
                for (int mp = 0; mp < 2; ++mp) {
                    f32x4 bs[2][2][2];
#pragma unroll
                    for (int mm = 0; mm < 2; ++mm) { const int row = u.pm * BM + ai * HALF + wr * 64 + (2 * mp + mm) * 16 + fr; const float* ip = inF + (size_t)row * 1024 + col0;
#pragma unroll
                        for (int bj = 0; bj < 2; ++bj)
#pragma unroll
                            for (int n = 0; n < 2; ++n) bs[mm][bj][n] = *(const f32x4*)(ip + bj * HALF + 4 * n); }
#pragma unroll
                    for (int mm = 0; mm < 2; ++mm) { const int m = 2 * mp + mm, row = u.pm * BM + ai * HALF + wr * 64 + m * 16 + fr; bf16_t* op = out + (size_t)row * 1024 + col0;
#pragma unroll
                        for (int bj = 0; bj < 2; ++bj) *(u32x4*)(op + bj * HALF) = pack8(bs[mm][bj][0] + gv[bj][0] * acc[ai][bj][m][0], bs[mm][bj][1] + gv[bj][1] * acc[ai][bj][m][1]); }
                    asm volatile("" ::: "memory");
                }
            } else {
                u32x4 bb[4][2];
#pragma unroll
                for (int m = 0; m < 4; ++m) { const int row = u.pm * BM + ai * HALF + wr * 64 + m * 16 + fr; const bf16_t* ip = inB + (size_t)row * 1024 + col0;
#pragma unroll
                    for (int bj = 0; bj < 2; ++bj) bb[m][bj] = *(const u32x4*)(ip + bj * HALF); }
#pragma unroll
                for (int m = 0; m < 4; ++m) { const int row = u.pm * BM + ai * HALF + wr * 64 + m * 16 + fr; bf16_t* op = out + (size_t)row * 1024 + col0;
#pragma unroll
                    for (int bj = 0; bj < 2; ++bj) { const u32x4 w = bb[m][bj];
                        const f32x4 x0 = (f32x4){__builtin_bit_cast(float, w.x << 16), __builtin_bit_cast(float, w.x & 0xffff0000u), __builtin_bit_cast(float, w.y << 16), __builtin_bit_cast(float, w.y & 0xffff0000u)};
                        const f32x4 x1 = (f32x4){__builtin_bit_cast(float, w.z << 16), __builtin_bit_cast(float, w.z & 0xffff0000u), __builtin_bit_cast(float, w.w << 16), __builtin_bit_cast(float, w.w & 0xffff0000u)};
                        *(u32x4*)(op + bj * HALF) = pack8(x0 + gv[bj][0] * acc[ai][bj][m][0], x1 + gv[bj][1] * acc[ai][bj][m][1]); } }
            }
        }
    }
};
__device__ __forceinline__ f32x4 dpp_ror(const f32x4 v, const int n) {
    f32x4 r;
#pragma unroll
    for (int j = 0; j < 4; ++j) r[j] = n == 1 ? __builtin_bit_cast(float, __builtin_amdgcn_update_dpp(0, __float_as_int(v[j]), 0x121, 0xf, 0xf, false))
                                              : __builtin_bit_cast(float, __builtin_amdgcn_update_dpp(0, __float_as_int(v[j]), 0x122, 0xf, 0xf, false));
    return r;
}
__device__ __forceinline__ float silu_f(float x) { return x * __builtin_amdgcn_rcpf(1.0f + __expf(-x)); }
struct EpiUpConv {
    static constexpr bool PERM = true, AFTER_DRAIN = false, DEFER_LAST = true;
    bf16_t* G; float* UB; const float* fw; const float* fb; float* ffnP; float* ffnS; const float* st; bool skip;
    __device__ __forceinline__ void operator()(const f32x4 (&acc)[2][2][4][2], const Unit& u, int wr, int wc, int fr, int fq) const {
        if (skip) return;
        const int cg0 = u.pn * 128 + wc * 32 + 8 * fq;
        u32x2 held[2][4];
#pragma unroll
        for (int n = 0; n < 2; ++n) {
            const int ch = cg0 + 4 * n;
            f32x4 w[2][3], bs[2];
#pragma unroll
            for (int pt = 0; pt < 2; ++pt) { bs[pt] = *(const f32x4*)(fb + pt * 2816 + ch);
#pragma unroll
                for (int k = 0; k < 3; ++k) w[pt][k] = *(const f32x4*)(fw + k * 5632 + pt * 2816 + ch); }
#pragma unroll
            for (int ai = 0; ai < 2; ++ai)
#pragma unroll
                for (int m = 0; m < 4; ++m) {
                    int row = u.pm * BM + ai * HALF + wr * 64 + m * 16 + fr; asm volatile("" : "+v"(row));
                    f32x4 a[2];
#pragma unroll
                    for (int pt = 0; pt < 2; ++pt) {
                        const f32x4 cur = acc[ai][pt][m][n];
                        f32x4 p1, p2;
                        {
                            const f32x4 pv = acc[ai][pt][m > 0 ? m - 1 : 0][n];
#pragma unroll
                            for (int j = 0; j < 4; ++j) {
                                const int o1 = __builtin_amdgcn_update_dpp(0, __float_as_int(pv[j]), 0x121, 0xf, 0xf, false);
                                const int o2 = __builtin_amdgcn_update_dpp(0, __float_as_int(pv[j]), 0x122, 0xf, 0xf, false);
                                p1[j] = __builtin_bit_cast(float, __builtin_amdgcn_update_dpp(o1, __float_as_int(cur[j]), 0x111, 0xf, 0xf, false));
                                p2[j] = __builtin_bit_cast(float, __builtin_amdgcn_update_dpp(o2, __float_as_int(cur[j]), 0x112, 0xf, 0xf, false)); }
                        }
                        a[pt] = bs[pt] + w[pt][0] * p2 + w[pt][1] * p1 + w[pt][2] * cur;
                        { const int t = row & 8191;
                            if (t >= 8190) *(f32x4*)(ffnP + ((size_t)(row >> 13) * 2 + (t - 8190)) * 5632 + pt * 2816 + ch) = cur;
                            if ((m == 0 && fr < 2) || (m == 3 && fr >= 14)) *(f32x4*)(UB + ((size_t)(row >> 6) * 4 + (m == 0 ? fr : fr - 12)) * 5632 + pt * 2816 + ch) = cur; }
                    }
                    if (!(m == 0 && fr < 2)) {
                        u32x2 o; o.x = cvt_pk_bf16(silu_f(a[0][0]) * a[1][0], silu_f(a[0][1]) * a[1][1]); o.y = cvt_pk_bf16(silu_f(a[0][2]) * a[1][2], silu_f(a[0][3]) * a[1][3]);
                        if (n == 0) held[ai][m] = o; else *(u32x4*)(G + (size_t)row * 2816 + cg0) = (u32x4){held[ai][m].x, held[ai][m].y, o.x, o.y}; }
                    asm volatile("" ::: "memory");
                }
        }
    }
    __device__ __forceinline__ bool defer(const Unit& u) const { return u.pm >= 64; }
    __device__ __forceinline__ void deferred(const f32x4 (&acc)[2][2][4][2], const Unit& u, PG8_LAS unsigned char* lds, int wid) const {
        if (skip) return;
        int lane; asm volatile("v_mbcnt_lo_u32_b32 %0, -1, 0\n\tv_mbcnt_hi_u32_b32 %0, -1, %0" : "=v"(lane));
        const int wr = wid >> 2, wc = wid & 3, fr = lane & 15, fq = lane >> 4;
#pragma unroll
        for (int k = 0; k < 8; ++k) { const int p = (k * 8 + wid) * 64 + lane, c4 = p & 31, pt = (p >> 5) & 1, rw = (p >> 6) & 1, b = p >> 7;
            __builtin_amdgcn_global_load_lds((const unsigned*)(st + ((size_t)b * 2 + rw) * 5632 + pt * 2816 + u.pn * 128 + c4 * 4), (PG8_LAS unsigned*)(lds + (k * 8 + wid) * 1024), 16, 0, 0); }
        asm volatile("s_waitcnt vmcnt(0)" ::: "memory"); __builtin_amdgcn_s_barrier();
        const int cg0 = u.pn * 128 + wc * 32 + 8 * fq, t = fr & 7;
        u32x2 held[2][4];
#pragma unroll
        for (int n = 0; n < 2; ++n) {
            const int ch = cg0 + 4 * n;
            f32x4 w[2][3], bs[2];
#pragma unroll
            for (int pt = 0; pt < 2; ++pt) { bs[pt] = *(const f32x4*)(fb + pt * 2816 + ch);
#pragma unroll
                for (int k = 0; k < 3; ++k) w[pt][k] = *(const f32x4*)(fw + k * 5632 + pt * 2816 + ch); }
#pragma unroll
            for (int ai = 0; ai < 2; ++ai)
#pragma unroll
                for (int m = 0; m < 4; ++m) {
                    int rl = ai * HALF + wr * 64 + m * 16 + fr; asm volatile("" : "+v"(rl));
                    const int row = u.pm * BM + rl, b = rl >> 3;
                    f32x4 a[2];
#pragma unroll
                    for (int pt = 0; pt < 2; ++pt) {
                        const f32x4 cur = acc[ai][pt][m][n];
                        const PG8_LAS f32x4* sp = (const PG8_LAS f32x4*)lds + b * 128 + pt * 32 + wc * 8 + 2 * fq + n;
                        const f32x4 s0 = sp[0], s1 = sp[64];
                        f32x4 c1, c2;
#pragma unroll
                        for (int j = 0; j < 4; ++j) {
                            c1[j] = __builtin_bit_cast(float, __builtin_amdgcn_update_dpp(0, __float_as_int(cur[j]), 0x111, 0xf, 0xf, false));
                            c2[j] = __builtin_bit_cast(float, __builtin_amdgcn_update_dpp(0, __float_as_int(cur[j]), 0x112, 0xf, 0xf, false)); }
                        const f32x4 p1 = t >= 1 ? c1 : s1, p2 = t >= 2 ? c2 : (t == 1 ? s1 : s0);
                        a[pt] = bs[pt] + w[pt][0] * p2 + w[pt][1] * p1 + w[pt][2] * cur;
                        if (t >= 6) *(f32x4*)(ffnS + ((size_t)(rl >> 3) * 2 + (t - 6)) * 5632 + pt * 2816 + ch) = cur;
                    }
                    u32x2 o; o.x = cvt_pk_bf16(silu_f(a[0][0]) * a[1][0], silu_f(a[0][1]) * a[1][1]); o.y = cvt_pk_bf16(silu_f(a[0][2]) * a[1][2], silu_f(a[0][3]) * a[1][3]);
                    if (n == 0) held[ai][m] = o; else *(u32x4*)(G + (size_t)row * 2816 + cg0) = (u32x4){held[ai][m].x, held[ai][m].y, o.x, o.y};
                    asm volatile("" ::: "memory");
                }
        }
    }
};
struct RopeCS { f32x4 v[4]; };
__device__ __forceinline__ RopeCS rope_load(const float* rp) { RopeCS r;
#pragma unroll
    for (int q = 0; q < 4; ++q) r.v[q] = *(const f32x4*)(rp + 4 * q);
    return r; }
__device__ __forceinline__ void rope8(const f32x4 (&a0)[2], const f32x4 (&a1)[2], const RopeCS& R, float sc, f32x4 (&o1)[2], f32x4 (&o2)[2]) {
#pragma unroll
    for (int n = 0; n < 2; ++n) { const f32x4 cs0 = R.v[2 * n], cs1 = R.v[2 * n + 1];
        const float c[4] = {cs0[0], cs0[2], cs1[0], cs1[2]}, s[4] = {cs0[1], cs0[3], cs1[1], cs1[3]};
#pragma unroll
        for (int j = 0; j < 4; ++j) { const float x1 = a0[n][j], x2 = a1[n][j]; o1[n][j] = (x1 * c[j] - x2 * s[j]) * sc; o2[n][j] = (x2 * c[j] + x1 * s[j]) * sc; } }
}
__device__ __forceinline__ int row_pos(int row) { return row < 16384 ? (row & 8191) : 8192 + ((row - 16384) & 7); }
struct EpiRopeKV {
    static constexpr bool PERM = true, AFTER_DRAIN = false, DEFER_LAST = false;
    bf16_t* Kb; bf16_t* Vb; float* kP; float* kS; float* vP; float* vS; const float* rope;
    __device__ __forceinline__ void operator()(const f32x4 (&acc)[2][2][4][2], const Unit& u, int wr, int wc, int fr, int fq) const {
#pragma unroll
        for (int ai = 0; ai < 2; ++ai) {
            RopeCS R[4];
            if (u.pn < 12) {
#pragma unroll
                for (int m = 0; m < 4; ++m) R[m] = rope_load(rope + ((size_t)row_pos(u.pm * BM + ai * HALF + wr * 64 + m * 16 + fr) * 32 + 8 * fq) * 2); }
#pragma unroll
            for (int m = 0; m < 4; ++m) {
                const int rl = ai * HALF + wr * 64 + m * 16 + fr, row = u.pm * BM + rl;
                bool fo; size_t forow;
                if (u.pm < 64) { const int t = row & 8191; fo = t >= 6144; forow = (size_t)(row >> 13) * 2048 + (t - 6144); } else { fo = true; forow = (size_t)(row - 16384); }
                if (u.pn < 12) {
                    f32x4 o1[2], o2[2]; rope8(acc[ai][0][m], acc[ai][1][m], R[m], 1.0f, o1, o2);
                    const int colA = u.pn * BM + 64 * wc + 8 * fq;
                    bf16_t* kp = Kb + (size_t)row * 3072 + colA;
                    EPI_ST((u32x4*)kp, pack8(o1[0], o1[1])); EPI_ST((u32x4*)(kp + 32), pack8(o2[0], o2[1]));
                    if (fo) { float* f = ((u.pm < 64) ? kP : kS) + forow * 3072 + colA;
                        EPI_ST((f32x4*)f, o1[0]); EPI_ST((f32x4*)(f + 4), o1[1]); EPI_ST((f32x4*)(f + 32), o2[0]); EPI_ST((f32x4*)(f + 36), o2[1]); }
                } else {
#pragma unroll
                    for (int bj = 0; bj < 2; ++bj) { const int vcol = (u.pn - 12) * BM + bj * HALF + wc * 32 + 8 * fq;
                        EPI_ST((u32x4*)(Vb + (size_t)row * 3072 + vcol), pack8(acc[ai][bj][m][0], acc[ai][bj][m][1]));
                        if (fo) { float* f = ((u.pm < 64) ? vP : vS) + forow * 3072 + vcol; EPI_ST((f32x4*)f, acc[ai][bj][m][0]); EPI_ST((f32x4*)(f + 4), acc[ai][bj][m][1]); } }
                }
            }
        }
    }
};
struct EpiRopeQ {
    static constexpr bool PERM = true, AFTER_DRAIN = false, DEFER_LAST = false;
    bf16_t* Qb; const float* rope; float qscale;
    __device__ __forceinline__ void operator()(const f32x4 (&acc)[2][2][4][2], const Unit& u, int wr, int wc, int fr, int fq) const {
#pragma unroll
        for (int ai = 0; ai < 2; ++ai) {
            RopeCS R[4];
#pragma unroll
            for (int m = 0; m < 4; ++m) R[m] = rope_load(rope + ((size_t)row_pos(u.pm * BM + ai * HALF + wr * 64 + m * 16 + fr) * 32 + 8 * fq) * 2);
#pragma unroll
            for (int m = 0; m < 4; ++m) {
                const int rl = ai * HALF + wr * 64 + m * 16 + fr, row = u.pm * BM + rl;
                f32x4 o1[2], o2[2]; rope8(acc[ai][0][m], acc[ai][1][m], R[m], qscale, o1, o2);
                bf16_t* qp = Qb + (size_t)row * 3072 + u.pn * BM + 64 * wc + 8 * fq;
                EPI_ST((u32x4*)qp, pack8(o1[0], o1[1])); EPI_ST((u32x4*)(qp + 32), pack8(o2[0], o2[1]));
            }
        }
    }
};

template <class Epi, class Sched, bool ALIGN_EPI = false, bool SP2 = false>
__device__ __forceinline__ void gemm_phase(PG8_LAS unsigned char* lds, const Gemm g, const Sched& S, const Epi& E, int tid_in) {
    int tid_ = tid_in; asm volatile("" : "+v"(tid_));
    const int tid = tid_, wid = __builtin_amdgcn_readfirstlane(tid >> 6), lane = tid & 63, wr = wid >> 2, wc = wid & 3, fr = lane & 15, fq = lane >> 4;
    const int K = g.K, nt = K / BK;
    unsigned voffA[2], voffB[2];
#pragma unroll
    for (int i = 0; i < 2; ++i) { int R, C; stage_rc(tid * 16 + i * 8192, R, C); const int Rb = Epi::PERM ? ((R & ~31) + perm32(R & 31)) : R;
        voffA[i] = (unsigned)(R * K + C) * 2u; voffB[i] = (unsigned)(Rb * K + C) * 2u; }
    const size_t kstep = (size_t)(BK * 2);
    const size_t hstep = (size_t)HALF * K * 2;
    const size_t tstep = 2 * hstep;
    const unsigned ldsw = (unsigned)wid * 1024u;
    const int aoff = lds_byte(wr * 64 + fr, fq * 8), boff = lds_byte(wc * 32 + fr, fq * 8);
#define PG8_SA(b, h) (((b) * 2 + (h)) * HTB)
#define PG8_SB(b, h) ((4 + (b) * 2 + (h)) * HTB)
#ifndef GEMM_B_AUX
#define GEMM_B_AUX 0
#endif
#ifndef GEMM_A_AUX
#define GEMM_A_AUX 0
#endif
#define PG8_STAGE(bufoff, gbase, voff) do { if ((bufoff) >= 4 * HTB) { _Pragma("unroll") for (int _i = 0; _i < 2; ++_i) \
        __builtin_amdgcn_global_load_lds((const unsigned*)((const char*)(gbase) + (voff)[_i]), (PG8_LAS unsigned*)(lds + (bufoff) + ldsw + _i * 8192), 16, 0, GEMM_B_AUX); } else { _Pragma("unroll") for (int _i = 0; _i < 2; ++_i) \
        __builtin_amdgcn_global_load_lds((const unsigned*)((const char*)(gbase) + (voff)[_i]), (PG8_LAS unsigned*)(lds + (bufoff) + ldsw + _i * 8192), 16, 0, GEMM_A_AUX); } } while (0)
#define PG8_LDA(dst, b, h) do { _Pragma("unroll") for (int m = 0; m < 4; ++m) _Pragma("unroll") for (int k = 0; k < 2; ++k) dst[m][k] = *(const PG8_LAS bf16x8*)(lds + PG8_SA(b, h) + aoff + m * 2048 + k * 1024); } while (0)
#define PG8_LDB(dst, b, h) do { _Pragma("unroll") for (int n = 0; n < 2; ++n) _Pragma("unroll") for (int k = 0; k < 2; ++k) dst[n][k] = *(const PG8_LAS bf16x8*)(lds + PG8_SB(b, h) + boff + n * 2048 + k * 1024); } while (0)
#define PG8_MMA(ai, bj, At, Bt) do { __builtin_amdgcn_s_setprio(1); _Pragma("unroll") for (int m = 0; m < 4; ++m) _Pragma("unroll") for (int n = 0; n < 2; ++n) _Pragma("unroll") for (int k = 0; k < 2; ++k) \
        acc[ai][bj][m][n] = __builtin_amdgcn_mfma_f32_16x16x32_bf16(Bt[n][k], At[m][k], acc[ai][bj][m][n], 0, 0, 0); __builtin_amdgcn_s_setprio(0); } while (0)
#if PROBE_FLAGS != 0
#define PG8_STAGE_P(bufoff, gbase, voff) do { if (!(g.pf & 1)) PG8_STAGE(bufoff, gbase, voff); } while (0)
#define PG8_LDA_P(dst, b, h) do { if (!(g.pf & 2)) PG8_LDA(dst, b, h); } while (0)
#define PG8_MMA_P(ai, bj, At, Bt) do { if (!(g.pf & 4)) PG8_MMA(ai, bj, At, Bt); } while (0)
#else
#define PG8_STAGE_P PG8_STAGE
#define PG8_LDA_P PG8_LDA
#define PG8_MMA_P PG8_MMA
#endif
#define PG8_WAIT_V(n) asm volatile("s_waitcnt vmcnt(" #n ")" ::: "memory")
#define PG8_WAIT_L(n) asm volatile("s_waitcnt lgkmcnt(" #n ")" ::: "memory")
#define PG8_BAR __builtin_amdgcn_s_barrier()
#define PG8_SCHED __builtin_amdgcn_sched_barrier(0)
    Unit cur, nxt; int ui = 0;
    if (!S.next(0, cur)) return;
    f32x4 acc[2][2][4][2];
#pragma unroll
    for (int a = 0; a < 2; ++a)
#pragma unroll
        for (int b = 0; b < 2; ++b)
#pragma unroll
            for (int m = 0; m < 4; ++m)
#pragma unroll
                for (int n = 0; n < 2; ++n) acc[a][b][m][n] = (f32x4){0.f, 0.f, 0.f, 0.f};
    bf16x8 At[4][2], B0[2][2], B1[2][2];
    const char* cA = (const char*)g.A + (size_t)cur.pm * tstep; const char* cB = (const char*)g.Bt + (size_t)cur.pn * tstep;
    S.a_ready(cur);
    if constexpr (SP2) {
        PG8_STAGE(PG8_SB(0, 0), cB, voffB); PG8_STAGE(PG8_SB(0, 1), cB + hstep, voffB); PG8_STAGE(PG8_SA(0, 0), cA, voffA); PG8_STAGE(PG8_SA(0, 1), cA + hstep, voffA);
        if (wr == 1) PG8_BAR;
        PG8_WAIT_V(2); PG8_BAR;
        PG8_STAGE(PG8_SB(1, 0), cB + kstep, voffB); PG8_STAGE(PG8_SA(1, 0), cA + kstep, voffA); PG8_STAGE(PG8_SB(1, 1), cB + hstep + kstep, voffB);
        PG8_WAIT_V(6); PG8_BAR;
    } else {
        PG8_STAGE(PG8_SB(0, 0), cB, voffB); PG8_STAGE(PG8_SA(0, 0), cA, voffA); PG8_STAGE(PG8_SB(0, 1), cB + hstep, voffB); PG8_STAGE(PG8_SA(0, 1), cA + hstep, voffA);
        if (wr == 1) PG8_BAR;
        PG8_WAIT_V(4); PG8_BAR;
        PG8_STAGE(PG8_SB(1, 0), cB + kstep, voffB); PG8_STAGE(PG8_SA(1, 0), cA + kstep, voffA); PG8_STAGE(PG8_SB(1, 1), cB + hstep + kstep, voffB);
        PG8_WAIT_V(6); PG8_BAR;
    }
    for (;;) {
        const bool has_next = S.next(ui + 1, nxt);
        const char* nA = has_next ? (const char*)g.A + (size_t)nxt.pm * tstep : cA; const char* nB = has_next ? (const char*)g.Bt + (size_t)nxt.pn * tstep : cB;
        for (int t = 0; t < nt; t += 2) {
            const bool last = (t == nt - 2);
            const char* a1 = cA + (size_t)(t + 1) * kstep;
            const char* a2 = last ? nA : cA + (size_t)(t + 2) * kstep; const char* b2 = last ? nB : cB + (size_t)(t + 2) * kstep;
            const char* a3 = a2 + kstep; const char* b3 = b2 + kstep;
            if (last && has_next) S.a_ready(nxt);
            if constexpr (SP2) {
            PG8_LDB(B0, 0, 0); PG8_LDB(B1, 0, 1); PG8_SCHED; PG8_LDA(At, 0, 0); PG8_STAGE_P(PG8_SA(1, 1), a1 + hstep, voffA);
            PG8_WAIT_V(8); PG8_WAIT_L(0); PG8_BAR; PG8_MMA_P(0, 0, At, B0); PG8_MMA_P(0, 1, At, B1); PG8_BAR; PG8_SCHED;
            PG8_LDA_P(At, 0, 1); PG8_STAGE_P(PG8_SB(0, 0), b2, voffB); PG8_STAGE_P(PG8_SB(0, 1), b2 + hstep, voffB); PG8_STAGE_P(PG8_SA(0, 0), a2, voffA);
            PG8_WAIT_V(8); PG8_WAIT_L(0); PG8_BAR; PG8_MMA_P(1, 0, At, B0); PG8_MMA_P(1, 1, At, B1); PG8_BAR; PG8_SCHED;
            PG8_LDB(B0, 1, 0); PG8_LDB(B1, 1, 1); PG8_SCHED; PG8_LDA(At, 1, 0); PG8_STAGE_P(PG8_SA(0, 1), a2 + hstep, voffA);
            PG8_WAIT_V(8); PG8_WAIT_L(0); PG8_BAR; PG8_MMA_P(0, 0, At, B0); PG8_MMA_P(0, 1, At, B1); PG8_BAR; PG8_SCHED;
            PG8_LDA_P(At, 1, 1); PG8_STAGE_P(PG8_SB(1, 0), b3, voffB); PG8_STAGE_P(PG8_SB(1, 1), b3 + hstep, voffB); PG8_STAGE_P(PG8_SA(1, 0), a3, voffA);
            PG8_WAIT_V(8); PG8_WAIT_L(0); PG8_BAR; PG8_MMA_P(1, 0, At, B0); PG8_MMA_P(1, 1, At, B1); PG8_BAR; PG8_SCHED;
            } else {
            PG8_LDB(B0, 0, 0); PG8_SCHED; PG8_LDA(At, 0, 0); PG8_STAGE(PG8_SA(1, 1), a1 + hstep, voffA);
            PG8_WAIT_L(8); PG8_BAR; PG8_WAIT_L(0); PG8_MMA(0, 0, At, B0); PG8_BAR; PG8_SCHED;
            PG8_LDB(B1, 0, 1); PG8_STAGE(PG8_SB(0, 0), b2, voffB);
            PG8_BAR; PG8_WAIT_L(0); PG8_MMA(0, 1, At, B1); PG8_BAR;
            PG8_LDA(At, 0, 1); PG8_STAGE(PG8_SA(0, 0), a2, voffA);
            PG8_BAR; PG8_WAIT_L(0); PG8_MMA(1, 0, At, B0); PG8_BAR; PG8_SCHED;
            PG8_STAGE(PG8_SB(0, 1), b2 + hstep, voffB);
            PG8_WAIT_V(6); PG8_BAR; PG8_MMA(1, 1, At, B1); PG8_BAR;
            PG8_LDB(B0, 1, 0); PG8_SCHED; PG8_LDA(At, 1, 0); PG8_STAGE(PG8_SA(0, 1), a2 + hstep, voffA);
            PG8_WAIT_L(8); PG8_BAR; PG8_WAIT_L(0); PG8_MMA(0, 0, At, B0); PG8_BAR; PG8_SCHED;
            PG8_LDB(B1, 1, 1); PG8_STAGE(PG8_SB(1, 0), b3, voffB);
            PG8_BAR; PG8_WAIT_L(0); PG8_MMA(0, 1, At, B1); PG8_BAR;
            PG8_LDA(At, 1, 1); PG8_STAGE(PG8_SA(1, 0), a3, voffA);
            PG8_BAR; PG8_WAIT_L(0); PG8_MMA(1, 0, At, B0); PG8_BAR; PG8_SCHED;
            PG8_STAGE(PG8_SB(1, 1), b3 + hstep, voffB);
            PG8_WAIT_V(6); PG8_BAR; PG8_MMA(1, 1, At, B1); PG8_BAR;
            }
        }
        if constexpr (ALIGN_EPI) { if (wr == 0) PG8_BAR; }
        if constexpr (Epi::DEFER_LAST) { if (!E.defer(cur)) E(acc, cur, wr, wc, fr, fq); S.done(cur); }
        else if constexpr (!Epi::AFTER_DRAIN) { E(acc, cur, wr, wc, fr, fq); S.done(cur); }
        if (!has_next) break;
#pragma unroll
        for (int a = 0; a < 2; ++a)
#pragma unroll
            for (int b = 0; b < 2; ++b)
#pragma unroll
                for (int m = 0; m < 4; ++m)
#pragma unroll
                    for (int n = 0; n < 2; ++n) acc[a][b][m][n] = (f32x4){0.f, 0.f, 0.f, 0.f};
        cur = nxt; cA = nA; cB = nB; ++ui;
        if constexpr (ALIGN_EPI) { if (wr == 1) PG8_BAR; }
    }
    PG8_WAIT_V(0);
    if constexpr (!ALIGN_EPI) { if (wr == 0) PG8_BAR; }
    PG8_BAR;
    if constexpr (Epi::AFTER_DRAIN) { E.fused(acc, cur, wr, wc, fr, fq, lds, wid, lane); S.done(cur); }
    if constexpr (Epi::DEFER_LAST) { if (E.defer(cur)) E.deferred(acc, cur, lds, wid); }
#undef PG8_SA
#undef PG8_SB
#undef PG8_STAGE
#undef PG8_LDA
#undef PG8_LDB
#undef PG8_MMA
#undef PG8_WAIT_V
#undef PG8_WAIT_L
#undef PG8_BAR
#undef PG8_SCHED
}
}

constexpr int NWAVES = 8;
#ifndef MK_N_LAUNCHES
#define MK_N_LAUNCHES 1
#endif

constexpr int DM = 1024, TP = 8192, MP = 16384, SB = 32, ST = 8, MT = 16640, NSEQ = 34;
constexpr int INW = 5120, INPAD = 5376, NHEAD = 32, FF = 2816, FF2 = 5632, AW = 3072;
constexpr float EPS = 1e-6f;
constexpr float QSCALE = 0.125f * 1.4426950408889634f;
constexpr size_t O_YP = 0, O_YS = 16777216, O_SSMP = 17039360, O_SSMS = 18087936, O_CONVP = 34865152, O_CONVS = 34902016, O_FFNP = 35491840, O_FFNS = 35581952,
                 O_KP = 37023744, O_KS = 49606656, O_VP = 50393088, O_VS = 62976000, O_END = 63762432;
enum { I_XP = 0, I_XS, I_SSM, I_CONV, I_FFNC, I_CK, I_CV, I_CP, I_CS, I_ADAW, I_ADAB, I_NMIX, I_NFFN, I_WIN, I_CW, I_CB, I_DTB, I_ALOG, I_D, I_MNORM, I_WOUT, I_KVN, I_KVAW, I_KVAB, I_WKV, I_WQ, I_WO, I_WUP, I_FCW, I_FCB, I_WDN, I_FN };

constexpr size_t MiB = 1u << 20;
constexpr size_t al(size_t x) { return (x + MiB - 1) / MiB * MiB; }
constexpr size_t WS_CTL = 0, CTL_ZERO_BYTES = 1 * MiB;
constexpr size_t WS_MOD = 1 * MiB;
constexpr size_t WS_ROPE = WS_MOD + al((size_t)5 * NSEQ * 6144 * 4);
constexpr size_t WS_DTRAW = WS_ROPE + al((size_t)8200 * 32 * 8);
constexpr size_t WS_DTV = WS_DTRAW + al((size_t)MT * 32 * 4);
constexpr size_t WS_ACUM = WS_DTV + al((size_t)MT * 32 * 4);
constexpr size_t WS_DECAY = WS_ACUM + al((size_t)MT * 32 * 4);
constexpr size_t WS_WIN = WS_DECAY + MiB;
constexpr size_t WS_WOUT = WS_WIN + al((size_t)2 * INPAD * 1024 * 2);
constexpr size_t WS_WUP = WS_WOUT + al((size_t)2 * 1024 * 2048 * 2);
constexpr size_t WS_WDN = WS_WUP + al((size_t)4 * FF2 * 1024 * 2);
constexpr size_t WS_WKV = WS_WDN + al((size_t)4 * 1024 * FF * 2);
constexpr size_t WS_WQ = WS_WKV + al((size_t)6144 * 1024 * 2);
constexpr size_t WS_WO = WS_WQ + al((size_t)2 * AW * 1024 * 2);
constexpr size_t WS_H = WS_WO + al((size_t)2 * 1024 * 1024 * 2);
constexpr size_t WS_XN = WS_H + al((size_t)MT * 1024 * 4);
constexpr size_t WS_XNKV = WS_XN + al((size_t)MT * 1024 * 2);
constexpr size_t WS_BIG = WS_XNKV + al((size_t)MT * 1024 * 2);
constexpr size_t WS_ACT = WS_BIG + al((size_t)MT * FF2 * 2);
constexpr size_t WS_CT = WS_ACT + al((size_t)MT * 3072 * 2);
constexpr size_t WS_STATES = WS_CT + al((size_t)2 * 2560 * 8192 * 2);
constexpr size_t WS_HPREV = WS_STATES + al((size_t)2 * 64 * 32 * 8192 * 4);
constexpr size_t WS_Y = WS_HPREV + al((size_t)2 * 64 * 32 * 8192 * 2);
constexpr size_t WS_KB = WS_Y + al((size_t)MT * 2048 * 2);
constexpr size_t WS_VB = WS_KB + al((size_t)MT * AW * 2);
constexpr size_t WS_QB = WS_VB + al((size_t)MT * AW * 2);
constexpr size_t WS_VT = WS_QB + al((size_t)MT * AW * 2) + MiB;
constexpr size_t WS_OB = WS_VT + al((size_t)2 * 48 * 64 * 8192 * 2) + MiB;
constexpr size_t WS_OG = WS_OB + al((size_t)MT * 1024 * 2);
constexpr size_t WS_ML = WS_OG + al((size_t)3 * MT * 1024 * 2);
constexpr size_t WS_SLAB = WS_ML + al((size_t)3 * MT * 16 * 8);
constexpr size_t WS_UB = WS_SLAB + 4 * MiB;
constexpr size_t WS_END = WS_UB + al((size_t)256 * 4 * 5632 * 4);
constexpr int CW_TMO = 0, CW_CODE = 1, CW_BAR = 4096;

constexpr int RING_OFF = 0, RING_BYTES = 147456;
constexpr int LDSCTL_OFF = RING_BYTES, MISC_OFF = LDSCTL_OFF + 320;
constexpr int LDS_BYTES = RING_BYTES + 1024;

#define GAS __attribute__((address_space(1)))
#define LAS __attribute__((address_space(3)))
typedef unsigned short bf16;
typedef unsigned v4u __attribute__((ext_vector_type(4)));
typedef unsigned v2u __attribute__((ext_vector_type(2)));
typedef float f32x4 __attribute__((ext_vector_type(4)));
typedef float f32x2 __attribute__((ext_vector_type(2)));
typedef short bf16x8 __attribute__((ext_vector_type(8)));
typedef short s16x4 __attribute__((ext_vector_type(4)));
typedef GAS unsigned gu32;
#define RLX_AGENT __ATOMIC_RELAXED, __HIP_MEMORY_SCOPE_AGENT
#define LDS_WAIT() asm volatile("s_waitcnt lgkmcnt(0)" ::: "memory")
#define VM_WAIT() asm volatile("s_waitcnt vmcnt(0)" ::: "memory")
__device__ __forceinline__ int lane_id_v() { int l; asm volatile("v_mbcnt_lo_u32_b32 %0, -1, 0\n\tv_mbcnt_hi_u32_b32 %0, -1, %0" : "=v"(l)); return l; }
__device__ __forceinline__ unsigned f2bf(float f) { unsigned u = __builtin_bit_cast(unsigned, f); return (u + 0x7fffu + ((u >> 16) & 1u)) >> 16; }
__device__ __forceinline__ unsigned pk2(float lo, float hi) { unsigned r; asm("v_cvt_pk_bf16_f32 %0, %1, %2" : "=v"(r) : "v"(lo), "v"(hi)); return r; }
__device__ __forceinline__ float bflo(unsigned w) { return __builtin_bit_cast(float, w << 16); }
__device__ __forceinline__ float bfhi(unsigned w) { return __builtin_bit_cast(float, w & 0xffff0000u); }
__device__ __forceinline__ float bf2f(bf16 h) { return __builtin_bit_cast(float, (unsigned)h << 16); }
__device__ __forceinline__ float silu(float x) { return x * __builtin_amdgcn_rcpf(1.0f + __expf(-x)); }
__device__ __forceinline__ float softplus(float x) { const float y = __expf(x);
    return x > 20.f ? x : (y < 0.03125f ? y * (1.0f + y * (-0.5f + y * (0.33333334f + y * (-0.25f + y * 0.2f)))) : __logf(1.0f + y)); }
__device__ __forceinline__ float row16_sum(float x) {
    x += __builtin_bit_cast(float, __builtin_amdgcn_update_dpp(0, __builtin_bit_cast(int, x), 0x128, 0xf, 0xf, false));
    x += __builtin_bit_cast(float, __builtin_amdgcn_update_dpp(0, __builtin_bit_cast(int, x), 0x124, 0xf, 0xf, false));
    x += __builtin_bit_cast(float, __builtin_amdgcn_update_dpp(0, __builtin_bit_cast(int, x), 0x122, 0xf, 0xf, false));
    x += __builtin_bit_cast(float, __builtin_amdgcn_update_dpp(0, __builtin_bit_cast(int, x), 0x121, 0xf, 0xf, false));
    return x;
}
__device__ __forceinline__ float wave_sum(float v) {
#pragma unroll
    for (int o = 1; o < 64; o <<= 1) v += __shfl_xor(v, o);
    return v;
}
__device__ __forceinline__ float wave_max(float v) {
#pragma unroll
    for (int o = 1; o < 64; o <<= 1) v = fmaxf(v, __shfl_xor(v, o));
    return v;
}
template <int N> struct TR {
    static __device__ __forceinline__ float run(float (&v)[N], int lane) {
        constexpr int H = N / 2; float r[H];
        const bool up = (lane & H) != 0;
#pragma unroll
        for (int i = 0; i < H; ++i) { const float keep = up ? v[i + H] : v[i], send = up ? v[i] : v[i + H]; r[i] = keep + __shfl_xor(send, H); }
        return TR<H>::run(r, lane);
    }
};
template <> struct TR<1> { static __device__ __forceinline__ float run(float (&v)[1], int) { return v[0]; } };

#define XB_TMO      128
#define XB_XCNT(j)  (256  + 64 * (j))
#define XB_XSUB(j)  (1280 + 64 * (j))
#define XB_XGEN(j)  (2304 + 64 * (j))
#define XB_TOP      3328
#define XB_TOPGEN   3392
#define XCD_BAR_WORDS 3456
#define XB_SPIN_CAP (1u << 18)

__device__ __forceinline__ unsigned xb_ld(unsigned* p)              { return __hip_atomic_load(p, __ATOMIC_RELAXED, __HIP_MEMORY_SCOPE_AGENT); }
__device__ __forceinline__ unsigned xb_add(unsigned* p, unsigned v) { return __hip_atomic_fetch_add(p, v, __ATOMIC_RELAXED, __HIP_MEMORY_SCOPE_AGENT); }
__device__ __forceinline__ unsigned xb_xcc_id() { return (unsigned)__builtin_amdgcn_s_getreg((3 << 11) | 20) & 0xFu; }
#define XB_SPIN(cond, bar) do { unsigned _sp = 0; while (cond) { __builtin_amdgcn_s_sleep(1); \
    if ((++_sp & 255u) == 0u) { if (xb_ld(&(bar)[XB_TMO])) break; if (_sp > XB_SPIN_CAP) { atomicAdd(&(bar)[XB_TMO], 1u); break; } } } } while (0)

struct XcdBarrier {
    unsigned* bar; unsigned x;
    volatile LAS unsigned* st; int wave;
};

__device__ __forceinline__ XcdBarrier xcd_barrier_post(unsigned* bar, volatile LAS unsigned* st) {
    XcdBarrier b; b.bar = bar; b.x = xb_xcc_id(); b.st = st;
    if (threadIdx.x == 0) (void)xb_add(&bar[XB_XCNT(b.x)], 1u);
    return b;
}
__device__ __forceinline__ void xcd_barrier_complete(unsigned* bar, unsigned x, unsigned& nloc, unsigned& nx) {
    const unsigned G = gridDim.x * gridDim.y * gridDim.z;
    unsigned sum, cnt, mine, sp = 0u;
    for (;;) {
        sum = 0u; cnt = 0u; mine = 0u;
#pragma unroll
        for (unsigned j = 0; j < 16; ++j) { const unsigned c = xb_ld(&bar[XB_XCNT(j)]); sum += c; cnt += (c > 0u) ? 1u : 0u; mine = (j == x) ? c : mine; }
        if (sum == G) break;
        __builtin_amdgcn_s_sleep(1);
        if ((++sp & 255u) == 0u) { if (xb_ld(&bar[XB_TMO])) break; if (sp > XB_SPIN_CAP) { atomicAdd(&bar[XB_TMO], 1u); break; } }
    }
    nloc = mine > 0u ? mine : 1u; nx = cnt > 0u ? cnt : 1u;
}

__device__ __forceinline__ void xcd_barrier(const XcdBarrier& b) {
    asm volatile("s_waitcnt vmcnt(0)" ::: "memory");
    __syncthreads();
    if (b.wave == 0 && lane_id_v() == 0) {
        unsigned* bar = b.bar;
        __builtin_amdgcn_s_waitcnt(0);
        unsigned nloc = b.st[0], nx = b.st[1];
        if (nloc == 0u) { xcd_barrier_complete(bar, b.x, nloc, nx); b.st[0] = nloc; b.st[1] = nx; }
        const unsigned old = xb_add(&bar[XB_XSUB(b.x)], 1u);
        const unsigned gen = old / nloc;
        if (old + 1u == (gen + 1u) * nloc) {
            __builtin_amdgcn_fence(__ATOMIC_RELEASE, "agent");
            asm volatile("s_waitcnt vmcnt(0)" ::: "memory");
            const unsigned og = xb_add(&bar[XB_TOP], 1u);
            const unsigned tg = og / nx;
            if (og + 1u == (tg + 1u) * nx) xb_add(&bar[XB_TOPGEN], 1u);
            else XB_SPIN(xb_ld(&bar[XB_TOPGEN]) == tg, bar);
            __builtin_amdgcn_fence(__ATOMIC_ACQUIRE, "agent");
            xb_add(&bar[XB_XGEN(b.x)], 1u);
            asm volatile("s_waitcnt vmcnt(0)" ::: "memory");
        } else {
            XB_SPIN(xb_ld(&bar[XB_XGEN(b.x)]) == gen, bar);
            __builtin_amdgcn_fence(__ATOMIC_ACQUIRE, "agent");
            asm volatile("s_waitcnt vmcnt(0)" ::: "memory");
        }
    }
    __syncthreads();
}

struct Frame {
    LAS unsigned char* lds;
    volatile LAS unsigned* MISC;
    gu32* ctl;
    int tid, lane, wave, G, vcu, pflags;
    const float* const* in; float* out; unsigned char* ws;
};
#define WSP(T, off) ((T*)(F.ws + (off)))

struct TrJob { const float* src; bf16* dst; int ldw, K, n0, k0, mode; };
__device__ __forceinline__ TrJob tr_job(const float* W, int ldw, int col_base, int K, int ncols, bf16* WT, int mode, int item) {
    const int nblk = ncols / 32, kb = item / nblk, nb = item % nblk; TrJob j; j.k0 = 64 * kb; j.n0 = 32 * nb; j.src = W + (size_t)j.k0 * ldw + col_base + j.n0; j.dst = WT; j.ldw = ldw; j.K = K; j.mode = mode; return j;
}
__device__ __forceinline__ void tr_load(const TrJob& j, f32x4 (&buf)[8], int lane) {
    const int r8 = lane >> 3, c4 = lane & 7;
#pragma unroll
    for (int i = 0; i < 8; ++i) buf[i] = *(const f32x4*)(j.src + (size_t)(8 * i + r8) * j.ldw + 4 * c4);
}
__device__ __forceinline__ void tr_store(const TrJob& j, const f32x4 (&buf)[8], LAS float* scr, int lane) {
    const int r8 = lane >> 3, c4 = lane & 7;
#pragma unroll
    for (int i = 0; i < 8; ++i) *(LAS f32x4*)(scr + (8 * i + r8) * 36 + 4 * c4) = buf[i];
    LDS_WAIT();
    const int c = lane & 7;
#pragma unroll
    for (int jj = 0; jj < 4; ++jj) { const int n = (lane >> 3) + 8 * jj; const LAS float* s = scr + (8 * c) * 36 + n;
        v4u o; o.x = pk2(s[0 * 36], s[1 * 36]); o.y = pk2(s[2 * 36], s[3 * 36]); o.z = pk2(s[4 * 36], s[5 * 36]); o.w = pk2(s[6 * 36], s[7 * 36]);
        int dn = j.n0 + n; if (j.mode == 1) { const int sidx = dn & 255; dn = (dn & ~255) + ((sidx >> 5) & 1) * 128 + (sidx >> 6) * 32 + (sidx & 31); }
        else if (j.mode == 2) { const int part = dn >= 2816 ? 1 : 0, c = dn - part * 2816; dn = (c >> 7) * 256 + part * 128 + (c & 127); }
        *(v4u*)(j.dst + (size_t)dn * j.K + j.k0 + 8 * c) = o; }
    LDS_WAIT();
}
__device__ __forceinline__ TrJob p0_job(Frame& F, int it) {
    constexpr int I_IN = 16 * 161, I_OUT = 32 * 32, I_UP = 16 * 176, I_DN = 44 * 32, I_KV = 16 * 96, I_Q = 16 * 96, I_O = 16 * 32;
    int r = it;
    if (r < 2 * I_IN) { const int L = r / I_IN; return tr_job(F.in[I_WIN] + (size_t)L * 1024 * 5152, 5152, 0, 1024, 5152, WSP(bf16, WS_WIN) + (size_t)L * INPAD * 1024, 0, r % I_IN); } r -= 2 * I_IN;
    if (r < 2 * I_OUT) { const int L = r / I_OUT; return tr_job(F.in[I_WOUT] + (size_t)L * 2048 * 1024, 1024, 0, 2048, 1024, WSP(bf16, WS_WOUT) + (size_t)L * 1024 * 2048, 0, r % I_OUT); } r -= 2 * I_OUT;
    if (r < 4 * I_UP) { const int L = r / I_UP; return tr_job(F.in[I_WUP] + (size_t)L * 1024 * FF2, FF2, 0, 1024, FF2, WSP(bf16, WS_WUP) + (size_t)L * FF2 * 1024, 2, r % I_UP); } r -= 4 * I_UP;
    if (r < 4 * I_DN) { const int L = r / I_DN; return tr_job(F.in[I_WDN] + (size_t)L * FF * 1024, 1024, 0, FF, 1024, WSP(bf16, WS_WDN) + (size_t)L * 1024 * FF, 0, r % I_DN); } r -= 4 * I_DN;
    if (r < 2 * I_KV) { const int hv = r / I_KV; return tr_job(F.in[I_WKV], 6144, hv * 3072, 1024, 3072, WSP(bf16, WS_WKV) + (size_t)hv * 3072 * 1024, hv == 0 ? 1 : 0, r % I_KV); } r -= 2 * I_KV;
    if (r < 2 * I_Q) { const int L = r / I_Q; return tr_job(F.in[I_WQ] + (size_t)L * 1024 * AW, AW, 0, 1024, AW, WSP(bf16, WS_WQ) + (size_t)L * AW * 1024, 1, r % I_Q); } r -= 2 * I_Q;
    { const int L = r / I_O; return tr_job(F.in[I_WO] + (size_t)L * 1024 * 1024, 1024, 0, 1024, 1024, WSP(bf16, WS_WO) + (size_t)L * 1024 * 1024, 0, r % I_O); }
}
__device__ __forceinline__ void p0_weights(Frame& F) {
    LAS float* scr = (LAS float*)(F.lds + RING_OFF + F.wave * 16384);
    const int gw = F.vcu * NWAVES + F.wave, NGW = F.G * NWAVES, lane = F.lane;
    constexpr int NITEMS = 2 * 16 * 161 + 2 * 32 * 32 + 4 * 16 * 176 + 4 * 44 * 32 + 2 * 16 * 96 + 2 * 16 * 96 + 2 * 16 * 32;
    f32x4 bA[8], bB[8]; TrJob jA, jB;
    int it = gw;
    if (it < NITEMS) { jA = p0_job(F, it); tr_load(jA, bA, lane); }
#pragma unroll 1
    for (; it < NITEMS; it += 2 * NGW) {
        const bool hasB = it + NGW < NITEMS, hasA2 = it + 2 * NGW < NITEMS;
        if (hasB) { jB = p0_job(F, it + NGW); tr_load(jB, bB, lane); }
        tr_store(jA, bA, scr, lane);
        if (hasA2) { jA = p0_job(F, it + 2 * NGW); tr_load(jA, bA, lane); }
        if (hasB) tr_store(jB, bB, scr, lane);
    }
    const int gt = F.vcu * (NWAVES * 64) + F.tid, NGT = F.G * NWAVES * 64;
    for (int i = gt; i < 2 * 224 * 128; i += NGT) { const int L = i / (224 * 128), j = i % (224 * 128);
        *(v4u*)(WSP(bf16, WS_WIN) + (size_t)L * INPAD * 1024 + (size_t)5152 * 1024 + (size_t)j * 8) = (v4u){0u, 0u, 0u, 0u}; }
    for (int i = gt; i < 8200 * 32; i += NGT) { const int pos = i >> 5, k = i & 31;
        const float inv = (float)exp(-(double)k * (9.210340371976184 / 32.0)); const float ang = (float)pos * inv;
        float s, c; sincosf(ang, &s, &c); *(f32x2*)(WSP(float, WS_ROPE) + (size_t)i * 2) = (f32x2){c, s}; }
}
__device__ __forceinline__ void p0_adaln(Frame& F) {
    LAS float* cs = (LAS float*)(F.lds + RING_OFF);
    LAS float* ob = (LAS float*)(F.lds + RING_OFF + 512 * 34 * 4);
    const int tid = F.tid, cq = F.lane, kq = F.wave;
    for (int chunk = blockIdx.x; chunk < 208; chunk += F.G) {
        const int l = chunk < 192 ? chunk / 48 : 4, cc = chunk < 192 ? chunk % 48 : chunk - 192;
        const float* W = l < 4 ? F.in[I_ADAW] + (size_t)l * 1024 * 6144 : F.in[I_KVAW]; const int ldw = l < 4 ? 6144 : 2048, col0 = cc * 128;
        const float* bias = l < 4 ? F.in[I_ADAB] + l * 6144 : F.in[I_KVAB];
        f32x2 acc[NSEQ];
#pragma unroll
        for (int s = 0; s < NSEQ; ++s) acc[s] = (f32x2){0.f, 0.f};
#pragma unroll 1
        for (int hf = 0; hf < 2; ++hf) {
            __syncthreads();
            int t1 = tid; asm volatile("" : "+v"(t1));
            { float cv[NSEQ];
#pragma unroll
              for (int i = 0; i < NSEQ; ++i) { const int idx = t1 + i * (NWAVES * 64), k = idx / NSEQ, s = idx % NSEQ;
                  cv[i] = s < 2 ? F.in[I_CP][s * 1024 + hf * 512 + k] : F.in[I_CS][(s - 2) * 1024 + hf * 512 + k]; }
              __builtin_amdgcn_sched_barrier(0);
#pragma unroll
              for (int i = 0; i < NSEQ; ++i) cs[t1 + i * (NWAVES * 64)] = silu(cv[i]); }
            __syncthreads();
            f32x2 wn[8];
#pragma unroll
            for (int i = 0; i < 8; ++i) wn[i] = *(const f32x2*)(W + (size_t)(hf * 512 + kq * 64 + i) * ldw + col0 + 2 * cq);
#pragma unroll 1
            for (int kk0 = 0; kk0 < 64; kk0 += 8) {
                f32x2 wv[8];
#pragma unroll
                for (int i = 0; i < 8; ++i) wv[i] = wn[i];
                if (kk0 + 8 < 64) {
#pragma unroll
                    for (int i = 0; i < 8; ++i) wn[i] = *(const f32x2*)(W + (size_t)(hf * 512 + kq * 64 + kk0 + 8 + i) * ldw + col0 + 2 * cq); }
                __builtin_amdgcn_sched_barrier(0);
#pragma unroll
                for (int i = 0; i < 8; ++i) { const int k = kq * 64 + kk0 + i;
#pragma unroll
                    for (int s2 = 0; s2 < NSEQ / 2; ++s2) { const f32x2 a = *(const LAS f32x2*)(cs + k * NSEQ + 2 * s2); acc[2 * s2] += a.x * wv[i]; acc[2 * s2 + 1] += a.y * wv[i]; } }
                __builtin_amdgcn_sched_barrier(0); }
        }
#pragma unroll 1
        for (int w = 0; w < NWAVES; ++w) {
            if (F.wave == w) {
#pragma unroll
                for (int s = 0; s < NSEQ; ++s) { LAS f32x2* p = (LAS f32x2*)(ob + s * 128 + 2 * cq); if (w == 0) *p = acc[s]; else *p = *p + acc[s]; } }
            __syncthreads();
        }
        int t2 = tid; asm volatile("" : "+v"(t2));
        for (int idx = t2; idx < NSEQ * 128; idx += NWAVES * 64) { const int s = idx >> 7, c = idx & 127;
            WSP(float, WS_MOD)[((size_t)l * NSEQ + s) * 6144 + col0 + c] = ob[idx] + bias[col0 + c]; }
    }
    __syncthreads();
}

__device__ __forceinline__ const float* rowsrc(const float* P, const float* S, int m) { return m < MP ? P + (size_t)m * 1024 : S + (size_t)(m - MP) * 1024; }
__device__ __forceinline__ int row_seq(int m) { return m < MP ? (m >> 13) : 2 + ((m - MP) >> 3); }
__device__ __forceinline__ float load_row_rstd(const float* xrow, int lane, f32x4 (&v)[4]) {
    const f32x4* xr = (const f32x4*)xrow + lane; float s = 0.f;
#pragma unroll
    for (int j = 0; j < 4; ++j) { v[j] = xr[64 * j]; s += (v[j].x * v[j].x + v[j].y * v[j].y) + (v[j].z * v[j].z + v[j].w * v[j].w); }
    return 1.0f / sqrtf(wave_sum(s) * (1.f / 1024.f) + EPS);
}
__device__ __forceinline__ void store_mod_row(const f32x4 (&v)[4], float rstd, const float* g, const float* mrow, int sh, int sc, bf16* orow, int lane) {
    unsigned long long* o8 = (unsigned long long*)orow + lane;
    f32x4 gv[4], sv[4], hv[4];
#pragma unroll
    for (int j = 0; j < 4; ++j) { const int col = 4 * lane + 256 * j; gv[j] = *(const f32x4*)(g + col); sv[j] = *(const f32x4*)(mrow + sc + col); hv[j] = *(const f32x4*)(mrow + sh + col); }
    __builtin_amdgcn_sched_barrier(0);
#pragma unroll
    for (int j = 0; j < 4; ++j) { const f32x4 r = v[j] * rstd * gv[j] * (sv[j] + 1.0f) + hv[j];
        o8[64 * j] = (unsigned long long)pk2(r.x, r.y) | ((unsigned long long)pk2(r.z, r.w) << 32); }
}
__device__ __forceinline__ float load_row_ssq(const float* xrow, int lane, f32x4 (&v)[4]) {
    const f32x4* xr = (const f32x4*)xrow + lane; float s = 0.f;
#pragma unroll
    for (int j = 0; j < 4; ++j) { v[j] = xr[64 * j]; s += (v[j].x * v[j].x + v[j].y * v[j].y) + (v[j].z * v[j].z + v[j].w * v[j].w); }
    return s;
}
struct Pend { const float* slab; const float* gate; const float* in; float* hout; };
__device__ __forceinline__ float load_row_any(const Pend& pd, const float* P, const float* S, int m, int lane, f32x4 (&v)[4]) {
    if (pd.slab == nullptr || m < MP) return load_row_ssq(rowsrc(P, S, m), lane, v);
    const int r = m - MP; const float* gp = pd.gate + (size_t)(2 + (r >> 3)) * 6144; float s = 0.f;
    f32x4 p0[4], p1[4], p2[4], p3[4], xin[4], gt[4];
#pragma unroll
    for (int j = 0; j < 4; ++j) { const int col = 4 * lane + 256 * j; const size_t o = (size_t)r * 1024 + col;
        p0[j] = *(const f32x4*)(pd.slab + o); p1[j] = *(const f32x4*)(pd.slab + 262144 + o); p2[j] = *(const f32x4*)(pd.slab + 524288 + o); p3[j] = *(const f32x4*)(pd.slab + 786432 + o);
        xin[j] = *(const f32x4*)(pd.in + o); gt[j] = *(const f32x4*)(gp + col); }
    __builtin_amdgcn_sched_barrier(0);
#pragma unroll
    for (int j = 0; j < 4; ++j) { const int col = 4 * lane + 256 * j; const size_t o = (size_t)r * 1024 + col;
        const f32x4 p = (p0[j] + p1[j]) + (p2[j] + p3[j]);
        v[j] = xin[j] + gt[j] * p; *(f32x4*)(pd.hout + o) = v[j];
        s += (v[j].x * v[j].x + v[j].y * v[j].y) + (v[j].z * v[j].z + v[j].w * v[j].w); }
    return s;
}
struct ModV { f32x4 a[4], h[4]; };
__device__ __forceinline__ void modv_load(ModV& M, const float* g, const float* mrow, int sh, int sc, int lane) {
    f32x4 gv[4], sv[4];
#pragma unroll
    for (int j = 0; j < 4; ++j) { const int col = 4 * lane + 256 * j; gv[j] = *(const f32x4*)(g + col); sv[j] = *(const f32x4*)(mrow + sc + col); M.h[j] = *(const f32x4*)(mrow + sh + col); }
    __builtin_amdgcn_sched_barrier(0);
#pragma unroll
    for (int j = 0; j < 4; ++j) M.a[j] = gv[j] * (sv[j] + 1.0f);
}
template <bool BF> struct RowRaw;
template <> struct RowRaw<false> { f32x4 v[4];
    __device__ __forceinline__ void load(const void* base, int m, int lane) { const f32x4* xr = (const f32x4*)((const float*)base + (size_t)m * 1024) + lane;
#pragma unroll
        for (int j = 0; j < 4; ++j) v[j] = xr[64 * j]; }
    __device__ __forceinline__ void get(f32x4 (&f)[4]) const {
#pragma unroll
        for (int j = 0; j < 4; ++j) f[j] = v[j]; } };
template <> struct RowRaw<true> { v2u v[4];
    __device__ __forceinline__ void load(const void* base, int m, int lane) { const v2u* xr = (const v2u*)((const bf16*)base + (size_t)m * 1024) + lane;
#pragma unroll
        for (int j = 0; j < 4; ++j) v[j] = xr[64 * j]; }
    __device__ __forceinline__ void get(f32x4 (&f)[4]) const {
#pragma unroll
        for (int j = 0; j < 4; ++j) f[j] = (f32x4){bflo(v[j].x), bfhi(v[j].x), bflo(v[j].y), bfhi(v[j].y)}; } };
__device__ __forceinline__ float row_rstd(const f32x4 (&v)[4]) { float s = 0.f;
#pragma unroll
    for (int j = 0; j < 4; ++j) s += (v[j].x * v[j].x + v[j].y * v[j].y) + (v[j].z * v[j].z + v[j].w * v[j].w);
    return 1.0f / sqrtf(wave_sum(s) * (1.f / 1024.f) + EPS); }
__device__ __forceinline__ void store_modv_row(const f32x4 (&v)[4], float rstd, const ModV& M, bf16* orow, int lane) {
    unsigned long long* o8 = (unsigned long long*)orow + lane;
#pragma unroll
    for (int j = 0; j < 4; ++j) { const f32x4 r = v[j] * rstd * M.a[j] + M.h[j]; o8[64 * j] = (unsigned long long)pk2(r.x, r.y) | ((unsigned long long)pk2(r.z, r.w) << 32); }
}
template <int NOUT, bool BF>
__device__ __forceinline__ void norm_rows(Frame& F, const Pend pd, const void* P, const float* S, const float* g1, const float* mod1, int sh1, int sc1, bf16* out1, const float* g2, const float* mod2, int sh2, int sc2, bf16* out2) {
    const int gw = F.vcu * NWAVES + F.wave, NGW = F.G * NWAVES, lane = F.lane;
    if (NGW == 2048) {
        RowRaw<BF> va, vb;
        va.load(P, gw, lane); vb.load(P, gw + 2048, lane);
        ModV M1, M2;
#pragma unroll 1
        for (int i = 0; i < 4; ++i) {
            const int m = gw + 4096 * i;
            if ((i & 1) == 0) { modv_load(M1, g1, mod1 + (size_t)(i >> 1) * 6144, sh1, sc1, lane); if (NOUT == 2) modv_load(M2, g2, mod2 + (size_t)(i >> 1) * 6144, sh2, sc2, lane); }
            RowRaw<BF> na, nb;
            if (i < 3) { na.load(P, m + 4096, lane); nb.load(P, m + 6144, lane); }
            __builtin_amdgcn_sched_barrier(0);
            f32x4 fa[4], fb[4]; va.get(fa); vb.get(fb);
            const float ra = row_rstd(fa), rb = row_rstd(fb);
            store_modv_row(fa, ra, M1, out1 + (size_t)m * 1024, lane); store_modv_row(fb, rb, M1, out1 + (size_t)(m + 2048) * 1024, lane);
            if (NOUT == 2) { store_modv_row(fa, ra, M2, out2 + (size_t)m * 1024, lane); store_modv_row(fb, rb, M2, out2 + (size_t)(m + 2048) * 1024, lane); }
            __builtin_amdgcn_sched_barrier(0);
            if (i < 3) { va = na; vb = nb; }
        }
        if (F.wave == 0) { const int m = MP + F.vcu; f32x4 v[4]; const float rs = 1.0f / sqrtf(wave_sum(load_row_any(pd, S, S, m, lane, v)) * (1.f / 1024.f) + EPS); const int seq = row_seq(m);
            store_mod_row(v, rs, g1, mod1 + (size_t)seq * 6144, sh1, sc1, out1 + (size_t)m * 1024, lane);
            if (NOUT == 2) store_mod_row(v, rs, g2, mod2 + (size_t)seq * 6144, sh2, sc2, out2 + (size_t)m * 1024, lane); }
        return;
    }
    for (int m = gw; m < MT; m += NGW) { f32x4 v[4]; float rs;
        if (m < MP) { RowRaw<BF> r; r.load(P, m, lane); r.get(v); rs = row_rstd(v); }
        else rs = 1.0f / sqrtf(wave_sum(load_row_any(pd, S, S, m, lane, v)) * (1.f / 1024.f) + EPS);
        const int seq = row_seq(m);
        store_mod_row(v, rs, g1, mod1 + (size_t)seq * 6144, sh1, sc1, out1 + (size_t)m * 1024, lane);
        if (NOUT == 2) store_mod_row(v, rs, g2, mod2 + (size_t)seq * 6144, sh2, sc2, out2 + (size_t)m * 1024, lane); }
}
__device__ __forceinline__ void final_norm_phase(Frame& F, const Pend pd, const bf16* HB, const float* HSr, const float* g, float* out) {
    const int gw = F.vcu * NWAVES + F.wave, NGW = F.G * NWAVES, lane = F.lane;
    f32x4 gv[4];
#pragma unroll
    for (int j = 0; j < 4; ++j) gv[j] = *(const f32x4*)(g + 4 * lane + 256 * j);
    if (NGW == 2048) {
        RowRaw<true> va, vb;
        va.load(HB, gw, lane); vb.load(HB, gw + 2048, lane);
#pragma unroll 1
        for (int i = 0; i < 4; ++i) {
            const int m = gw + 4096 * i;
            RowRaw<true> na, nb;
            if (i < 3) { na.load(HB, m + 4096, lane); nb.load(HB, m + 6144, lane); }
            __builtin_amdgcn_sched_barrier(0);
            f32x4 fa[4], fb[4]; va.get(fa); vb.get(fb);
            const float ra = row_rstd(fa), rb = row_rstd(fb);
            f32x4* oa = (f32x4*)(out + (size_t)m * 1024) + lane; f32x4* ob = (f32x4*)(out + (size_t)(m + 2048) * 1024) + lane;
#pragma unroll
            for (int j = 0; j < 4; ++j) { oa[64 * j] = fa[j] * ra * gv[j]; ob[64 * j] = fb[j] * rb * gv[j]; }
            __builtin_amdgcn_sched_barrier(0);
            if (i < 3) { va = na; vb = nb; }
        }
        if (F.wave == 0) { const int m = MP + F.vcu; f32x4 v[4]; const float rstd = 1.0f / sqrtf(wave_sum(load_row_any(pd, HSr, HSr, m, lane, v)) * (1.f / 1024.f) + EPS);
            f32x4* o = (f32x4*)(out + (size_t)m * 1024) + lane;
#pragma unroll
            for (int j = 0; j < 4; ++j) o[64 * j] = v[j] * rstd * gv[j]; }
        return;
    }
    for (int m = gw; m < MT; m += NGW) { f32x4 v[4]; float rstd;
        if (m < MP) { RowRaw<true> r; r.load(HB, m, lane); r.get(v); rstd = row_rstd(v); }
        else rstd = 1.0f / sqrtf(wave_sum(load_row_any(pd, HSr, HSr, m, lane, v)) * (1.f / 1024.f) + EPS);
        f32x4* o = (f32x4*)(out + (size_t)m * 1024) + lane;
#pragma unroll
        for (int j = 0; j < 4; ++j) o[64 * j] = v[j] * rstd * gv[j]; }
}


__device__ __forceinline__ void unpack4(const v2u w, float (&x)[4]) { x[0] = bflo(w.x); x[1] = bfhi(w.x); x[2] = bflo(w.y); x[3] = bfhi(w.y); }
struct CvIn { v2u x[11]; f32x4 st[3]; f32x4 w[4], bias; };
__device__ __forceinline__ void cvm_load(Frame& F, int L, int u, int lane, CvIn& I) {
    const bf16* Z = WSP(bf16, WS_BIG); const float* st = F.in[I_CONV] + (size_t)L * 32 * 3 * 3072;
    const int rb = u / 48, cgp = u % 48, ch0 = cgp * 64 + 4 * (lane & 15), seg = lane >> 4, row0 = rb * 32 + seg * 8; const bool sample = rb >= 512;
#pragma unroll
    for (int r = 3; r < 11; ++r) I.x[r] = *(const v2u*)(Z + (size_t)(row0 + r - 3) * 5120 + 2048 + ch0);
    { const float* cw = F.in[I_CW] + (size_t)L * 4 * 3072; const float* cb = F.in[I_CB] + (size_t)L * 3072;
#pragma unroll
      for (int k = 0; k < 4; ++k) I.w[k] = *(const f32x4*)(cw + k * 3072 + ch0);
      I.bias = *(const f32x4*)(cb + ch0); }
    if (sample) { const int b = (row0 - MP) >> 3;
#pragma unroll
        for (int r = 0; r < 3; ++r) I.st[r] = *(const f32x4*)(st + ((size_t)b * 3 + r) * 3072 + ch0); }
    else if ((row0 & 8191) != 0) {
#pragma unroll
        for (int r = 0; r < 3; ++r) I.x[r] = *(const v2u*)(Z + (size_t)(row0 + r - 3) * 5120 + 2048 + ch0); }
    else {
#pragma unroll
        for (int r = 0; r < 3; ++r) I.x[r] = (v2u){0u, 0u}; }
}
__device__ __forceinline__ void cvm_compute(Frame& F, int L, int u, int lane, const CvIn& I) {
    bf16* A = WSP(bf16, WS_ACT); bf16* CT = WSP(bf16, WS_CT);
    const float* cw = F.in[I_CW] + (size_t)L * 4 * 3072; const float* cb = F.in[I_CB] + (size_t)L * 3072;
    float* convP = F.out + O_CONVP + (size_t)L * 2 * 3 * 3072; float* convS = F.out + O_CONVS + (size_t)L * 32 * 3 * 3072;
    const int rb = u / 48, cgp = u % 48, ch0 = cgp * 64 + 4 * (lane & 15), seg = lane >> 4, row0 = rb * 32 + seg * 8; const bool sample = rb >= 512;
    float xw[11][4];
#pragma unroll
    for (int r = 3; r < 11; ++r) unpack4(I.x[r], xw[r]);
    if (sample) {
#pragma unroll
        for (int r = 0; r < 3; ++r) { xw[r][0] = I.st[r].x; xw[r][1] = I.st[r].y; xw[r][2] = I.st[r].z; xw[r][3] = I.st[r].w; } }
    else {
#pragma unroll
        for (int r = 0; r < 3; ++r) unpack4(I.x[r], xw[r]); }
    f32x4 w[4];
#pragma unroll
    for (int k = 0; k < 4; ++k) w[k] = I.w[k];
    const f32x4 bias = I.bias;
    float o[8][4];
#pragma unroll
    for (int tt = 0; tt < 8; ++tt)
#pragma unroll
        for (int c = 0; c < 4; ++c) o[tt][c] = silu(bias[c] + w[0][c] * xw[tt][c] + w[1][c] * xw[tt + 1][c] + w[2][c] * xw[tt + 2][c] + w[3][c] * xw[tt + 3][c]);
    if (sample || cgp >= 32) {
#pragma unroll
        for (int tt = 0; tt < 8; ++tt) *(v2u*)(A + (size_t)(row0 + tt) * 3072 + ch0) = (v2u){pk2(o[tt][0], o[tt][1]), pk2(o[tt][2], o[tt][3])}; }
    if (!sample && cgp < 40) { const int b = row0 >> 13, t0 = row0 & 8191;
#pragma unroll
        for (int c = 0; c < 4; ++c) *(v4u*)(CT + (size_t)(b * 2560 + ch0 + c) * 8192 + t0) = (v4u){pk2(o[0][c], o[1][c]), pk2(o[2][c], o[3][c]), pk2(o[4][c], o[5][c]), pk2(o[6][c], o[7][c])}; }
    if (sample) { const int b = (row0 - MP) >> 3;
#pragma unroll
        for (int j = 0; j < 3; ++j) *(f32x4*)(convS + ((size_t)b * 3 + j) * 3072 + ch0) = (f32x4){xw[8 + j][0], xw[8 + j][1], xw[8 + j][2], xw[8 + j][3]}; }
    else if ((row0 & 8191) == 8184) { const int b = row0 >> 13;
#pragma unroll
        for (int j = 0; j < 3; ++j) *(f32x4*)(convP + ((size_t)b * 3 + j) * 3072 + ch0) = (f32x4){xw[8 + j][0], xw[8 + j][1], xw[8 + j][2], xw[8 + j][3]}; }
}
__device__ __forceinline__ void conv_mamba_phase(Frame& F, int L) {
    const int gw = F.vcu * NWAVES + F.wave, NGW = F.G * NWAVES, lane = F.lane; constexpr int NU = 520 * 48;
    CvIn A, B; int u = gw;
    if (u < NU) cvm_load(F, L, u, lane, A);
#pragma unroll 1
    for (; u < NU; u += 2 * NGW) {
        const bool hasB = u + NGW < NU, hasA2 = u + 2 * NGW < NU;
        if (hasB) cvm_load(F, L, u + NGW, lane, B);
        cvm_compute(F, L, u, lane, A);
        if (hasA2) cvm_load(F, L, u + 2 * NGW, lane, A);
        if (hasB) cvm_compute(F, L, u + NGW, lane, B);
    }
}
struct FfIn { v2u x[2][10]; f32x4 st[2][2]; };
__device__ __forceinline__ void cvf_load(Frame& F, int L, int u, int lane, FfIn& I) {
    const bf16* U = WSP(bf16, WS_BIG); const float* st = F.in[I_FFNC] + (size_t)L * 32 * 2 * FF2;
    const int rb = u / 44, cgp = u % 44, ch0 = cgp * 64 + 4 * (lane & 15), seg = lane >> 4, row0 = rb * 32 + seg * 8; const bool sample = rb >= 512;
#pragma unroll
    for (int part = 0; part < 2; ++part) { const int ch = ch0 + part * FF;
#pragma unroll
        for (int r = 2; r < 10; ++r) I.x[part][r] = *(const v2u*)(U + (size_t)(row0 + r - 2) * FF2 + ch);
        if (sample) { const int b = (row0 - MP) >> 3;
#pragma unroll
            for (int r = 0; r < 2; ++r) I.st[part][r] = *(const f32x4*)(st + ((size_t)b * 2 + r) * FF2 + ch); }
        else if ((row0 & 8191) != 0) {
#pragma unroll
            for (int r = 0; r < 2; ++r) I.x[part][r] = *(const v2u*)(U + (size_t)(row0 + r - 2) * FF2 + ch); }
        else {
#pragma unroll
            for (int r = 0; r < 2; ++r) I.x[part][r] = (v2u){0u, 0u}; } }
}
__device__ __forceinline__ void cvf_compute(Frame& F, int L, int u, int lane, const FfIn& I) {
    bf16* Gh = WSP(bf16, WS_ACT);
    const float* fw = F.in[I_FCW] + (size_t)L * 3 * FF2; const float* fb = F.in[I_FCB] + (size_t)L * FF2;
    float* ffnP = F.out + O_FFNP + (size_t)L * 2 * 2 * FF2; float* ffnS = F.out + O_FFNS + (size_t)L * 32 * 2 * FF2;
    const int rb = u / 44, cgp = u % 44, ch0 = cgp * 64 + 4 * (lane & 15), seg = lane >> 4, row0 = rb * 32 + seg * 8; const bool sample = rb >= 512;
    float og[8][4];
#pragma unroll
    for (int part = 0; part < 2; ++part) {
        const int ch = ch0 + part * FF;
        float xw[10][4];
#pragma unroll
        for (int r = 2; r < 10; ++r) unpack4(I.x[part][r], xw[r]);
        if (sample) {
#pragma unroll
            for (int r = 0; r < 2; ++r) { xw[r][0] = I.st[part][r].x; xw[r][1] = I.st[part][r].y; xw[r][2] = I.st[part][r].z; xw[r][3] = I.st[part][r].w; } }
        else {
#pragma unroll
            for (int r = 0; r < 2; ++r) unpack4(I.x[part][r], xw[r]); }
        f32x4 w[3];
#pragma unroll
        for (int k = 0; k < 3; ++k) w[k] = *(const f32x4*)(fw + k * FF2 + ch);
        const f32x4 bias = *(const f32x4*)(fb + ch);
#pragma unroll
        for (int tt = 0; tt < 8; ++tt)
#pragma unroll
            for (int c = 0; c < 4; ++c) { const float a = bias[c] + w[0][c] * xw[tt][c] + w[1][c] * xw[tt + 1][c] + w[2][c] * xw[tt + 2][c];
                if (part == 0) og[tt][c] = silu(a); else og[tt][c] *= a; }
        if (sample) { const int b = (row0 - MP) >> 3;
#pragma unroll
            for (int j = 0; j < 2; ++j) *(f32x4*)(ffnS + ((size_t)b * 2 + j) * FF2 + ch) = (f32x4){xw[8 + j][0], xw[8 + j][1], xw[8 + j][2], xw[8 + j][3]}; }
        else if ((row0 & 8191) == 8184) { const int b = row0 >> 13;
#pragma unroll
            for (int j = 0; j < 2; ++j) *(f32x4*)(ffnP + ((size_t)b * 2 + j) * FF2 + ch) = (f32x4){xw[8 + j][0], xw[8 + j][1], xw[8 + j][2], xw[8 + j][3]}; }
    }
#pragma unroll
    for (int tt = 0; tt < 8; ++tt) *(v2u*)(Gh + (size_t)(row0 + tt) * FF + ch0) = (v2u){pk2(og[tt][0], og[tt][1]), pk2(og[tt][2], og[tt][3])};
}
__device__ __forceinline__ void conv_ffn_phase(Frame& F, int L) {
    const int gw = F.vcu * NWAVES + F.wave, NGW = F.G * NWAVES, lane = F.lane; constexpr int NU = 520 * 44;
    FfIn A, B; int u = gw;
    if (u < NU) cvf_load(F, L, u, lane, A);
#pragma unroll 1
    for (; u < NU; u += 2 * NGW) {
        const bool hasB = u + NGW < NU, hasA2 = u + 2 * NGW < NU;
        if (hasB) cvf_load(F, L, u + NGW, lane, B);
        cvf_compute(F, L, u, lane, A);
        if (hasA2) cvf_load(F, L, u + 2 * NGW, lane, A);
        if (hasB) cvf_compute(F, L, u + NGW, lane, B);
    }
}

struct FxIn { f32x4 u0[2], u1[2], u2[2], b[2], w0[2], w1[2], w2[2]; };
__device__ __forceinline__ void fx_load(FxIn& I, const float* UB, const float* fw, const float* fb, int pm, int i) {
    const int ri = i / 704, cq = i % 704, ch = 4 * cq, k = ri & 1, row = pm * 256 + (ri >> 1) * 64 + k, blk = row >> 6, t = row & 8191;
#pragma unroll
    for (int pt = 0; pt < 2; ++pt) { const int c = pt * 2816 + ch; const f32x4 z4 = (f32x4){0.f, 0.f, 0.f, 0.f};
        I.u0[pt] = *(const f32x4*)(UB + ((size_t)blk * 4 + k) * 5632 + c);
        I.u1[pt] = k == 1 ? *(const f32x4*)(UB + ((size_t)blk * 4 + 0) * 5632 + c) : (t >= 1 ? *(const f32x4*)(UB + ((size_t)(blk - 1) * 4 + 3) * 5632 + c) : z4);
        I.u2[pt] = t >= 2 ? *(const f32x4*)(UB + ((size_t)(blk - 1) * 4 + (k == 1 ? 3 : 2)) * 5632 + c) : z4;
        I.b[pt] = *(const f32x4*)(fb + c); I.w0[pt] = *(const f32x4*)(fw + c); I.w1[pt] = *(const f32x4*)(fw + 5632 + c); I.w2[pt] = *(const f32x4*)(fw + 2 * 5632 + c); }
}
__device__ __forceinline__ void fx_store(const FxIn& I, bf16* Gh, int pm, int i) {
    const int ri = i / 704, cq = i % 704, ch = 4 * cq, k = ri & 1, row = pm * 256 + (ri >> 1) * 64 + k;
    f32x4 a[2];
#pragma unroll
    for (int pt = 0; pt < 2; ++pt) a[pt] = I.b[pt] + I.w0[pt] * I.u2[pt] + I.w1[pt] * I.u1[pt] + I.w2[pt] * I.u0[pt];
    *(v2u*)(Gh + (size_t)row * FF + ch) = (v2u){pk2(silu(a[0][0]) * a[1][0], silu(a[0][1]) * a[1][1]), pk2(silu(a[0][2]) * a[1][2], silu(a[0][3]) * a[1][3])};
}
__device__ __forceinline__ void ffn_fixup(Frame& F, int L, int pm) {
    const float* UB = WSP(float, WS_UB); bf16* Gh = WSP(bf16, WS_ACT);
    const float* fw = F.in[I_FCW] + (size_t)L * 3 * FF2; const float* fb = F.in[I_FCB] + (size_t)L * FF2;
    int i = F.tid;
#pragma unroll 1
    for (; i + NWAVES * 64 < 8 * 704; i += 2 * NWAVES * 64) { FxIn A, B; fx_load(A, UB, fw, fb, pm, i); fx_load(B, UB, fw, fb, pm, i + NWAVES * 64);
        __builtin_amdgcn_sched_barrier(0);
        fx_store(A, Gh, pm, i); fx_store(B, Gh, pm, i + NWAVES * 64);
        __builtin_amdgcn_sched_barrier(0); }
    if (i < 8 * 704) { FxIn A; fx_load(A, UB, fw, fb, pm, i); fx_store(A, Gh, pm, i); }
    VM_WAIT(); __syncthreads();
}

#define MFMA16(a, b, c) __builtin_amdgcn_mfma_f32_16x16x32_bf16((a), (b), (c), 0, 0, 0)
__device__ __forceinline__ void ssd_s1_phase(Frame& F, int L) {
    const float* dtraw = WSP(float, WS_DTRAW); float* dtv = WSP(float, WS_DTV); float* acum = WSP(float, WS_ACUM); float* decay = WSP(float, WS_DECAY);
    const bf16* CT = WSP(bf16, WS_CT); bf16* STS = WSP(bf16, WS_STATES);
    const int gw = F.vcu * NWAVES + F.wave, NGW = F.G * NWAVES, lane = F.lane, fr = lane & 15, fq = lane >> 4;
    const bool light = F.G == 256 && (int)blockIdx.x < 128;
    const int wv = (int)blockIdx.x * NWAVES + F.wave;
    const int ufirst = F.G == 256 ? (light ? wv : 1024 + (wv - 1024) * 3) : gw, ucnt = F.G == 256 ? (light ? 1 : 3) : 0;
    for (int ui = 0, u = ufirst; F.G == 256 ? ui < ucnt : u < 4096; ++ui, u = F.G == 256 ? ufirst + ui : u + NGW) {
        const int hd = u & 31, c = (u >> 5) & 63, b = u >> 11, g = hd >> 3;
        const float Aneg = -__expf(F.in[I_ALOG][L * 32 + hd]), dtb = F.in[I_DTB][L * 32 + hd];
        const int rowc = b * 8192 + c * 128, tc = c * 128;
        const float dt0 = softplus(dtraw[(size_t)(rowc + 2 * lane) * 32 + hd] + dtb), dt1 = softplus(dtraw[(size_t)(rowc + 2 * lane + 1) * 32 + hd] + dtb);
        const float a0 = dt0 * Aneg, a1 = dt1 * Aneg;
        float incl = a0 + a1;
#pragma unroll
        for (int o = 1; o < 64; o <<= 1) { const float t = __shfl_up(incl, o); if (lane >= o) incl += t; }
        const float excl = incl - (a0 + a1), ac0 = excl + a0, ac1 = ac0 + a1, total = __shfl(incl, 63);
        dtv[(size_t)(rowc + 2 * lane) * 32 + hd] = dt0; dtv[(size_t)(rowc + 2 * lane + 1) * 32 + hd] = dt1;
        acum[(size_t)(rowc + 2 * lane) * 32 + hd] = ac0; acum[(size_t)(rowc + 2 * lane + 1) * 32 + hd] = ac1;
        if (lane == 0) decay[(b * 64 + c) * 32 + hd] = __expf(total);
        const float w0 = dt0 * __expf(total - ac0), w1 = dt1 * __expf(total - ac1);
        f32x4 acc[8][4];
#pragma unroll
        for (int nt = 0; nt < 8; ++nt)
#pragma unroll
            for (int pt = 0; pt < 4; ++pt) acc[nt][pt] = (f32x4){0.f, 0.f, 0.f, 0.f};
        const bf16* CTb = CT + (size_t)b * 2560 * 8192 + tc;
#pragma unroll 1
        for (int ks = 0; ks < 4; ++ks) {
            float wv[8];
#pragma unroll
            for (int jp = 0; jp < 4; ++jp) { const int sl = 16 * ks + 4 * fq + jp; wv[2 * jp] = __shfl(w0, sl); wv[2 * jp + 1] = __shfl(w1, sl); }
            v4u raw[4]; bf16x8 a[8];
#pragma unroll
            for (int pt = 0; pt < 4; ++pt) raw[pt] = *(const v4u*)(CTb + (size_t)(hd * 64 + 16 * pt + fr) * 8192 + 32 * ks + 8 * fq);
#pragma unroll
            for (int nt = 0; nt < 8; ++nt) a[nt] = *(const bf16x8*)(CTb + (size_t)(2048 + g * 128 + 16 * nt + fr) * 8192 + 32 * ks + 8 * fq);
            __builtin_amdgcn_sched_barrier(0);
            bf16x8 xb[4];
#pragma unroll
            for (int pt = 0; pt < 4; ++pt) {
                v4u sc; sc.x = pk2(bflo(raw[pt].x) * wv[0], bfhi(raw[pt].x) * wv[1]); sc.y = pk2(bflo(raw[pt].y) * wv[2], bfhi(raw[pt].y) * wv[3]);
                sc.z = pk2(bflo(raw[pt].z) * wv[4], bfhi(raw[pt].z) * wv[5]); sc.w = pk2(bflo(raw[pt].w) * wv[6], bfhi(raw[pt].w) * wv[7]); xb[pt] = __builtin_bit_cast(bf16x8, sc); }
#pragma unroll
            for (int nt = 0; nt < 8; ++nt)
#pragma unroll
                for (int pt = 0; pt < 4; ++pt) acc[nt][pt] = MFMA16(a[nt], xb[pt], acc[nt][pt]);
            __builtin_amdgcn_sched_barrier(0);
        }
        bf16* sp = STS + (size_t)((b * 64 + c) * 32 + hd) * 8192;
#pragma unroll
        for (int nt = 0; nt < 8; ++nt)
#pragma unroll
            for (int pt = 0; pt < 4; ++pt) *(v2u*)(sp + (16 * pt + fr) * 128 + 16 * nt + 4 * fq) = (v2u){pk2(acc[nt][pt][0], acc[nt][pt][1]), pk2(acc[nt][pt][2], acc[nt][pt][3])};
    }
}
__device__ __forceinline__ void ssd_sample_phase(Frame& F, int L) {
    const float* dtraw = WSP(float, WS_DTRAW); const bf16* ACT = WSP(bf16, WS_ACT); const bf16* Z = WSP(bf16, WS_BIG); bf16* Y = WSP(bf16, WS_Y);
    LAS float* part = (LAS float*)(F.lds + RING_OFF);
    LAS float* yb = (LAS float*)(F.lds + RING_OFF + 4096 + F.wave * 2048);
    const int lane = F.lane;
    for (int u = blockIdx.x; u < 128; u += F.G) {
        const int b = u >> 2, g = u & 3, hd = 8 * g + F.wave;
        const float Aneg = -__expf(F.in[I_ALOG][L * 32 + hd]), dtb = F.in[I_DTB][L * 32 + hd], Dh = F.in[I_D][L * 32 + hd];
        const float dt_l = softplus(dtraw[(size_t)(MP + b * 8 + (lane & 7)) * 32 + hd] + dtb);
        const float* h0 = F.in[I_SSM] + ((size_t)(L * 32 + b) * 32 + hd) * 8192;
        float* hs = F.out + O_SSMS + ((size_t)(L * 32 + b) * 32 + hd) * 8192;
#pragma unroll 1
        for (int ph = 0; ph < 2; ++ph) {
            f32x2 h[32];
#pragma unroll
            for (int i = 0; i < 32; ++i) h[i] = *(const f32x2*)(h0 + (32 * ph + i) * 128 + 2 * lane);
            const bf16* arow = ACT + (size_t)(MP + b * 8) * 3072;
            float xl_n = bf2f(arow[hd * 64 + lane]); unsigned bw_n = *(const unsigned*)(arow + 2048 + g * 128 + 2 * lane), cw_n = *(const unsigned*)(arow + 2560 + g * 128 + 2 * lane);
#pragma unroll 1
            for (int t = 0; t < 8; ++t) {
                const float dt = __shfl(dt_l, t), dA = __expf(dt * Aneg);
                const float xl = xl_n; const unsigned bw = bw_n, cw = cw_n;
                if (t < 7) { const bf16* nrow = arow + (size_t)(t + 1) * 3072;
                    xl_n = bf2f(nrow[hd * 64 + lane]); bw_n = *(const unsigned*)(nrow + 2048 + g * 128 + 2 * lane); cw_n = *(const unsigned*)(nrow + 2560 + g * 128 + 2 * lane); }
                const float B0 = bflo(bw), B1 = bfhi(bw), C0 = bflo(cw), C1 = bfhi(cw);
                float yp[32];
#pragma unroll
                for (int i = 0; i < 32; ++i) { const float coef = dt * __shfl(xl, 32 * ph + i);
                    h[i].x = h[i].x * dA + coef * B0; h[i].y = h[i].y * dA + coef * B1; yp[i] = h[i].x * C0 + h[i].y * C1; }
                float y = TR<32>::run(yp, lane); y += __shfl_xor(y, 32);
                if (lane < 32) yb[t * 64 + 32 * ph + lane] = y;
            }
#pragma unroll
            for (int i = 0; i < 32; ++i) *(f32x2*)(hs + (32 * ph + i) * 128 + 2 * lane) = h[i];
        }
        LDS_WAIT();
        { float xs[8], zs[8];
#pragma unroll
          for (int t = 0; t < 8; ++t) { const size_t row = (size_t)(MP + b * 8 + t); xs[t] = bf2f(ACT[row * 3072 + hd * 64 + lane]); zs[t] = bf2f(Z[row * 5120 + hd * 64 + lane]); }
#pragma unroll
          for (int t = 0; t < 8; ++t) { const float y = yb[t * 64 + lane] + Dh * xs[t], yg = y * silu(zs[t]);
            yb[t * 64 + lane] = yg;
            const float ss = wave_sum(yg * yg); if (lane == 0) part[F.wave * 8 + t] = ss; } }
        LDS_WAIT();
        __syncthreads();
        const float nw = F.in[I_MNORM][L * 2048 + hd * 64 + lane];
#pragma unroll 1
        for (int t = 0; t < 8; ++t) { float tot = 0.f;
#pragma unroll
            for (int w = 0; w < 8; ++w) tot += part[w * 8 + t];
            const float rstd = 1.0f / sqrtf(tot * (1.f / 512.f) + EPS);
            Y[(size_t)(MP + b * 8 + t) * 2048 + hd * 64 + lane] = (bf16)f2bf(yb[t * 64 + lane] * rstd * nw); }
        LDS_WAIT();
        __syncthreads();
    }
}
__device__ __forceinline__ void ssd_s2_phase(Frame& F, int L) {
    const bf16* STS = WSP(bf16, WS_STATES); const float* decay = WSP(float, WS_DECAY); bf16* HP = WSP(bf16, WS_HPREV);
    const int gt = F.vcu * (NWAVES * 64) + F.tid, NGT = F.G * NWAVES * 64;
    for (int gi = gt; gi < 131072; gi += NGT) {
        const int nq = gi & 31, p = (gi >> 5) & 63, hd = (gi >> 11) & 31, b = gi >> 16;
        const size_t base = ((size_t)(b * 64) * 32 + hd) * 8192 + p * 128 + 4 * nq;
        f32x4 h = (f32x4){0.f, 0.f, 0.f, 0.f};
#pragma unroll 1
        for (int c0 = 0; c0 < 64; c0 += 16) {
            v2u sw[16]; float d[16];
#pragma unroll
            for (int i = 0; i < 16; ++i) { sw[i] = *(const v2u*)(STS + base + (size_t)(c0 + i) * 32 * 8192); d[i] = decay[(b * 64 + c0 + i) * 32 + hd]; }
            __builtin_amdgcn_sched_barrier(0);
#pragma unroll
            for (int i = 0; i < 16; ++i) { const f32x4 s = (f32x4){bflo(sw[i].x), bfhi(sw[i].x), bflo(sw[i].y), bfhi(sw[i].y)};
                *(v2u*)(HP + base + (size_t)(c0 + i) * 32 * 8192) = (v2u){pk2(h.x, h.y), pk2(h.z, h.w)}; h = h * d[i] + s; }
            __builtin_amdgcn_sched_barrier(0);
        }
        *(f32x4*)(F.out + O_SSMP + ((size_t)(L * 2 + b) * 32 + hd) * 8192 + p * 128 + 4 * nq) = h;
    }
}
__device__ __forceinline__ void ssd_s3_phase(Frame& F, int L) {
    const float* dtv = WSP(float, WS_DTV); const float* acum = WSP(float, WS_ACUM); const bf16* ACT = WSP(bf16, WS_ACT); const bf16* Z = WSP(bf16, WS_BIG);
    const bf16* CT = WSP(bf16, WS_CT); const bf16* HP = WSP(bf16, WS_HPREV); bf16* Y = WSP(bf16, WS_Y);
    LAS unsigned char* tB = F.lds + RING_OFF; LAS unsigned char* tC = tB + 32768;
    LAS float* sA = (LAS float*)(F.lds + RING_OFF + 65536 + F.wave * 1024); LAS float* sD = sA + 128;
    LAS float* part = (LAS float*)(F.lds + RING_OFF + 65536 + 8192);
    LAS unsigned char* zs = F.lds + RING_OFF + 77824 + F.wave * 8192;
    const int lane = F.lane, fr = lane & 15, fq = lane >> 4, tid = F.tid;
    const int srow = lane >> 2, sk = lane & 3;
    for (int u = blockIdx.x; u < 512; u += F.G) {
        const int g = u & 3, c = (u >> 2) & 63, b = u >> 8, hd = 8 * g + F.wave;
        const int rowc = b * 8192 + c * 128;
#pragma unroll
        for (int jj = 0; jj < 4; ++jj) { const int ci = tid + 512 * jj, row = ci >> 4, ch = ci & 15; const bf16* src = ACT + (size_t)(rowc + row) * 3072 + 2048 + g * 128 + 8 * ch;
            const v4u vb = *(const v4u*)src, vc = *(const v4u*)(src + 512); const int off = row * 256 + ((ch ^ (row & 15)) << 4);
            *(LAS v4u*)(tB + off) = vb; *(LAS v4u*)(tC + off) = vc; }
        *(LAS f32x2*)(sA + 2 * lane) = (f32x2){acum[(size_t)(rowc + 2 * lane) * 32 + hd], acum[(size_t)(rowc + 2 * lane + 1) * 32 + hd]};
        *(LAS f32x2*)(sD + 2 * lane) = (f32x2){dtv[(size_t)(rowc + 2 * lane) * 32 + hd], dtv[(size_t)(rowc + 2 * lane + 1) * 32 + hd]};
        LDS_WAIT(); __syncthreads();
        const float Dh = F.in[I_D][L * 32 + hd];
        const bf16* hb = HP + (size_t)((b * 64 + c) * 32 + hd) * 8192;
        const bf16* CTx = CT + (size_t)(b * 2560 + hd * 64) * 8192 + c * 128;
#pragma unroll 1
        for (int half = 0; half < 2; ++half) {
            bf16x8 hp[2][4], xf[4][2];
#pragma unroll
            for (int pt = 0; pt < 2; ++pt) {
#pragma unroll
                for (int ks = 0; ks < 4; ++ks) { if (F.pflags & 16) hp[pt][ks] = (bf16x8){0, 0, 0, 0, 0, 0, 0, 0}; else hp[pt][ks] = *(const bf16x8*)(hb + (32 * half + 16 * pt + fr) * 128 + 32 * ks + 8 * fq); }
#pragma unroll
                for (int k2 = 0; k2 < 4; ++k2) { const bf16* xp = CTx + (size_t)(32 * half + 16 * pt + fr) * 8192 + 32 * k2 + 4 * fq;
                    if (F.pflags & 8) xf[k2][pt] = (bf16x8){0, 0, 0, 0, 0, 0, 0, 0}; else {
                    const v2u lo = *(const v2u*)xp, hi = *(const v2u*)(xp + 16); xf[k2][pt] = __builtin_bit_cast(bf16x8, ((v4u){lo.x, lo.y, hi.x, hi.y})); } } }
            { v4u zz[8];
#pragma unroll
              for (int i = 0; i < 8; ++i) zz[i] = *(const v4u*)(Z + (size_t)(rowc + 16 * i + srow) * 5120 + hd * 64 + 32 * half + 8 * sk);
              __builtin_amdgcn_sched_barrier(0);
#pragma unroll
              for (int i = 0; i < 8; ++i) { const int row = 16 * i + srow; *(LAS v4u*)(zs + row * 64 + ((sk ^ ((row >> 1) & 3)) << 4)) = zz[i]; } }
            LDS_WAIT();
#pragma unroll 1
            for (int j = 0; j < ((F.pflags & 4) ? 0 : 8); ++j) {
                const int l = 16 * j + fr;
                const float al = sA[l];
                bf16x8 cf[4];
#pragma unroll
                for (int ks = 0; ks < 4; ++ks) cf[ks] = *(const LAS bf16x8*)(tC + l * 256 + (((4 * ks + fq) ^ (l & 15)) << 4));
                f32x4 ya[2], yo[2];
#pragma unroll
                for (int pt = 0; pt < 2; ++pt) { ya[pt] = (f32x4){0.f, 0.f, 0.f, 0.f}; yo[pt] = (f32x4){0.f, 0.f, 0.f, 0.f}; }
#pragma unroll
                for (int pt = 0; pt < 2; ++pt)
#pragma unroll
                    for (int ks = 0; ks < 4; ++ks) yo[pt] = MFMA16(hp[pt][ks], cf[ks], yo[pt]);
#pragma unroll
                for (int ks2 = 0; ks2 < 4; ++ks2) if (ks2 <= (j >> 1) && !(F.pflags & 1)) {
                    const int i0 = 2 * ks2, i1 = i0 + 1; const bool has1 = i1 <= j;
                    const int r0 = 16 * i0 + fr, r1 = 16 * i1 + fr;
                    f32x4 g0 = (f32x4){0.f, 0.f, 0.f, 0.f}, g1 = (f32x4){0.f, 0.f, 0.f, 0.f};
#pragma unroll
                    for (int ks = 0; ks < 4; ++ks) { const bf16x8 bf0 = *(const LAS bf16x8*)(tB + r0 * 256 + (((4 * ks + fq) ^ (r0 & 15)) << 4)); g0 = MFMA16(bf0, cf[ks], g0); }
                    if (has1) {
#pragma unroll
                        for (int ks = 0; ks < 4; ++ks) { const bf16x8 bf1 = *(const LAS bf16x8*)(tB + r1 * 256 + (((4 * ks + fq) ^ (r1 & 15)) << 4)); g1 = MFMA16(bf1, cf[ks], g1); } }
                    const f32x4 sa0 = *(const LAS f32x4*)(sA + 16 * i0 + 4 * fq), sd0 = *(const LAS f32x4*)(sD + 16 * i0 + 4 * fq);
                    const f32x4 sa1 = *(const LAS f32x4*)(sA + 16 * i1 + 4 * fq), sd1 = *(const LAS f32x4*)(sD + 16 * i1 + 4 * fq);
                    float m0[4], m1[4];
#pragma unroll
                    for (int r = 0; r < 4; ++r) { const int s0 = 16 * i0 + 4 * fq + r, s1 = 16 * i1 + 4 * fq + r;
                        m0[r] = (s0 <= l) ? g0[r] * __expf(al - sa0[r]) * sd0[r] : 0.f;
                        m1[r] = (has1 && s1 <= l) ? g1[r] * __expf(al - sa1[r]) * sd1[r] : 0.f;
                        if (s0 == l) m0[r] += Dh;
                        if (has1 && s1 == l) m1[r] += Dh; }
                    v4u mp; mp.x = pk2(m0[0], m0[1]); mp.y = pk2(m0[2], m0[3]); mp.z = pk2(m1[0], m1[1]); mp.w = pk2(m1[2], m1[3]);
                    const bf16x8 mf = __builtin_bit_cast(bf16x8, mp);
#pragma unroll
                    for (int pt = 0; pt < 2; ++pt) ya[pt] = MFMA16(xf[ks2][pt], mf, ya[pt]);
                }
                const float el = __expf(al);
                float ssq = 0.f;
#pragma unroll
                for (int pt = 0; pt < 2; ++pt) {
                    LAS v2u* zp = (LAS v2u*)(zs + l * 64 + (((2 * pt + (fq >> 1)) ^ ((l >> 1) & 3)) << 4) + 8 * (fq & 1));
                    float zv[4]; unpack4(*zp, zv);
                    float yg[4];
#pragma unroll
                    for (int r = 0; r < 4; ++r) { const float y = ya[pt][r] + el * yo[pt][r]; yg[r] = y * silu(zv[r]); ssq += yg[r] * yg[r]; }
                    *zp = (v2u){pk2(yg[0], yg[1]), pk2(yg[2], yg[3])}; }
                ssq += __shfl_xor(ssq, 16); ssq += __shfl_xor(ssq, 32);
                if (fq == 0) { if (half == 0) part[F.wave * 128 + l] = ssq; else part[F.wave * 128 + l] += ssq; }
            }
            LDS_WAIT();
            { v4u yy[8];
#pragma unroll
              for (int i = 0; i < 8; ++i) { const int row = 16 * i + srow; yy[i] = *(const LAS v4u*)(zs + row * 64 + ((sk ^ ((row >> 1) & 3)) << 4)); }
#pragma unroll
              for (int i = 0; i < 8; ++i) *(v4u*)(Y + (size_t)(rowc + 16 * i + srow) * 2048 + hd * 64 + 32 * half + 8 * sk) = yy[i]; }
        }
        VM_WAIT(); LDS_WAIT();
        __syncthreads();
        if (!(F.pflags & 2)) {
        v4u yy[2][8]; f32x4 nw[2][2];
#pragma unroll
        for (int half = 0; half < 2; ++half) {
#pragma unroll
            for (int i = 0; i < 8; ++i) yy[half][i] = *(const v4u*)(Y + (size_t)(rowc + 16 * i + srow) * 2048 + hd * 64 + 32 * half + 8 * sk);
#pragma unroll
            for (int q = 0; q < 2; ++q) nw[half][q] = *(const f32x4*)(F.in[I_MNORM] + L * 2048 + hd * 64 + 32 * half + 8 * sk + 4 * q); }
        __builtin_amdgcn_sched_barrier(0);
#pragma unroll
        for (int i = 0; i < 8; ++i) {
            const int l = 16 * i + srow;
            float tot = 0.f;
#pragma unroll
            for (int w = 0; w < 8; ++w) tot += part[w * 128 + l];
            const float rstd = 1.0f / sqrtf(tot * (1.f / 512.f) + EPS);
#pragma unroll
            for (int half = 0; half < 2; ++half) { const v4u v = yy[half][i]; const f32x4 w0 = nw[half][0] * rstd, w1 = nw[half][1] * rstd;
                *(v4u*)(Y + (size_t)(rowc + l) * 2048 + hd * 64 + 32 * half + 8 * sk) =
                    (v4u){pk2(bflo(v.x) * w0.x, bfhi(v.x) * w0.y), pk2(bflo(v.y) * w0.z, bfhi(v.y) * w0.w), pk2(bflo(v.z) * w1.x, bfhi(v.z) * w1.y), pk2(bflo(v.w) * w1.z, bfhi(v.w) * w1.w)}; }
        }
        }
        LDS_WAIT();
        __syncthreads();
    }
}


template <int NT, int KB>
__device__ __forceinline__ void sg_batch(const bf16* a0, const bf16* a1, const bf16* const (&bp)[NT], int k, f32x4 (&acc)[2][NT]) {
    bf16x8 af0[KB], af1[KB], bf[KB][NT];
#pragma unroll
    for (int i = 0; i < KB; ++i) { af0[i] = *(const bf16x8*)(a0 + k + 32 * i); af1[i] = *(const bf16x8*)(a1 + k + 32 * i);
#pragma unroll
        for (int ct = 0; ct < NT; ++ct) bf[i][ct] = *(const bf16x8*)(bp[ct] + k + 32 * i); }
    __builtin_amdgcn_sched_barrier(0);
#pragma unroll
    for (int i = 0; i < KB; ++i)
#pragma unroll
        for (int ct = 0; ct < NT; ++ct) { acc[0][ct] = MFMA16(bf[i][ct], af0[i], acc[0][ct]); acc[1][ct] = MFMA16(bf[i][ct], af1[i], acc[1][ct]); }
    __builtin_amdgcn_sched_barrier(0);
}
template <int NT, class CB, class EP>
__device__ __forceinline__ void sgemm_unit(const bf16* A, const bf16* Bt, int K, int kbeg, int kend, const CB& cb, const EP& ep, int wave, int lane) {
    const int fr = lane & 15, fq = lane >> 4;
    f32x4 acc[2][NT];
#pragma unroll
    for (int rt = 0; rt < 2; ++rt)
#pragma unroll
        for (int ct = 0; ct < NT; ++ct) acc[rt][ct] = (f32x4){0.f, 0.f, 0.f, 0.f};
    const bf16* a0 = A + (size_t)(32 * wave + fr) * K + 8 * fq; const bf16* a1 = a0 + (size_t)16 * K;
    const bf16* bp[NT];
#pragma unroll
    for (int ct = 0; ct < NT; ++ct) bp[ct] = Bt + (size_t)(cb(ct) + fr) * K + 8 * fq;
    constexpr int KB = NT >= 4 ? 4 : 8;
    int k = kbeg;
#pragma unroll 1
    for (; k + 32 * KB <= kend; k += 32 * KB) sg_batch<NT, KB>(a0, a1, bp, k, acc);
#pragma unroll 1
    for (; k + 64 <= kend; k += 64) sg_batch<NT, 2>(a0, a1, bp, k, acc);
    if (k < kend) sg_batch<NT, 1>(a0, a1, bp, k, acc);
    ep(acc, 32 * wave + fr, fq);
}
__device__ __forceinline__ v2u pack4(const f32x4 a) { return (v2u){pk2(a[0], a[1]), pk2(a[2], a[3])}; }
#define SAMPLE_UNITS(u, NU, skip) for (int u = (int)F.G - 1 - (skip) - (int)blockIdx.x; u >= 0 && u < (NU); u += (int)F.G)

__device__ __forceinline__ void sg_inproj(Frame& F, int L) {
    const bf16* A = WSP(bf16, WS_XN) + (size_t)MP * 1024; const bf16* Bt = WSP(bf16, WS_WIN) + (size_t)L * INPAD * 1024;
    bf16* O = WSP(bf16, WS_BIG);
    SAMPLE_UNITS(u, 160, 0) { const int c0 = 32 * u;
        sgemm_unit<2>(A, Bt, 1024, 0, 1024, [&](int ct) { return c0 + 16 * ct; },
            [&](const f32x4 (&acc)[2][2], int rl, int fq) {
#pragma unroll
                for (int rt = 0; rt < 2; ++rt)
#pragma unroll
                    for (int ct = 0; ct < 2; ++ct) *(v2u*)(O + (size_t)(MP + rl + 16 * rt) * INW + c0 + 16 * ct + 4 * fq) = pack4(acc[rt][ct]); },
            F.wave, F.lane); }
}
__device__ __forceinline__ void sg_dt(Frame& F, int L) {
    const bf16* Bt = WSP(bf16, WS_WIN) + (size_t)L * INPAD * 1024; float* dtraw = WSP(float, WS_DTRAW);
    SAMPLE_UNITS(u, 65, 160) {
        sgemm_unit<2>(WSP(bf16, WS_XN) + (size_t)u * 256 * 1024, Bt, 1024, 0, 1024, [&](int ct) { return INW + 16 * ct; },
            [&](const f32x4 (&acc)[2][2], int rl, int fq) {
#pragma unroll
                for (int rt = 0; rt < 2; ++rt)
#pragma unroll
                    for (int ct = 0; ct < 2; ++ct) *(f32x4*)(dtraw + (size_t)(u * 256 + rl + 16 * rt) * 32 + 16 * ct + 4 * fq) = acc[rt][ct]; },
            F.wave, F.lane); }
}
__device__ __forceinline__ void sg_resid(Frame& F, const bf16* A, const bf16* Bt, int K) {
    float* slab = WSP(float, WS_SLAB);
    SAMPLE_UNITS(u, 256, 0) { const int c0 = 16 * (u & 63), kq = u >> 6, kl = K / 4;
        sgemm_unit<1>(A, Bt, K, kq * kl, (kq + 1) * kl, [&](int) { return c0; },
            [&](const f32x4 (&acc)[2][1], int rl, int fq) {
#pragma unroll
                for (int rt = 0; rt < 2; ++rt) *(f32x4*)(slab + ((size_t)kq * 256 + rl + 16 * rt) * 1024 + c0 + 4 * fq) = acc[rt][0]; },
            F.wave, F.lane); }
}
__device__ __forceinline__ void sg_rope_store(const f32x4 (&acc)[2][4], int rl, int fq, int T, int h4, const float* rope, float scale, bf16* Ob, float* Of) {
    f32x4 cs[2][2][2];
#pragma unroll
    for (int rt = 0; rt < 2; ++rt) { const int pos = 8192 + ((rl + 16 * rt) & 7);
#pragma unroll
        for (int ct = 0; ct < 2; ++ct) { const int i0 = 16 * ct + 4 * fq; cs[rt][ct][0] = *(const f32x4*)(rope + ((size_t)pos * 32 + i0) * 2); cs[rt][ct][1] = *(const f32x4*)(rope + ((size_t)pos * 32 + i0) * 2 + 4); } }
    __builtin_amdgcn_sched_barrier(0);
#pragma unroll
    for (int rt = 0; rt < 2; ++rt) { const int r = rl + 16 * rt;
#pragma unroll
        for (int ct = 0; ct < 2; ++ct) { const int i0 = 16 * ct + 4 * fq, col = 256 * T + 64 * h4 + i0;
            const f32x4 cs0 = cs[rt][ct][0], cs1 = cs[rt][ct][1];
            const float c[4] = {cs0[0], cs0[2], cs1[0], cs1[2]}, s[4] = {cs0[1], cs0[3], cs1[1], cs1[3]};
            f32x4 o1, o2;
#pragma unroll
            for (int j = 0; j < 4; ++j) { const float x1 = acc[rt][ct][j], x2 = acc[rt][ct + 2][j]; o1[j] = (x1 * c[j] - x2 * s[j]) * scale; o2[j] = (x2 * c[j] + x1 * s[j]) * scale; }
            *(v2u*)(Ob + (size_t)(MP + r) * AW + col) = pack4(o1); *(v2u*)(Ob + (size_t)(MP + r) * AW + col + 32) = pack4(o2);
            if (Of) { *(f32x4*)(Of + (size_t)r * AW + col) = o1; *(f32x4*)(Of + (size_t)r * AW + col + 32) = o2; } } }
}
__device__ __forceinline__ void sg_kv(Frame& F) {
    const bf16* A = WSP(bf16, WS_XNKV) + (size_t)MP * 1024; const bf16* Bt = WSP(bf16, WS_WKV);
    SAMPLE_UNITS(u, 144, 0) {
        if (u < 48) { const int T = u >> 2, h4 = u & 3;
            sgemm_unit<4>(A, Bt, 1024, 0, 1024, [&](int ct) { return 256 * T + 128 * (ct >> 1) + 32 * h4 + 16 * (ct & 1); },
                [&](const f32x4 (&acc)[2][4], int rl, int fq) { sg_rope_store(acc, rl, fq, T, h4, WSP(float, WS_ROPE), 1.0f, WSP(bf16, WS_KB), F.out + O_KS); }, F.wave, F.lane);
        } else { const int c0 = 32 * (u - 48);
            sgemm_unit<2>(A, Bt + (size_t)3072 * 1024, 1024, 0, 1024, [&](int ct) { return c0 + 16 * ct; },
                [&](const f32x4 (&acc)[2][2], int rl, int fq) {
#pragma unroll
                    for (int rt = 0; rt < 2; ++rt)
#pragma unroll
                        for (int ct = 0; ct < 2; ++ct) { const int r = rl + 16 * rt, col = c0 + 16 * ct + 4 * fq;
                            *(v2u*)(WSP(bf16, WS_VB) + (size_t)(MP + r) * AW + col) = pack4(acc[rt][ct]); *(f32x4*)(F.out + O_VS + (size_t)r * AW + col) = acc[rt][ct]; } },
                F.wave, F.lane); }
    }
}
__device__ __forceinline__ void sg_q(Frame& F, int LB, int skip) {
    const bf16* A = WSP(bf16, WS_XN) + (size_t)MP * 1024; const bf16* Bt = WSP(bf16, WS_WQ) + (size_t)LB * AW * 1024;
    SAMPLE_UNITS(u, 48, skip) { const int T = u >> 2, h4 = u & 3;
        sgemm_unit<4>(A, Bt, 1024, 0, 1024, [&](int ct) { return 256 * T + 128 * (ct >> 1) + 32 * h4 + 16 * (ct & 1); },
            [&](const f32x4 (&acc)[2][4], int rl, int fq) { sg_rope_store(acc, rl, fq, T, h4, WSP(float, WS_ROPE), QSCALE, WSP(bf16, WS_QB), nullptr); }, F.wave, F.lane); }
}

__device__ __forceinline__ void vt_phase(Frame& F) {
    const bf16* V = WSP(bf16, WS_VB); bf16* Vt = WSP(bf16, WS_VT);
    LAS unsigned* tile32 = (LAS unsigned*)(F.lds + RING_OFF + F.wave * 16384); LAS bf16* tile16 = (LAS bf16*)tile32;
    const int gw = F.vcu * NWAVES + F.wave, NGW = F.G * NWAVES, lane = F.lane;
    for (int u = gw; u < 2 * 48 * 128; u += NGW) {
        const int blk = u & 127, head = (u >> 7) % 48, b = u / (128 * 48);
        const int gsh = (head >> 4) * 2, dil = 1 << gsh, nsub = 8192 >> gsh, loc0 = blk * 64, r = loc0 / nsub, i0 = loc0 % nsub;
#pragma unroll
        for (int it = 0; it < 8; ++it) { const int tok = 8 * it + (lane >> 3), cg = lane & 7;
            const v4u val = *(const v4u*)(V + (size_t)(b * 8192 + dil * (i0 + tok) + r) * 3072 + head * 64 + 8 * cg);
            LAS unsigned* p = tile32 + tok * 33 + 4 * cg; p[0] = val.x; p[1] = val.y; p[2] = val.z; p[3] = val.w; }
        LDS_WAIT();
#pragma unroll
        for (int it = 0; it < 8; ++it) { const int d = 8 * it + (lane >> 3), ck = lane & 7;
            unsigned e[8];
#pragma unroll
            for (int k = 0; k < 8; ++k) e[k] = tile16[(8 * ck + k) * 66 + d];
            *(v4u*)(Vt + (size_t)((b * 48 + head) * 64 + d) * 8192 + r * nsub + i0 + 8 * ck) = (v4u){e[0] | (e[1] << 16), e[2] | (e[3] << 16), e[4] | (e[5] << 16), e[6] | (e[7] << 16)}; }
        LDS_WAIT();
    }
}
constexpr int AT_KBYTES = 256 * 128, AT_BUF = 2 * AT_KBYTES;
constexpr int AT_NS = 64;
struct AtPre { v4u k[4]; v4u v[4]; bf16x8 q[2]; };
__device__ __forceinline__ void at_decode(int u, int& b, int& head, int& gsh, int& r, int& i0) {
    const int run = u & 63; head = (u >> 6) % 48; b = u / (64 * 48); gsh = (head >> 4) * 2;
    const int nsub = 8192 >> gsh, loc0 = run * 128; r = loc0 / nsub; i0 = loc0 % nsub;
}
__device__ __forceinline__ void at_issue(AtPre& P, const bf16* Qb, const bf16* Kb, const bf16* Vb, int u, int tid) {
    int b, head, gsh, r, i0; at_decode(u, b, head, gsh, r, i0);
#pragma unroll
    for (int j = 0; j < 4; ++j) { const int c = tid + 512 * j, row = c >> 3, ch = c & 7; int si = i0 - 128 + row; si = si < 0 ? 0 : si;
        const size_t off = ((size_t)b * 8192 + ((size_t)si << gsh) + r) * 3072 + head * 64 + 8 * ch;
        P.k[j] = *(const v4u*)(Kb + off); P.v[j] = *(const v4u*)(Vb + off); }
    const int wave = tid >> 6, lane = tid & 63, fr = lane & 15, fq = lane >> 4;
    const size_t qrow = (size_t)b * 8192 + ((size_t)(i0 + 16 * wave + fr) << gsh) + r;
#pragma unroll
    for (int ks = 0; ks < 2; ++ks) P.q[ks] = *(const bf16x8*)(Qb + qrow * 3072 + head * 64 + 32 * ks + 8 * fq);
}
__device__ __forceinline__ void at_write(const AtPre& P, LAS unsigned char* buf, int tid) {
#pragma unroll
    for (int j = 0; j < 4; ++j) { const int c = tid + 512 * j, row = c >> 3, ch = c & 7; *(LAS v4u*)(buf + row * 128 + ((ch ^ (row & 7)) << 4)) = P.k[j]; }
#pragma unroll
    for (int j = 0; j < 4; ++j) { const int c = tid + 512 * j, row = c >> 3, ch = c & 7; *(LAS v4u*)(buf + AT_KBYTES + row * 128 + ((ch ^ (row & 7)) << 4)) = P.v[j]; }
}
__device__ __forceinline__ void at_compute(const LAS unsigned char* buf, const bf16x8 (&qf)[2], int u, int wave, int lane, bf16* Og, f32x2* ML) {
    int b, head, gsh, r, i0; at_decode(u, b, head, gsh, r, i0);
    const int fr = lane & 15, fq = lane >> 4;
    f32x4 s[9];
    { bf16x8 k0[9], k1[9];
#pragma unroll
      for (int kt = 0; kt < 9; ++kt) { const int row = 16 * wave + 16 * kt + fr;
          k0[kt] = *(const LAS bf16x8*)(buf + row * 128 + (((fq) ^ (row & 7)) << 4)); k1[kt] = *(const LAS bf16x8*)(buf + row * 128 + (((4 + fq) ^ (row & 7)) << 4)); }
      __builtin_amdgcn_sched_barrier(0);
#pragma unroll
      for (int kt = 0; kt < 9; ++kt) { s[kt] = MFMA16(k0[kt], qf[0], ((f32x4){0.f, 0.f, 0.f, 0.f})); s[kt] = MFMA16(k1[kt], qf[1], s[kt]); }
      __builtin_amdgcn_sched_barrier(0); }
    const int kbase = i0 - 128 + 16 * wave;
    float mx = -INFINITY;
#pragma unroll
    for (int kt = 0; kt < 9; ++kt)
#pragma unroll
        for (int rho = 0; rho < 4; ++rho) { const int kk = 16 * kt + 4 * fq + rho; const bool ok = kk >= fr && kk <= fr + 128 && (kbase + kk) >= 0;
            s[kt][rho] = ok ? s[kt][rho] : -INFINITY; mx = fmaxf(mx, s[kt][rho]); }
    mx = fmaxf(mx, __shfl_xor(mx, 16)); mx = fmaxf(mx, __shfl_xor(mx, 32));
    float ls = 0.f;
#pragma unroll
    for (int kt = 0; kt < 9; ++kt)
#pragma unroll
        for (int rho = 0; rho < 4; ++rho) { const float p = __builtin_amdgcn_exp2f(s[kt][rho] - mx); s[kt][rho] = p; ls += p; }
    ls += __shfl_xor(ls, 16); ls += __shfl_xor(ls, 32);
    f32x4 o[4];
#pragma unroll
    for (int dt = 0; dt < 4; ++dt) o[dt] = (f32x4){0.f, 0.f, 0.f, 0.f};
#pragma unroll
    for (int k5 = 0; k5 < 5; ++k5) {
        v4u pp; pp.x = pk2(s[2 * k5][0], s[2 * k5][1]); pp.y = pk2(s[2 * k5][2], s[2 * k5][3]);
        if (k5 < 4) { pp.z = pk2(s[2 * k5 + 1][0], s[2 * k5 + 1][1]); pp.w = pk2(s[2 * k5 + 1][2], s[2 * k5 + 1][3]); } else { pp.z = 0u; pp.w = 0u; }
        const bf16x8 pf = __builtin_bit_cast(bf16x8, pp);
        v2u lo[4], hi[4];
        const int vrow = 16 * wave + 32 * k5 + 4 * fq + (fr >> 2);
#pragma unroll
        for (int dt = 0; dt < 4; ++dt) { const int c16 = 2 * dt + ((fr & 3) >> 1), sub = 8 * (fr & 1);
            lo[dt] = __builtin_bit_cast(v2u, __builtin_amdgcn_ds_read_tr16_b64_v4i16((LAS s16x4*)(buf + AT_KBYTES + vrow * 128 + ((c16 ^ (vrow & 7)) << 4) + sub)));
            if (k5 < 4) hi[dt] = __builtin_bit_cast(v2u, __builtin_amdgcn_ds_read_tr16_b64_v4i16((LAS s16x4*)(buf + AT_KBYTES + (vrow + 16) * 128 + ((c16 ^ ((vrow + 16) & 7)) << 4) + sub)));
            else hi[dt] = (v2u){0u, 0u}; }
        __builtin_amdgcn_sched_barrier(0);
#pragma unroll
        for (int dt = 0; dt < 4; ++dt) o[dt] = MFMA16(__builtin_bit_cast(bf16x8, ((v4u){lo[dt].x, lo[dt].y, hi[dt].x, hi[dt].y})), pf, o[dt]);
    }
    const int g = head >> 4, hh = head & 15;
    const size_t row = (size_t)b * 8192 + ((size_t)(i0 + 16 * wave + fr) << gsh) + r;
    const float inv = 1.0f / ls;
    bf16* op = Og + ((size_t)g * MT + row) * 1024 + hh * 64 + 4 * fq;
#pragma unroll
    for (int dt = 0; dt < 4; ++dt) *(v2u*)(op + 16 * dt) = (v2u){pk2(o[dt][0] * inv, o[dt][1] * inv), pk2(o[dt][2] * inv, o[dt][3] * inv)};
    if (fq == 0) ML[((size_t)g * MT + row) * 16 + hh] = (f32x2){mx, ls};
}
__device__ __forceinline__ void attn_prompt_phase(Frame& F, int first, int nwg) {
    const bf16* Qb = WSP(bf16, WS_QB); const bf16* Kb = WSP(bf16, WS_KB); const bf16* Vt = WSP(bf16, WS_VB); bf16* Og = WSP(bf16, WS_OG); f32x2* ML = WSP(f32x2, WS_ML);
    const int me = (int)blockIdx.x - first;
    if (me < 0 || me >= nwg) return;
    AtPre P; int u = me; int par = 0;
    if (u < 6144) { at_issue(P, Qb, Kb, Vt, u, F.tid); at_write(P, F.lds + RING_OFF, F.tid); }
    bf16x8 qf[2] = {P.q[0], P.q[1]};
    LDS_WAIT(); __syncthreads();
    for (; u < 6144; u += nwg) {
        const int un = u + nwg;
        if (un < 6144) at_issue(P, Qb, Kb, Vt, un, F.tid);
        at_compute(F.lds + RING_OFF + par * AT_BUF, qf, u, F.wave, F.lane, Og, ML);
        if (un < 6144) { at_write(P, F.lds + RING_OFF + (par ^ 1) * AT_BUF, F.tid); qf[0] = P.q[0]; qf[1] = P.q[1]; }
        LDS_WAIT(); __syncthreads();
        par ^= 1;
    }
}
__device__ __forceinline__ void sa_load(f32x4 (&buf)[16], int jbase, const float* cache, const float* fresh, int b, int t, int gsh, int h0, int lane) {
#pragma unroll
    for (int jj = 0; jj < 16; ++jj) { int j = jbase + jj; j = j > 128 ? 128 : j; const int idx = 2048 + t - (j << gsh);
        const float* p = idx < 2048 ? cache + ((size_t)(b * 2048 + idx) * 48 + h0) * 64 : fresh + (size_t)(b * 8 + idx - 2048) * 3072 + h0 * 64;
        buf[jj] = *(const f32x4*)(p + 4 * lane); }
}
__device__ __forceinline__ void sa_score(const f32x4 (&buf)[16], int jbase, const float (&q4)[4], LAS float* sc, int hq, int dq) {
#pragma unroll
    for (int jj = 0; jj < 16; ++jj) { const float p = row16_sum((q4[0] * buf[jj].x + q4[1] * buf[jj].y) + (q4[2] * buf[jj].z + q4[3] * buf[jj].w));
        if (dq == 0 && jbase + jj < 129) sc[hq * 132 + jbase + jj] = p; }
}
__device__ __forceinline__ void sa_pv(const f32x4 (&buf)[16], int jbase, const LAS float* sc, int hq, f32x4& o) {
#pragma unroll
    for (int jj = 0; jj < 16; ++jj) { const float pj = (jbase + jj < 129) ? sc[hq * 132 + jbase + jj] : 0.f; o += pj * buf[jj]; }
}
__device__ __forceinline__ void attn_sample_phase(Frame& F, int first, int nwg, int LB) {
    const int me = (int)blockIdx.x - first;
    if (me < 0 || me >= nwg) return;
    unsigned* ctr = (unsigned*)(F.ctl + 2048 + LB);
    const bf16* Qb = WSP(bf16, WS_QB); bf16* Og = WSP(bf16, WS_OG); f32x2* ML = WSP(f32x2, WS_ML);
    const float* ck = F.in[I_CK]; const float* cv = F.in[I_CV]; const float* kS = F.out + O_KS; const float* vS = F.out + O_VS;
    LAS float* sc = (LAS float*)(F.lds + RING_OFF + F.wave * 4096);
    const int lane = F.lane, hq = lane >> 4, dq = lane & 15;
    for (int it = 0;; ++it) {
        if (F.tid == 0) F.MISC[16 + (it & 1)] = xb_add(ctr, 1u);
        __syncthreads();
        const int v = (int)F.MISC[16 + (it & 1)];
        if (v >= 32 * 3 * 4) break;
        const int u = 32 * 3 * 4 - 1 - v;
        const int hquad = u & 3, b = (u >> 2) & 31, g = u >> 7, gsh = 2 * g;
        const int t = F.wave, h0 = 16 * g + 4 * hquad;
        const size_t row = (size_t)(MP + b * 8 + t);
        float q4[4]; unpack4(*(const v2u*)(Qb + row * 3072 + h0 * 64 + 4 * lane), q4);
        f32x4 bA[16], bB[16];
        sa_load(bA, 0, ck, kS, b, t, gsh, h0, lane);
#pragma unroll 1
        for (int j0 = 0; j0 < 128; j0 += 32) {
            sa_load(bB, j0 + 16, ck, kS, b, t, gsh, h0, lane); sa_score(bA, j0, q4, sc, hq, dq);
            sa_load(bA, j0 + 32, ck, kS, b, t, gsh, h0, lane); sa_score(bB, j0 + 16, q4, sc, hq, dq);
        }
        sa_load(bB, 0, cv, vS, b, t, gsh, h0, lane);
        sa_score(bA, 128, q4, sc, hq, dq);
        LDS_WAIT();
        float sv[9]; float mx = -INFINITY;
#pragma unroll
        for (int i = 0; i < 9; ++i) { const int j = dq + 16 * i; sv[i] = j < 129 ? sc[hq * 132 + j] : -INFINITY; mx = fmaxf(mx, sv[i]); }
        mx = fmaxf(mx, __shfl_xor(mx, 1)); mx = fmaxf(mx, __shfl_xor(mx, 2)); mx = fmaxf(mx, __shfl_xor(mx, 4)); mx = fmaxf(mx, __shfl_xor(mx, 8));
        float ls = 0.f;
#pragma unroll
        for (int i = 0; i < 9; ++i) { sv[i] = __builtin_amdgcn_exp2f(sv[i] - mx); ls += sv[i]; }
        ls = row16_sum(ls);
        LDS_WAIT();
#pragma unroll
        for (int i = 0; i < 9; ++i) { const int j = dq + 16 * i; if (j < 129) sc[hq * 132 + j] = sv[i]; }
        LDS_WAIT();
        f32x4 o = (f32x4){0.f, 0.f, 0.f, 0.f};
#pragma unroll 1
        for (int j0 = 0; j0 < 128; j0 += 32) {
            sa_load(bA, j0 + 16, cv, vS, b, t, gsh, h0, lane); sa_pv(bB, j0, sc, hq, o);
            sa_load(bB, j0 + 32, cv, vS, b, t, gsh, h0, lane); sa_pv(bA, j0 + 16, sc, hq, o);
        }
        sa_pv(bB, 128, sc, hq, o);
        LDS_WAIT();
        const int hh = 4 * hquad + hq; const float inv = 1.0f / ls;
        *(v2u*)(Og + ((size_t)g * MT + row) * 1024 + hh * 64 + 4 * dq) = (v2u){pk2(o[0] * inv, o[1] * inv), pk2(o[2] * inv, o[3] * inv)};
        if (dq == 0) ML[((size_t)g * MT + row) * 16 + hh] = (f32x2){mx, ls};
    }
}
struct MgIn { f32x2 a0, a1, a2; v4u x0, x1, x2; };
__device__ __forceinline__ void mg_load(MgIn& I, const bf16* Og, const f32x2* ML, int i) { const int row = i >> 7, c8 = i & 127, hh = c8 >> 3;
    I.a0 = ML[((size_t)0 * MT + row) * 16 + hh]; I.a1 = ML[((size_t)1 * MT + row) * 16 + hh]; I.a2 = ML[((size_t)2 * MT + row) * 16 + hh];
    I.x0 = *(const v4u*)(Og + ((size_t)0 * MT + row) * 1024 + 8 * c8); I.x1 = *(const v4u*)(Og + ((size_t)1 * MT + row) * 1024 + 8 * c8); I.x2 = *(const v4u*)(Og + ((size_t)2 * MT + row) * 1024 + 8 * c8); }
__device__ __forceinline__ void mg_store(const MgIn& I, bf16* Ob, int i) { const int row = i >> 7, c8 = i & 127;
    const f32x2 a0 = I.a0, a1 = I.a1, a2 = I.a2; const v4u x0 = I.x0, x1 = I.x1, x2 = I.x2;
    const float M = fmaxf(a0.x, fmaxf(a1.x, a2.x));
    float w0 = __builtin_amdgcn_exp2f(a0.x - M) * a0.y, w1 = __builtin_amdgcn_exp2f(a1.x - M) * a1.y, w2 = __builtin_amdgcn_exp2f(a2.x - M) * a2.y;
    const float inv = 1.0f / (w0 + w1 + w2); w0 *= inv; w1 *= inv; w2 *= inv;
    v4u o;
    o.x = pk2(w0 * bflo(x0.x) + w1 * bflo(x1.x) + w2 * bflo(x2.x), w0 * bfhi(x0.x) + w1 * bfhi(x1.x) + w2 * bfhi(x2.x));
    o.y = pk2(w0 * bflo(x0.y) + w1 * bflo(x1.y) + w2 * bflo(x2.y), w0 * bfhi(x0.y) + w1 * bfhi(x1.y) + w2 * bfhi(x2.y));
    o.z = pk2(w0 * bflo(x0.z) + w1 * bflo(x1.z) + w2 * bflo(x2.z), w0 * bfhi(x0.z) + w1 * bfhi(x1.z) + w2 * bfhi(x2.z));
    o.w = pk2(w0 * bflo(x0.w) + w1 * bflo(x1.w) + w2 * bflo(x2.w), w0 * bfhi(x0.w) + w1 * bfhi(x1.w) + w2 * bfhi(x2.w));
    *(v4u*)(Ob + (size_t)row * 1024 + 8 * c8) = o; }
__device__ __forceinline__ void attn_merge_phase(Frame& F) {
    const bf16* Og = WSP(bf16, WS_OG); const f32x2* ML = WSP(f32x2, WS_ML); bf16* Ob = WSP(bf16, WS_OB);
    const int gt = F.vcu * (NWAVES * 64) + F.tid, NGT = F.G * NWAVES * 64;
    int i = gt;
#pragma unroll 1
    for (; i + 3 * NGT < MT * 128; i += 4 * NGT) { MgIn A, B, C, D; mg_load(A, Og, ML, i); mg_load(B, Og, ML, i + NGT); mg_load(C, Og, ML, i + 2 * NGT); mg_load(D, Og, ML, i + 3 * NGT);
        __builtin_amdgcn_sched_barrier(0);
        mg_store(A, Ob, i); mg_store(B, Ob, i + NGT); mg_store(C, Ob, i + 2 * NGT); mg_store(D, Ob, i + 3 * NGT);
        __builtin_amdgcn_sched_barrier(0); }
#pragma unroll 1
    for (; i < MT * 128; i += NGT) { MgIn A; mg_load(A, Og, ML, i); mg_store(A, Ob, i); }
}


constexpr int NPHASES = 38;
#ifndef PROBE_MASK
#define PROBE_MASK 0u
#endif
#ifdef PROBE_NULLEPI
#define PROBE_NULLEPI_ON 1
#else
#define PROBE_NULLEPI_ON 0
#endif
#ifndef PROBE_FLAGS
#define PROBE_FLAGS 0
#endif
#ifndef PROBE_SUB
#define PROBE_SUB 3
#endif
#ifndef PROBE_REPS
#define PROBE_REPS 2
#endif
#ifndef AUDIT_SUB
#define AUDIT_SUB 3
#endif
#ifndef AUDIT_SITES
#define AUDIT_SITES 0xffffffffu
#endif
struct Args { const float* in[32]; float* out; unsigned char* ws; int ph_lo, ph_hi, li, pad; };
__device__ __forceinline__ Frame phase_frame(const Frame& F0) {
    Frame F = F0; int tid = F0.wave * 64 + lane_id_v();
    F.tid = tid; F.lane = tid & 63; F.wave = __builtin_amdgcn_readfirstlane(tid >> 6);
    return F;
}
__global__ void __launch_bounds__(NWAVES * 64, 2) yoco_fwd(Args args) {
    extern __shared__ __attribute__((aligned(16))) unsigned char lds[];
    Frame F0;
    F0.lds = (LAS unsigned char*)lds;
    F0.MISC = (volatile LAS unsigned*)(F0.lds + MISC_OFF);
    F0.tid = threadIdx.x; F0.lane = F0.tid & 63; F0.wave = __builtin_amdgcn_readfirstlane(F0.tid >> 6);
    F0.G = gridDim.x; { const int bx = blockIdx.x; F0.vcu = (F0.G % 8 == 0) ? (bx % 8) * (F0.G / 8) + bx / 8 : bx; }
    F0.ws = args.ws; F0.out = args.out; F0.ctl = (gu32*)(args.ws + WS_CTL);
    F0.in = args.in;
    for (int u = F0.tid; u < (LDS_BYTES - LDSCTL_OFF) / 4; u += NWAVES * 64) ((LAS unsigned*)(F0.lds + LDSCTL_OFF))[u] = 0u;
    __syncthreads();
    XcdBarrier bar; bar.bar = (unsigned*)(F0.ctl + CW_BAR); bar.x = 0; bar.st = nullptr;
    if (MK_N_LAUNCHES == 1) bar = xcd_barrier_post((unsigned*)(F0.ctl + CW_BAR), F0.MISC + 8);
    bar.wave = F0.wave;
    const int lo = args.ph_lo, hi = args.ph_hi;
    int ph = 0;
#define PHASE_BEGIN(id) if (((AUDIT_SITES >> (id)) & 1u) && lo <= ph && ph < hi) { _Pragma("unroll 1") for (int rep_ = 0; rep_ < (((PROBE_MASK >> (id)) & 1u) ? 1 + PROBE_REPS : 1); ++rep_) { Frame F = phase_frame(F0); \
    F.pflags = (PROBE_FLAGS != 0 && ((PROBE_MASK >> (id)) & 1u) && rep_ < PROBE_REPS) ? PROBE_FLAGS : 0;
#define PHASE_END } if (ph + 1 < hi) { if (MK_N_LAUNCHES == 1) xcd_barrier(bar); } } ++ph;
#define H_ WSP(float, WS_H)
#define HB_ WSP(bf16, WS_H)
#define HS_ (WSP(float, WS_H) + (size_t)MP * 1024)
#define XN_ WSP(bf16, WS_XN)
#define XNKV_ WSP(bf16, WS_XNKV)
#define MODL_ (WSP(float, WS_MOD) + (size_t)L * NSEQ * 6144)
#define HP_ ((L == 0) ? F.in[I_XP] : H_)
#define HSS_ ((L == 0) ? F.in[I_XS] : HS_)

    PHASE_BEGIN(0) if (AUDIT_SUB & 1) p0_weights(F); __syncthreads(); if (AUDIT_SUB & 2) p0_adaln(F); PHASE_END

#pragma unroll 1
    for (int L = 0; L < 4; ++L) {
        PHASE_BEGIN(1)
            const Pend pd{(L == 0 || rep_ > 0) ? nullptr : WSP(float, WS_SLAB), WSP(float, WS_MOD) + (size_t)(L == 0 ? 0 : L - 1) * NSEQ * 6144 + 5120, HS_, HS_};
            if (L == 2) norm_rows<2, true>(F, pd, HB_, HSS_, F.in[I_NMIX] + L * 1024, MODL_, 0, 1024, XN_, F.in[I_KVN], WSP(float, WS_MOD) + (size_t)4 * NSEQ * 6144, 0, 1024, XNKV_);
            else if (L == 0) norm_rows<1, false>(F, pd, F.in[I_XP], HSS_, F.in[I_NMIX] + L * 1024, MODL_, 0, 1024, XN_, F.in[I_NMIX] + L * 1024, MODL_, 0, 1024, XN_);
            else norm_rows<1, true>(F, pd, HB_, HSS_, F.in[I_NMIX] + L * 1024, MODL_, 0, 1024, XN_, F.in[I_NMIX] + L * 1024, MODL_, 0, 1024, XN_);
        PHASE_END
        if (L < 2) {
            PHASE_BEGIN(2) { pg8::Gemm g{XN_, WSP(bf16, WS_WIN) + (size_t)L * INPAD * 1024, MP, INW, 1024, F.pflags}; pg8::StaticOrder S; S.init(MP, INW, F.G, (int)blockIdx.x);
                pg8::EpiInProj E{WSP(bf16, WS_BIG), WSP(float, WS_DTRAW), (PROBE_NULLEPI_ON && rep_ > 0) || F.pflags != 0};
                if (!(F.pflags & 16)) pg8::gemm_phase<pg8::EpiInProj, pg8::StaticOrder, true, true>(F.lds + RING_OFF, g, S, E, F.tid); }
                if (!(PROBE_NULLEPI_ON && rep_ > 0) && (F.pflags == 0 || (F.pflags & 16))) { sg_inproj(F, L); sg_dt(F, L); } PHASE_END
            PHASE_BEGIN(3) conv_mamba_phase(F, L); PHASE_END
            PHASE_BEGIN(4) if ((AUDIT_SUB & 1) && (rep_ == 0 || (PROBE_SUB & 1))) ssd_s1_phase(F, L); if ((AUDIT_SUB & 2) && (rep_ == 0 || (PROBE_SUB & 2))) { Frame F2 = phase_frame(F0); F2.pflags = 0; ssd_sample_phase(F2, L); } PHASE_END
            PHASE_BEGIN(5) ssd_s2_phase(F, L); PHASE_END
            PHASE_BEGIN(6) ssd_s3_phase(F, L); PHASE_END
        } else {
            PHASE_BEGIN(7)
                if (L == 2) { pg8::Gemm g{XNKV_, WSP(bf16, WS_WKV), MP, 6144, 1024}; pg8::StaticOrder S; S.init(MP, 6144, F.G, (int)blockIdx.x);
                    pg8::EpiRopeKV E{WSP(bf16, WS_KB), WSP(bf16, WS_VB), F.out + O_KP, F.out + O_KS, F.out + O_VP, F.out + O_VS, WSP(float, WS_ROPE)};
                    pg8::gemm_phase<pg8::EpiRopeKV, pg8::StaticOrder, true, true>(F.lds + RING_OFF, g, S, E, F.tid); }
                { pg8::Gemm g{XN_, WSP(bf16, WS_WQ) + (size_t)(L - 2) * AW * 1024, MP, AW, 1024}; pg8::StaticOrder S; S.init(MP, AW, F.G, (int)blockIdx.x);
                    pg8::EpiRopeQ E{WSP(bf16, WS_QB), WSP(float, WS_ROPE), QSCALE};
                    pg8::gemm_phase<pg8::EpiRopeQ, pg8::StaticOrder, true, true>(F.lds + RING_OFF, g, S, E, F.tid); }
                if (L == 2) sg_kv(F);
                sg_q(F, L - 2, L == 2 ? 144 : 0);
            PHASE_END
            PHASE_BEGIN(9) if ((AUDIT_SUB & 1) && (rep_ == 0 || (PROBE_SUB & 1))) attn_prompt_phase(F, AT_NS, (int)F.G - AT_NS); __syncthreads(); if ((AUDIT_SUB & 2) && (rep_ == 0 || (PROBE_SUB & 2))) attn_sample_phase(F, 0, (int)F.G, L - 2); PHASE_END
            PHASE_BEGIN(16) attn_merge_phase(F); PHASE_END
        }
        PHASE_BEGIN(10) { pg8::Gemm g{L < 2 ? WSP(bf16, WS_Y) : WSP(bf16, WS_OB), L < 2 ? WSP(bf16, WS_WOUT) + (size_t)L * 1024 * 2048 : WSP(bf16, WS_WO) + (size_t)(L - 2) * 1024 * 1024, MP, 1024, L < 2 ? 2048 : 1024};
            pg8::StaticOrder S; S.init(MP, 1024, F.G, (int)blockIdx.x);
            pg8::EpiResid E{L == 0 ? F.in[I_XP] : nullptr, HB_, rep_ > 0 ? WSP(bf16, WS_END) : HB_, MODL_ + 2048};
            pg8::gemm_phase<pg8::EpiResid, pg8::StaticOrder, true, true>(F.lds + RING_OFF, g, S, E, F.tid);
            sg_resid(F, (L < 2 ? WSP(bf16, WS_Y) + (size_t)MP * 2048 : WSP(bf16, WS_OB) + (size_t)MP * 1024), g.Bt, g.K); } PHASE_END
        PHASE_BEGIN(11) { const Pend pd{rep_ > 0 ? nullptr : WSP(float, WS_SLAB), MODL_ + 2048, HSS_, HS_};
            norm_rows<1, true>(F, pd, HB_, HS_, F.in[I_NFFN] + L * 1024, MODL_, 3072, 4096, XN_, F.in[I_NFFN] + L * 1024, MODL_, 3072, 4096, XN_); } PHASE_END
        PHASE_BEGIN(12) { pg8::Gemm g{XN_, WSP(bf16, WS_WUP) + (size_t)L * FF2 * 1024, MT, FF2, 1024}; pg8::UpOrder S; S.init(MP, FF2, F.G, (int)blockIdx.x);
            pg8::EpiUpConv E{WSP(bf16, WS_ACT), WSP(float, WS_UB), F.in[I_FCW] + (size_t)L * 3 * FF2, F.in[I_FCB] + (size_t)L * FF2, F.out + O_FFNP + (size_t)L * 2 * 2 * FF2, F.out + O_FFNS + (size_t)L * 32 * 2 * FF2, F.in[I_FFNC] + (size_t)L * 32 * 2 * FF2, F.pflags != 0};
            pg8::gemm_phase<pg8::EpiUpConv, pg8::UpOrder, true, true>(F.lds + RING_OFF, g, S, E, F.tid); } PHASE_END
        PHASE_BEGIN(14) { pg8::Gemm g{WSP(bf16, WS_ACT), WSP(bf16, WS_WDN) + (size_t)L * 1024 * FF, MP, 1024, FF}; pg8::StaticOrder S; S.init(MP, 1024, F.G, (int)blockIdx.x);
            { pg8::Unit u0; if (S.next(0, u0)) ffn_fixup(F, L, u0.pm); else { VM_WAIT(); __syncthreads(); } }
            pg8::EpiResid E{nullptr, HB_, rep_ > 0 ? WSP(bf16, WS_END) : HB_, MODL_ + 5120};
            pg8::gemm_phase<pg8::EpiResid, pg8::StaticOrder, true, true>(F.lds + RING_OFF, g, S, E, F.tid);
            sg_resid(F, WSP(bf16, WS_ACT) + (size_t)MP * FF, g.Bt, FF); } PHASE_END
    }
    PHASE_BEGIN(15) { const Pend pd{rep_ > 0 ? nullptr : WSP(float, WS_SLAB), WSP(float, WS_MOD) + (size_t)3 * NSEQ * 6144 + 5120, HS_, HS_};
        final_norm_phase(F, pd, HB_, HS_, F.in[I_FN], F.out + O_YP); } PHASE_END
#ifdef PROBE_BARRIERS
    if (MK_N_LAUNCHES == 1) { _Pragma("unroll 1") for (int i = 0; i < PROBE_BARRIERS; ++i) xcd_barrier(bar); }
#endif
#undef PHASE_BEGIN
#undef PHASE_END
}

extern "C" void kernel_launch(void* const* d_in, const int* in_sizes, int n_in, void* d_out, int out_size, void* d_ws, size_t ws_size, hipStream_t stream) {
    static int grid = 0;
    if (grid == 0) {
        if (n_in != 32 || (size_t)out_size != O_END || ws_size < WS_END + 80 * MiB) { fprintf(stderr, "kernel_launch: unexpected shapes (n_in %d, out %d, ws %zu, need %zu); nothing launched\n", n_in, out_size, ws_size, (size_t)WS_END); grid = -1; return; }
        int dev = 0, cus = 0;
        if (hipGetDevice(&dev) != hipSuccess || hipDeviceGetAttribute(&cus, hipDeviceAttributeMultiprocessorCount, dev) != hipSuccess) { grid = -1; return; }
        if (hipFuncSetAttribute((const void*)yoco_fwd, hipFuncAttributeMaxDynamicSharedMemorySize, LDS_BYTES) != hipSuccess) { fprintf(stderr, "kernel_launch: hipFuncSetAttribute failed\n"); grid = -1; return; }
        int per_cu = 0;
        if (hipOccupancyMaxActiveBlocksPerMultiprocessor(&per_cu, (const void*)yoco_fwd, NWAVES * 64, LDS_BYTES) != hipSuccess || per_cu < 1)
            fprintf(stderr, "kernel_launch: note: occupancy query reports %d workgroups per CU\n", per_cu);
        (void)hipGetLastError();
        grid = cus;
        if (grid < 22) { fprintf(stderr, "kernel_launch: %d CUs: the up-projection's schedule needs at least 22 workgroups; nothing launched\n", grid); grid = -1; return; }
    }
    if (grid < 0) return;
    if (hipMemsetAsync((char*)d_ws + WS_CTL, 0, CTL_ZERO_BYTES, stream) != hipSuccess) return;
    Args a{};
    for (int i = 0; i < 32; ++i) a.in[i] = (const float*)d_in[i];
    a.out = (float*)d_out; a.ws = (unsigned char*)d_ws; a.li = 0; a.pad = 0;
#if MK_N_LAUNCHES == 1
    a.ph_lo = 0; a.ph_hi = NPHASES;
    hipLaunchKernelGGL(yoco_fwd, dim3(grid), dim3(NWAVES * 64), LDS_BYTES, stream, a);
#else
    for (int k = 0; k < NPHASES; ++k) { a.ph_lo = k; a.ph_hi = k + 1; hipLaunchKernelGGL(yoco_fwd, dim3(grid), dim3(NWAVES * 64), LDS_BYTES, stream, a); }
#endif
    const hipError_t le = hipPeekAtLastError();
    if (le != hipSuccess) fprintf(stderr, "kernel_launch: launch failed: %s\n", hipGetErrorName(le));
}
```
